# Optimizing an MI355X kernel written in HIP

```python
import jax, jax.numpy as jnp
from jax import lax
import numpy as np

D_MODEL = 1024
BATCH = 4
SEQ = 4096
DEPTH = 2

MLA_HEADS = 8
MLA_Q_RANK = 256
MLA_KV_RANK = 128
MLA_NOPE = 64
MLA_ROPE = 32
MLA_V = 64
MOBA_HEADS = 8
MOBA_HEAD_DIM = 64
MOBA_BLOCK = 256
MOBA_TOPK = 3
MOBA_Q_CHUNK = 32
RET_HEADS = 4
RET_QK_DIM = 64
RET_V_DIM = 128
RET_CHUNK = 128
RET_THETA = 10000.0
ROPE_THETA = 500000.0
PARTIAL_ROPE_DIV = 4
ATTN_Q_BLOCK = 128
D_FF = 4 * D_MODEL
NORM_EPS = 1e-6
GN_EPS = 1e-5
NEG_INF = -1e30

MOBA_W = MOBA_HEADS * MOBA_HEAD_DIM
RET_QK_W = RET_HEADS * RET_QK_DIM
RET_V_W = RET_HEADS * RET_V_DIM
MLA_OUT_W = MLA_HEADS * MLA_V
IN_SPLIT_SIZES = (MLA_Q_RANK, MLA_KV_RANK, MLA_ROPE,
                  MOBA_W, MOBA_W, MOBA_W,
                  RET_QK_W, RET_QK_W, RET_V_W, RET_V_W,
                  D_MODEL, D_MODEL, D_MODEL)
IN_COLS = sum(IN_SPLIT_SIZES)
IN_SPLIT_IDX = tuple(int(i) for i in np.cumsum(IN_SPLIT_SIZES)[:-1])

kernel_name = "hybrid_mla_moba_retention_block"


def rms_norm(x, g, eps=NORM_EPS):
    xf = x.astype(jnp.float32)
    y = xf * lax.rsqrt(jnp.mean(xf * xf, axis=-1, keepdims=True) + eps)
    return (y * g.astype(jnp.float32)).astype(x.dtype)


def rope_tables(seq, dim, theta):
    inv = 1.0 / (theta ** (jnp.arange(0, dim, 2, dtype=jnp.float32) / dim))
    ang = jnp.arange(seq, dtype=jnp.float32)[:, None] * inv[None, :]
    return jnp.cos(ang), jnp.sin(ang)


def apply_rope(x, cos, sin):
    half = x.shape[-1] // 2
    x1, x2 = x[..., :half], x[..., half:]
    c, s = cos.astype(x.dtype), sin.astype(x.dtype)
    return jnp.concatenate([x1 * c - x2 * s, x1 * s + x2 * c], axis=-1)


def causal_attention(q, k, v, scale):
    B, H, S, _ = q.shape
    kpos = jnp.arange(S)

    def block(i):
        start = i * ATTN_Q_BLOCK
        qb = lax.dynamic_slice_in_dim(q, start, ATTN_Q_BLOCK, axis=2)
        s = jnp.einsum('bhqd,bhkd->bhqk', qb, k).astype(jnp.float32) * scale
        qpos = start + jnp.arange(ATTN_Q_BLOCK)
        s = jnp.where(kpos[None, :] <= qpos[:, None], s, NEG_INF)
        p = jax.nn.softmax(s, axis=-1).astype(v.dtype)
        return jnp.einsum('bhqk,bhkd->bhqd', p, v)

    o = lax.map(block, jnp.arange(S // ATTN_Q_BLOCK))
    return o.transpose(1, 2, 0, 3, 4).reshape(B, H, S, v.shape[-1])


def mla_branch(cq, ckv, k_rope, q_norm_g, kv_norm_g, w_q_up, w_kv_up, cos, sin):
    B, S, _ = cq.shape
    cq = rms_norm(cq, q_norm_g)
    ckv = rms_norm(ckv, kv_norm_g)
    q = (cq @ w_q_up).reshape(B, S, MLA_HEADS, MLA_NOPE + MLA_ROPE).transpose(0, 2, 1, 3)
    q = jnp.concatenate([q[..., :MLA_NOPE], apply_rope(q[..., MLA_NOPE:], cos, sin)], axis=-1)
    kv = (ckv @ w_kv_up).reshape(B, S, MLA_HEADS, MLA_NOPE + MLA_V).transpose(0, 2, 1, 3)
    k_pe = apply_rope(k_rope, cos, sin)[:, None]
    k = jnp.concatenate([kv[..., :MLA_NOPE],
                         jnp.broadcast_to(k_pe, (B, MLA_HEADS, S, MLA_ROPE))], axis=-1)
    v = kv[..., MLA_NOPE:]
    o = causal_attention(q, k, v, (MLA_NOPE + MLA_ROPE) ** -0.5)
    return o.transpose(0, 2, 1, 3).reshape(B, S, MLA_OUT_W)


def moba_branch(q, k, v, cos, sin):
    B, S, _ = q.shape
    H, Dh, BS, QC = MOBA_HEADS, MOBA_HEAD_DIM, MOBA_BLOCK, MOBA_Q_CHUNK
    rd = Dh // PARTIAL_ROPE_DIV

    def heads(t):
        return t.reshape(B, S, H, Dh).transpose(0, 2, 1, 3)

    def partial_rope(t):
        return jnp.concatenate([apply_rope(t[..., :rd], cos, sin), t[..., rd:]], axis=-1)

    q, k, v = partial_rope(heads(q)), partial_rope(heads(k)), heads(v)
    nb = -(-S // BS)
    pad = nb * BS - S
    padw = ((0, 0), (0, 0), (0, pad), (0, 0))
    q, k, v = jnp.pad(q, padw), jnp.pad(k, padw), jnp.pad(v, padw)
    kb = k.reshape(B, H, nb, BS, Dh)
    vb = v.reshape(B, H, nb, BS, Dh)
    k_mean = jnp.mean(kb.astype(jnp.float32), axis=3)
    topk = min(MOBA_TOPK, nb)
    scale = Dh ** -0.5
    bi = jnp.arange(B)[:, None, None, None]
    hi = jnp.arange(H)[None, :, None, None]

    def chunk(c):
        start = c * QC
        blk = start // BS
        qc = lax.dynamic_slice_in_dim(q, start, QC, axis=2)
        gate = jnp.einsum('bhqd,bhnd->bhqn', qc.astype(jnp.float32), k_mean)
        gate = jnp.where(jnp.arange(nb) < blk, gate, NEG_INF)
        _, idx = lax.top_k(gate, topk)
        sel_valid = jnp.arange(topk) < blk
        k_sel = kb[bi, hi, idx]
        v_sel = vb[bi, hi, idx]
        s_sel = jnp.einsum('bhqd,bhqnkd->bhqnk', qc, k_sel).astype(jnp.float32) * scale
        s_sel = jnp.where(sel_valid[:, None], s_sel, NEG_INF).reshape(B, H, QC, topk * BS)
        k_own = lax.dynamic_index_in_dim(kb, blk, axis=2, keepdims=False)
        v_own = lax.dynamic_index_in_dim(vb, blk, axis=2, keepdims=False)
        s_own = jnp.einsum('bhqd,bhkd->bhqk', qc, k_own).astype(jnp.float32) * scale
        qpos = start + jnp.arange(QC)
        kpos = blk * BS + jnp.arange(BS)
        s_own = jnp.where(kpos[None, :] <= qpos[:, None], s_own, NEG_INF)
        p = jax.nn.softmax(jnp.concatenate([s_sel, s_own], axis=-1), axis=-1).astype(v.dtype)
        o_sel = jnp.einsum('bhqn,bhqnd->bhqd', p[..., :topk * BS],
                           v_sel.reshape(B, H, QC, topk * BS, Dh))
        o_own = jnp.einsum('bhqk,bhkd->bhqd', p[..., topk * BS:], v_own)
        return o_sel + o_own

    o = lax.map(chunk, jnp.arange(nb * BS // QC))
    o = o.transpose(1, 2, 0, 3, 4).reshape(B, H, nb * BS, Dh)[:, :, :S]
    return o.transpose(0, 2, 1, 3).reshape(B, S, MOBA_W)


def retention_branch(q, k, v, g, gn_w, gn_b, cos, sin):
    B, S, _ = q.shape
    H, Dk, Dv, C = RET_HEADS, RET_QK_DIM, RET_V_DIM, RET_CHUNK
    nc = S // C
    f32 = jnp.float32
    q = apply_rope(q.astype(f32).reshape(B, S, H, Dk).transpose(0, 2, 1, 3), cos, sin)
    k = apply_rope(k.astype(f32).reshape(B, S, H, Dk).transpose(0, 2, 1, 3), cos, sin) * (Dk ** -0.5)
    v = v.astype(f32).reshape(B, S, H, Dv).transpose(0, 2, 1, 3)
    log_gamma = jnp.log(1.0 - 2.0 ** (-5.0 - jnp.arange(H, dtype=f32)))
    pos = jnp.arange(C, dtype=f32)
    diff = pos[:, None] - pos[None, :]
    decay_in = jnp.where(diff >= 0, jnp.exp(log_gamma[:, None, None] * diff), 0.0)
    xi = jnp.exp(log_gamma[:, None] * (pos + 1.0))
    zeta = jnp.exp(log_gamma[:, None] * (C - 1.0 - pos))
    gamma_c = jnp.exp(log_gamma * C)[None, :, None, None]
    qc = q.reshape(B, H, nc, C, Dk)
    kc = k.reshape(B, H, nc, C, Dk)
    vc = v.reshape(B, H, nc, C, Dv)
    scores = jnp.einsum('bhnid,bhnjd->bhnij', qc, kc) * decay_in[:, None]
    inner = jnp.einsum('bhnij,bhnje->bhnie', scores, vc)
    kv_chunk = jnp.einsum('bhnjd,bhnje->bhnde', kc * zeta[:, None, :, None], vc)

    def step(R, kv):
        return gamma_c * R + kv, R

    _, R_prev = lax.scan(step, jnp.zeros((B, H, Dk, Dv), f32), kv_chunk.transpose(2, 0, 1, 3, 4))
    R_prev = R_prev.transpose(1, 2, 0, 3, 4)
    cross = jnp.einsum('bhnid,bhnde->bhnie', qc * xi[:, None, :, None], R_prev)
    o = (inner + cross).reshape(B, H, S, Dv)
    mu = jnp.mean(o, axis=-1, keepdims=True)
    var = jnp.mean(jnp.square(o - mu), axis=-1, keepdims=True)
    o = (o - mu) * lax.rsqrt(var + GN_EPS)
    o = o.transpose(0, 2, 1, 3).reshape(B, S, RET_V_W) * gn_w.astype(f32) + gn_b.astype(f32)
    return jax.nn.silu(g) * o.astype(g.dtype)


def hybrid_mixer(h, w_in, mla_q_norm, mla_kv_norm, mla_w_q_up, mla_w_kv_up, ret_gn_w, ret_gn_b,
                 w_branch_mla, w_branch_moba, w_branch_ret, w_out, ropes):
    (cos_mla, sin_mla), (cos_moba, sin_moba), (cos_ret, sin_ret) = ropes
    p = h @ w_in
    (cq, ckv, k_rope, mq, mk, mv, rq, rk, rv, rg, g_mla, g_moba, g_ret) = jnp.split(p, IN_SPLIT_IDX, axis=-1)
    o_mla = mla_branch(cq, ckv, k_rope, mla_q_norm, mla_kv_norm, mla_w_q_up, mla_w_kv_up, cos_mla, sin_mla)
    o_moba = moba_branch(mq, mk, mv, cos_moba, sin_moba)
    o_ret = retention_branch(rq, rk, rv, rg, ret_gn_w, ret_gn_b, cos_ret, sin_ret)
    merged = (jax.nn.sigmoid(g_mla) * (o_mla @ w_branch_mla)
              + jax.nn.sigmoid(g_moba) * (o_moba @ w_branch_moba)
              + jax.nn.sigmoid(g_ret) * (o_ret @ w_branch_ret))
    return merged @ w_out


def squared_relu_mlp(h, w_up, w_down):
    return jnp.square(jax.nn.relu(h @ w_up)) @ w_down


def setup_inputs(seed: int = 0) -> dict:
    key = jax.random.key(seed)
    ks = jax.random.split(key, 18)

    def dense(k, shape):
        return jax.random.normal(k, shape, jnp.float32) * (shape[-2] ** -0.5)

    def gain(k, shape):
        return 1.0 + 0.02 * jax.random.normal(k, shape, jnp.float32)

    L = DEPTH
    return {
        "x": jax.random.normal(ks[0], (BATCH, SEQ, D_MODEL), jnp.float32),
        "attn_norm": gain(ks[1], (L, D_MODEL)),
        "w_in": dense(ks[2], (L, D_MODEL, IN_COLS)),
        "mla_q_norm": gain(ks[3], (L, MLA_Q_RANK)),
        "mla_kv_norm": gain(ks[4], (L, MLA_KV_RANK)),
        "mla_w_q_up": dense(ks[5], (L, MLA_Q_RANK, MLA_HEADS * (MLA_NOPE + MLA_ROPE))),
        "mla_w_kv_up": dense(ks[6], (L, MLA_KV_RANK, MLA_HEADS * (MLA_NOPE + MLA_V))),
        "ret_gn_w": gain(ks[7], (L, RET_V_W)),
        "ret_gn_b": 0.02 * jax.random.normal(ks[8], (L, RET_V_W), jnp.float32),
        "w_branch_mla": dense(ks[9], (L, MLA_OUT_W, D_MODEL)),
        "w_branch_moba": dense(ks[10], (L, MOBA_W, D_MODEL)),
        "w_branch_ret": dense(ks[11], (L, RET_V_W, D_MODEL)),
        "w_out": dense(ks[12], (L, D_MODEL, D_MODEL)),
        "mlp_norm": gain(ks[13], (L, D_MODEL)),
        "w_mlp_up": dense(ks[14], (L, D_MODEL, D_FF)),
        "w_mlp_down": dense(ks[15], (L, D_FF, D_MODEL)),
        "final_norm": gain(ks[16], (D_MODEL,)),
    }


def reference(x, attn_norm, w_in, mla_q_norm, mla_kv_norm, mla_w_q_up, mla_w_kv_up, ret_gn_w, ret_gn_b,
              w_branch_mla, w_branch_moba, w_branch_ret, w_out, mlp_norm, w_mlp_up, w_mlp_down, final_norm):
    S = x.shape[1]
    ropes = (rope_tables(S, MLA_ROPE, ROPE_THETA),
             rope_tables(S, MOBA_HEAD_DIM // PARTIAL_ROPE_DIV, ROPE_THETA),
             rope_tables(S, RET_QK_DIM, RET_THETA))
    for l in range(DEPTH):
        h = rms_norm(x, attn_norm[l])
        x = x + hybrid_mixer(h, w_in[l], mla_q_norm[l], mla_kv_norm[l], mla_w_q_up[l], mla_w_kv_up[l],
                             ret_gn_w[l], ret_gn_b[l], w_branch_mla[l], w_branch_moba[l], w_branch_ret[l],
                             w_out[l], ropes)
        h = rms_norm(x, mlp_norm[l])
        x = x + squared_relu_mlp(h, w_mlp_up[l], w_mlp_down[l])
    return rms_norm(x, final_norm)
```

```cpp
#include <hip/hip_runtime.h>
#include <hip/hip_cooperative_groups.h>
#include <cstdio>
#include <cstdint>
#include <cmath>
namespace cg = cooperative_groups;

#define LAS __attribute__((address_space(3)))
typedef unsigned short bf16_t;
typedef short bf16x8 __attribute__((ext_vector_type(8)));
typedef float f32x4 __attribute__((ext_vector_type(4)));
typedef float f32x16 __attribute__((ext_vector_type(16)));
typedef unsigned u32x4 __attribute__((ext_vector_type(4)));
typedef short s16x4 __attribute__((ext_vector_type(4)));
typedef float f32x2_t __attribute__((ext_vector_type(2)));
typedef __bf16 bf16x2_t __attribute__((ext_vector_type(2)));

__device__ __forceinline__ unsigned pk2(float lo, float hi) { f32x2_t v = {lo, hi}; bf16x2_t b = __builtin_convertvector(v, bf16x2_t); return __builtin_bit_cast(unsigned, b); }
__device__ __forceinline__ u32x4 pack8(f32x4 a, f32x4 b) { return (u32x4){pk2(a[0], a[1]), pk2(a[2], a[3]), pk2(b[0], b[1]), pk2(b[2], b[3])}; }
__device__ __forceinline__ void unpack8(u32x4 w, f32x4& a, f32x4& b) {
    a[0] = __uint_as_float(w.x << 16); a[1] = __uint_as_float(w.x & 0xffff0000u); a[2] = __uint_as_float(w.y << 16); a[3] = __uint_as_float(w.y & 0xffff0000u);
    b[0] = __uint_as_float(w.z << 16); b[1] = __uint_as_float(w.z & 0xffff0000u); b[2] = __uint_as_float(w.w << 16); b[3] = __uint_as_float(w.w & 0xffff0000u);
}
__device__ __forceinline__ int opaque_tid() { int t = threadIdx.x; asm volatile("" : "+v"(t)); return t; }
__device__ __forceinline__ float dot4(f32x4 a) { return (a[0] * a[0] + a[1] * a[1]) + (a[2] * a[2] + a[3] * a[3]); }

constexpr int TT = 16384, SS = 4096, DM = 1024;
constexpr float NEPS = 1e-6f, GNEPS = 1e-5f;
constexpr float LOG2E = 1.4426950408889634f;
constexpr size_t MiB = 1u << 20;
constexpr size_t TAB_CM = 0, TAB_SM = 262144, TAB_CB = 524288, TAB_SB = 655360, TAB_CR = 786432, TAB_SR = 1310720;
constexpr size_t WS_SSQX = 2 * MiB, WS_SSQCQ = 3 * MiB, WS_SSQKV = 3 * MiB + 262144, WS_KMP = 3 * MiB + 524288;
constexpr size_t WS_W = 4 * MiB;
constexpr size_t W_IN = WS_W, W_QU = WS_W + 13 * MiB, W_KVU = WS_W + 13 * MiB + 524288, W_BR = WS_W + 14 * MiB, W_OUT = WS_W + 17 * MiB, W_UP = WS_W + 19 * MiB, W_DN = WS_W + 27 * MiB;
constexpr size_t WS_XB = 39 * MiB;
constexpr size_t A0 = 71 * MiB;
constexpr size_t WS_MQ = A0, WS_MK = A0 + 16 * MiB, WS_MV = A0 + 32 * MiB, WS_RQ = A0 + 48 * MiB, WS_RK = A0 + 56 * MiB, WS_RKV = A0 + 64 * MiB, WS_RV = A0 + 80 * MiB,
                 WS_OM = A0 + 96 * MiB, WS_QM = A0 + 112 * MiB, WS_CQ = A0 + 136 * MiB, WS_KVM = A0 + 144 * MiB, WS_CKV = A0 + 176 * MiB, WS_KPE = A0 + 180 * MiB, WS_END = A0 + 181 * MiB;
constexpr size_t WS_GMLA = WS_QM, WS_GMOBA = WS_MK, WS_GRET = WS_KVM, WS_MB = WS_RQ, WS_HID = A0;
constexpr int LDS_BYTES = 147456;
#ifndef PMASK
#define PMASK 0xffff
#endif
#define PH(k) ((PMASK >> (k)) & 1)

struct Args {
    const float* in[17];
    float* out;
    unsigned char* ws;
    float inv_mla[16], inv_moba[8], inv_ret[32], ret_lg2[4];
};

namespace pg8 {
constexpr int BM = 256, BK = 64, HALF = 128, HTB = HALF * BK * 2, STAGE_BYTES = 8 * HTB, NXCD = 8, WGM = 8;
__host__ __device__ __forceinline__ int lds_byte(int r, int c) { const int st = (r >> 4) * 2 + (c >> 5), rr = r & 15, cc = c & 31, ob = rr * 64 + cc * 2; return st * 1024 + (ob ^ (((ob >> 9) & 1) << 5)); }
__host__ __device__ __forceinline__ void stage_rc(int b, int& R, int& C) { const int st = b / 1024, sb = b % 1024, swz = sb ^ (((sb >> 9) & 1) << 5); R = (st >> 1) * 16 + swz / 64; C = (st & 1) * 32 + (swz % 64) / 2; }
__host__ __device__ __forceinline__ int perm32(int rho) { const int n = rho >> 4, i = rho & 15; return 8 * (i >> 2) + 4 * n + (i & 3); }

struct Unit { int pm, pn, aux; const char* a; const char* b; };
struct Gemm { int lda, ldb, K; };

struct SchedStd {
    const char* A; const char* B; int lda, ldb; int nM, nN, nwg, G, c;
    __device__ void init(const void* A_, const void* B_, int lda_, int ldb_, int nM_, int nN_, int G_, int c_) { A = (const char*)A_; B = (const char*)B_; lda = lda_; ldb = ldb_; nM = nM_; nN = nN_; nwg = nM * nN; G = G_; c = c_; }
    __device__ __forceinline__ bool next(int i, Unit& u) const {
        const long L = (long)i * G + c; if (L >= nwg) return false;
        int wgid = (int)L; { const int q = nwg / NXCD, r = nwg % NXCD, xcd = wgid % NXCD, off = wgid / NXCD; wgid = (xcd < r ? xcd * (q + 1) : r * (q + 1) + (xcd - r) * q) + off; }
        const int nig = WGM * nN, gid = wgid / nig, fm = gid * WGM, gsz = (nM - fm) < WGM ? (nM - fm) : WGM;
        u.pm = fm + ((wgid % nig) % gsz); u.pn = (wgid % nig) / gsz; u.aux = 0;
        u.a = A + (size_t)u.pm * BM * lda * 2; u.b = B + (size_t)u.pn * BM * ldb * 2; return true;
    }
};
struct SchedMerge {
    const char* A0; const char* A1; const char* A2; const char* B; int G, c;
    __device__ __forceinline__ bool next(int i, Unit& u) const {
        const int br = i % 3; const long L = (long)(i / 3) * G + c; if (L >= 256) return false;
        int wgid = (int)L; { const int xcd = wgid % NXCD, off = wgid / NXCD; wgid = xcd * 32 + off; }
        const int nN = 4, nig = WGM * nN, gid = wgid / nig, fm = gid * WGM;
        u.pm = fm + ((wgid % nig) % WGM); u.pn = (wgid % nig) / WGM; u.aux = br;
        const char* Ab = br == 0 ? A0 : (br == 1 ? A1 : A2);
        u.a = Ab + (size_t)u.pm * BM * 512 * 2; u.b = B + ((size_t)br * 1024 + (size_t)u.pn * BM) * 512 * 2; return true;
    }
};

template <class Epi, class Sched>
__device__ __forceinline__ void gemm_phase(LAS unsigned char* lds, const Gemm g, const Sched& S, const Epi& E) {
    const int tid = opaque_tid(), wid = __builtin_amdgcn_readfirstlane(tid >> 6), lane = tid & 63, wr = wid >> 2, wc = wid & 3, fr = lane & 15, fq = lane >> 4;
    int K = g.K; asm volatile("" : "+s"(K)); const int nt = K / BK;
    unsigned voffA[2], voffB[2];
#pragma unroll
    for (int i = 0; i < 2; ++i) { int R, C; stage_rc(tid * 16 + i * 8192, R, C); const int Rb = (R & ~31) + perm32(R & 31);
        voffA[i] = (unsigned)(R * g.lda + C) * 2u; voffB[i] = (unsigned)(Rb * g.ldb + C) * 2u; }
    const size_t kstep = (size_t)(BK * 2);
    const size_t hstepA = (size_t)HALF * g.lda * 2, hstepB = (size_t)HALF * g.ldb * 2;
    const unsigned ldsw = (unsigned)wid * 1024u;
    const int aoff = lds_byte(wr * 64 + fr, fq * 8), boff = lds_byte(wc * 32 + fr, fq * 8);
#define PG8_SA(b, h) (((b) * 2 + (h)) * HTB)
#define PG8_SB(b, h) ((4 + (b) * 2 + (h)) * HTB)
#define PG8_STAGE(bufoff, gbase, voff) do { _Pragma("unroll") for (int _i = 0; _i < 2; ++_i) \
        __builtin_amdgcn_global_load_lds((const unsigned*)((const char*)(gbase) + (voff)[_i]), (LAS unsigned*)(lds + (bufoff) + ldsw + _i * 8192), 16, 0, 0); } while (0)
#define PG8_LDA(dst, b, h) do { _Pragma("unroll") for (int m = 0; m < 4; ++m) _Pragma("unroll") for (int k = 0; k < 2; ++k) dst[m][k] = *(const LAS bf16x8*)(lds + PG8_SA(b, h) + aoff + m * 2048 + k * 1024); } while (0)
#define PG8_LDB(dst, b, h) do { _Pragma("unroll") for (int n = 0; n < 2; ++n) _Pragma("unroll") for (int k = 0; k < 2; ++k) dst[n][k] = *(const LAS bf16x8*)(lds + PG8_SB(b, h) + boff + n * 2048 + k * 1024); } while (0)
#define PG8_MMA(ai, bj, At, Bt) do { __builtin_amdgcn_s_setprio(1); _Pragma("unroll") for (int m = 0; m < 4; ++m) _Pragma("unroll") for (int n = 0; n < 2; ++n) _Pragma("unroll") for (int k = 0; k < 2; ++k) \
        acc[ai][bj][m][n] = __builtin_amdgcn_mfma_f32_16x16x32_bf16(Bt[n][k], At[m][k], acc[ai][bj][m][n], 0, 0, 0); __builtin_amdgcn_s_setprio(0); } while (0)
#define PG8_WAIT_V(n) asm volatile("s_waitcnt vmcnt(" #n ")" ::: "memory")
#define PG8_WAIT_L(n) asm volatile("s_waitcnt lgkmcnt(" #n ")" ::: "memory")
#define PG8_BAR __builtin_amdgcn_s_barrier()
#define PG8_SCHED __builtin_amdgcn_sched_barrier(0)
    Unit cur, nxt; int ui = 0;
    if (!S.next(0, cur)) return;
    f32x4 acc[2][2][4][2];
#pragma unroll
    for (int a = 0; a < 2; ++a)
#pragma unroll
        for (int b = 0; b < 2; ++b)
#pragma unroll
            for (int m = 0; m < 4; ++m)
#pragma unroll
                for (int n = 0; n < 2; ++n) acc[a][b][m][n] = (f32x4){0.f, 0.f, 0.f, 0.f};
    bf16x8 At[4][2], B0[2][2], B1[2][2];
    const char* cA = cur.a; const char* cB = cur.b;
    PG8_STAGE(PG8_SB(0, 0), cB, voffB); PG8_STAGE(PG8_SB(0, 1), cB + hstepB, voffB); PG8_STAGE(PG8_SA(0, 0), cA, voffA); PG8_STAGE(PG8_SA(0, 1), cA + hstepA, voffA);
    if (wr == 1) PG8_BAR;
    PG8_WAIT_V(2); PG8_BAR;
    PG8_STAGE(PG8_SB(1, 0), cB + kstep, voffB); PG8_STAGE(PG8_SA(1, 0), cA + kstep, voffA); PG8_STAGE(PG8_SB(1, 1), cB + hstepB + kstep, voffB);
    PG8_WAIT_V(6); PG8_BAR;
    for (;;) {
        const bool has_next = S.next(ui + 1, nxt);
        const char* nA = has_next ? nxt.a : cA; const char* nB = has_next ? nxt.b : cB;
        for (int t = 0; t < nt; t += 2) {
            const bool last = (t == nt - 2);
            const char* a1 = cA + (size_t)(t + 1) * kstep;
            const char* a2 = last ? nA : cA + (size_t)(t + 2) * kstep; const char* b2 = last ? nB : cB + (size_t)(t + 2) * kstep;
            const char* a3 = a2 + kstep; const char* b3 = b2 + kstep;
            PG8_LDB(B0, 0, 0); PG8_LDB(B1, 0, 1); PG8_SCHED; PG8_LDA(At, 0, 0); PG8_STAGE(PG8_SA(1, 1), a1 + hstepA, voffA);
            PG8_WAIT_V(8); PG8_WAIT_L(0); PG8_BAR; PG8_MMA(0, 0, At, B0); PG8_MMA(0, 1, At, B1); PG8_BAR; PG8_SCHED;
            PG8_LDA(At, 0, 1); PG8_STAGE(PG8_SB(0, 0), b2, voffB); PG8_STAGE(PG8_SB(0, 1), b2 + hstepB, voffB); PG8_STAGE(PG8_SA(0, 0), a2, voffA);
            PG8_WAIT_V(8); PG8_WAIT_L(0); PG8_BAR; PG8_MMA(1, 0, At, B0); PG8_MMA(1, 1, At, B1); PG8_BAR; PG8_SCHED;
            PG8_LDB(B0, 1, 0); PG8_LDB(B1, 1, 1); PG8_SCHED; PG8_LDA(At, 1, 0); PG8_STAGE(PG8_SA(0, 1), a2 + hstepA, voffA);
            PG8_WAIT_V(8); PG8_WAIT_L(0); PG8_BAR; PG8_MMA(0, 0, At, B0); PG8_MMA(0, 1, At, B1); PG8_BAR; PG8_SCHED;
            PG8_LDA(At, 1, 1); PG8_STAGE(PG8_SB(1, 0), b3, voffB); PG8_STAGE(PG8_SB(1, 1), b3 + hstepB, voffB); PG8_STAGE(PG8_SA(1, 0), a3, voffA);
            PG8_WAIT_V(8); PG8_WAIT_L(0); PG8_BAR; PG8_MMA(1, 0, At, B0); PG8_MMA(1, 1, At, B1); PG8_BAR; PG8_SCHED;
        }
        if (wr == 0) PG8_BAR;
        const bool keep = E(acc, cur, wr, wc, fr, fq);
        if (!has_next) break;
        if (!keep) {
#pragma unroll
        for (int a = 0; a < 2; ++a)
#pragma unroll
            for (int b = 0; b < 2; ++b)
#pragma unroll
                for (int m = 0; m < 4; ++m)
#pragma unroll
                    for (int n = 0; n < 2; ++n) acc[a][b][m][n] = (f32x4){0.f, 0.f, 0.f, 0.f};
        }
        cur = nxt; cA = nA; cB = nB; ++ui;
        if (wr == 1) PG8_BAR;
    }
    PG8_WAIT_V(0);
    PG8_BAR;
#undef PG8_SA
#undef PG8_SB
#undef PG8_STAGE
#undef PG8_LDA
#undef PG8_LDB
#undef PG8_MMA
#undef PG8_WAIT_V
#undef PG8_WAIT_L
#undef PG8_BAR
#undef PG8_SCHED
}
}
using pg8::Unit;

__device__ __forceinline__ float ssq16(const float* p) { const f32x4 a = *(const f32x4*)p, b = *(const f32x4*)(p + 4), c = *(const f32x4*)(p + 8), d = *(const f32x4*)(p + 12);
    return ((a[0] + a[1]) + (a[2] + a[3])) + ((b[0] + b[1]) + (b[2] + b[3])) + ((c[0] + c[1]) + (c[2] + c[3])) + ((d[0] + d[1]) + (d[2] + d[3])); }
__device__ __forceinline__ float ssq4(const float* p) { const f32x4 a = *(const f32x4*)p; return (a[0] + a[1]) + (a[2] + a[3]); }
__device__ __forceinline__ void rope8(f32x4& v0, f32x4& v1, const float* ct, const float* st, int pos, int NF, int fb) {
    const f32x4 c = *(const f32x4*)(ct + (size_t)pos * NF + fb), s = *(const f32x4*)(st + (size_t)pos * NF + fb);
    const f32x4 a = v0 * c - v1 * s, b = v0 * s + v1 * c; v0 = a; v1 = b;
}
#define EPI_ROWLOOP _Pragma("unroll") for (int ai = 0; ai < 2; ++ai) _Pragma("unroll") for (int m = 0; m < 4; ++m)
#define EPI_FENCE asm volatile("" ::: "memory")

#define WSP(T, off) ((T*)(ws + (off)))
__device__ __forceinline__ float rstd_x(const unsigned char* ws, int row) { return rsqrtf(ssq16((const float*)(ws + WS_SSQX) + (size_t)row * 16) * (1.f / 1024.f) + NEPS); }
struct EpiP1 {
    unsigned char* ws;
    __device__ __forceinline__ bool operator()(f32x4 (&acc)[2][2][4][2], const Unit& u, int wr, int wc, int fr, int fq) const {
        const int pn = u.pn, row0 = u.pm * 256 + wr * 64 + fr, cl0 = wc * 32 + 8 * fq;
        size_t d0, d1; int l0, l1, c0, c1, md0 = 0, md1 = 0; bool st1 = true; size_t ssqo = 0;
        if (pn == 0) { d0 = d1 = WS_CQ; l0 = l1 = 256; c0 = cl0; c1 = 128 + cl0; ssqo = WS_SSQCQ; }
        else if (pn == 1) { d0 = WS_CKV; l0 = 128; c0 = cl0; d1 = WS_KPE; l1 = 32; c1 = 8 * fq; md1 = 1; st1 = (wc == 0); ssqo = WS_SSQKV; }
        else if (pn < 8) { const int sec = (pn - 2) >> 1; d0 = d1 = WS_MQ + (size_t)sec * (16 * MiB); l0 = l1 = 512; c0 = ((pn - 2) & 1) * 256 + cl0; c1 = c0 + 128; md0 = md1 = (sec < 2) ? 2 : 0; }
        else if (pn < 10) { d0 = d1 = (pn == 8 ? WS_RQ : WS_RK); l0 = l1 = 256; c0 = cl0; c1 = 128 + cl0; md0 = md1 = 3; }
        else { d0 = d1 = WS_RV; l0 = l1 = 512; c0 = (pn - 10) * 256 + cl0; c1 = c0 + 128; }
        const int md = md0 | md1; const int NF = md == 1 ? 16 : (md == 2 ? 8 : 32);
        const float* ct = (const float*)(ws + (md == 1 ? TAB_CM : (md == 2 ? TAB_CB : TAB_CR))); const float* st = (const float*)(ws + (md == 1 ? TAB_SM : (md == 2 ? TAB_SB : TAB_SR)));
        const bool rp0 = md0 == 2 ? ((c0 & 63) < 16) : (md0 != 0), rp1 = md1 == 2 ? ((c1 & 63) < 16) : (md1 != 0);
        const int fb0 = 4 * ((c0 & 63) >> 3), fb1 = 4 * ((c1 & 63) >> 3);
        bf16_t* p0 = (bf16_t*)(ws + d0) + c0; bf16_t* p1 = (bf16_t*)(ws + d1) + c1;
        EPI_ROWLOOP { const int row = row0 + ai * 128 + m * 16; const float rs = rstd_x(ws, row); const int pos = row & (SS - 1);
            f32x4 v0 = acc[ai][0][m][0] * rs, v1 = acc[ai][0][m][1] * rs; float ss = dot4(v0) + dot4(v1);
            if (rp0) rope8(v0, v1, ct, st, pos, NF, fb0);
            *(u32x4*)(p0 + (size_t)row * l0) = pack8(v0, v1);
            v0 = acc[ai][1][m][0] * rs; v1 = acc[ai][1][m][1] * rs; if (pn == 0) ss += dot4(v0) + dot4(v1);
            if (rp1) rope8(v0, v1, ct, st, pos, NF, fb1);
            if (st1) *(u32x4*)(p1 + (size_t)row * l1) = pack8(v0, v1);
            if (ssqo) { ss += __shfl_xor(ss, 16); ss += __shfl_xor(ss, 32); if (fq == 0) ((float*)(ws + ssqo))[(size_t)row * 4 + wc] = ss; }
            EPI_FENCE; }
        return false;
    }
};
struct EpiQU {
    unsigned char* ws;
    __device__ __forceinline__ bool operator()(f32x4 (&acc)[2][2][4][2], const Unit& u, int wr, int wc, int fr, int fq) const {
        const int row0 = u.pm * 256 + wr * 64 + fr, c0 = u.pn * 256 + wc * 32 + 8 * fq;
        EPI_ROWLOOP { const int row = row0 + ai * 128 + m * 16; const float rs = rsqrtf(ssq4(WSP(const float, WS_SSQCQ) + (size_t)row * 4) * (1.f / 256.f) + NEPS);
#pragma unroll
            for (int bj = 0; bj < 2; ++bj) { const int c = c0 + bj * 128, d = c % 96; f32x4 v0 = acc[ai][bj][m][0] * rs, v1 = acc[ai][bj][m][1] * rs;
                if (d >= 64) rope8(v0, v1, WSP(const float, TAB_CM), WSP(const float, TAB_SM), row & (SS - 1), 16, 4 * ((d - 64) >> 3));
                *(u32x4*)(WSP(bf16_t, WS_QM) + (size_t)row * 768 + c) = pack8(v0, v1); }
            EPI_FENCE; }
        return false;
    }
};
struct EpiKVU {
    unsigned char* ws;
    __device__ __forceinline__ bool operator()(f32x4 (&acc)[2][2][4][2], const Unit& u, int wr, int wc, int fr, int fq) const {
        const int row0 = u.pm * 256 + wr * 64 + fr, c0 = u.pn * 256 + wc * 32 + 8 * fq;
        EPI_ROWLOOP { const int row = row0 + ai * 128 + m * 16; const float rs = rsqrtf(ssq4(WSP(const float, WS_SSQKV) + (size_t)row * 4) * (1.f / 128.f) + NEPS);
#pragma unroll
            for (int bj = 0; bj < 2; ++bj) { const int c = c0 + bj * 128; const f32x4 v0 = acc[ai][bj][m][0] * rs, v1 = acc[ai][bj][m][1] * rs;
                *(u32x4*)(WSP(bf16_t, WS_KVM) + (size_t)row * 1024 + c) = pack8(v0, v1); }
            EPI_FENCE; }
        return false;
    }
};
__device__ __forceinline__ float sigm(float v) { return 1.f / (1.f + __expf(-v)); }
struct EpiGate {
    unsigned char* ws;
    __device__ __forceinline__ bool operator()(f32x4 (&acc)[2][2][4][2], const Unit& u, int wr, int wc, int fr, int fq) const {
        const int pn = u.pn, row0 = u.pm * 256 + wr * 64 + fr, cl0 = wc * 32 + 8 * fq;
        if (pn < 12) {
            bf16_t* dst = (pn < 4 ? WSP(bf16_t, WS_GMLA) : (pn < 8 ? WSP(bf16_t, WS_GMOBA) : WSP(bf16_t, WS_GRET))); const int cb0 = (pn & 3) * 256;
            EPI_ROWLOOP { const int row = row0 + ai * 128 + m * 16; const float rs = rstd_x(ws, row);
#pragma unroll
                for (int bj = 0; bj < 2; ++bj) { f32x4 v0 = acc[ai][bj][m][0] * rs, v1 = acc[ai][bj][m][1] * rs;
#pragma unroll
                    for (int j = 0; j < 4; ++j) { v0[j] = fmaxf(sigm(v0[j]), 1e-30f); v1[j] = fmaxf(sigm(v1[j]), 1e-30f); }
                    *(u32x4*)(dst + (size_t)row * 1024 + cb0 + bj * 128 + cl0) = pack8(v0, v1); }
                EPI_FENCE; }
        } else {
            const int cb0 = (pn - 12) * 256;
            EPI_ROWLOOP { const int row = row0 + ai * 128 + m * 16; const float rs = rstd_x(ws, row);
#pragma unroll
                for (int bj = 0; bj < 2; ++bj) { f32x4 v0 = acc[ai][bj][m][0] * rs, v1 = acc[ai][bj][m][1] * rs; bf16_t* p = WSP(bf16_t, WS_RV) + (size_t)row * 512 + cb0 + bj * 128 + cl0;
                    f32x4 o0, o1; unpack8(*(const u32x4*)p, o0, o1);
#pragma unroll
                    for (int j = 0; j < 4; ++j) { v0[j] = v0[j] * sigm(v0[j]) * o0[j]; v1[j] = v1[j] * sigm(v1[j]) * o1[j]; }
                    *(u32x4*)p = pack8(v0, v1); }
                EPI_FENCE; }
        }
        return false;
    }
};
struct EpiMerge {
    unsigned char* ws;
    __device__ __forceinline__ bool operator()(f32x4 (&acc)[2][2][4][2], const Unit& u, int wr, int wc, int fr, int fq) const {
        const int br = u.aux, row0 = u.pm * 256 + wr * 64 + fr, c0 = u.pn * 256 + wc * 32 + 8 * fq;
        const bf16_t* Ga = br == 0 ? WSP(bf16_t, WS_GMLA) : (br == 1 ? WSP(bf16_t, WS_GMOBA) : WSP(bf16_t, WS_GRET)); const bf16_t* Gb = br == 0 ? WSP(bf16_t, WS_GMOBA) : WSP(bf16_t, WS_GRET);
        EPI_ROWLOOP { const int row = row0 + ai * 128 + m * 16;
#pragma unroll
            for (int bj = 0; bj < 2; ++bj) { const size_t off = (size_t)row * 1024 + c0 + bj * 128; f32x4 a0, a1; unpack8(*(const u32x4*)(Ga + off), a0, a1);
                if (br < 2) { f32x4 b0, b1; unpack8(*(const u32x4*)(Gb + off), b0, b1);
#pragma unroll
                    for (int j = 0; j < 4; ++j) { acc[ai][bj][m][0][j] *= a0[j] / b0[j]; acc[ai][bj][m][1][j] *= a1[j] / b1[j]; } }
                else { const f32x4 v0 = acc[ai][bj][m][0] * a0, v1 = acc[ai][bj][m][1] * a1; *(u32x4*)(WSP(bf16_t, WS_MB) + off) = pack8(v0, v1); } }
            EPI_FENCE; }
        return br < 2;
    }
};
struct EpiRes {
    const float* res; float* out; unsigned char* ws;
    __device__ __forceinline__ bool operator()(f32x4 (&acc)[2][2][4][2], const Unit& u, int wr, int wc, int fr, int fq) const {
        const int row0 = u.pm * 256 + wr * 64 + fr, c0 = u.pn * 256 + wc * 32 + 8 * fq;
        EPI_ROWLOOP { const int row = row0 + ai * 128 + m * 16; float ss = 0.f;
#pragma unroll
            for (int bj = 0; bj < 2; ++bj) { const size_t off = (size_t)row * 1024 + c0 + bj * 128;
                const f32x4 v0 = acc[ai][bj][m][0] + *(const f32x4*)(res + off), v1 = acc[ai][bj][m][1] + *(const f32x4*)(res + off + 4);
                *(f32x4*)(out + off) = v0; *(f32x4*)(out + off + 4) = v1; *(u32x4*)(WSP(bf16_t, WS_XB) + off) = pack8(v0, v1); ss += dot4(v0) + dot4(v1); }
            ss += __shfl_xor(ss, 16); ss += __shfl_xor(ss, 32); if (fq == 0) WSP(float, WS_SSQX)[(size_t)row * 16 + u.pn * 4 + wc] = ss;
            EPI_FENCE; }
        return false;
    }
};
struct EpiUp {
    unsigned char* ws;
    __device__ __forceinline__ bool operator()(f32x4 (&acc)[2][2][4][2], const Unit& u, int wr, int wc, int fr, int fq) const {
        const int row0 = u.pm * 256 + wr * 64 + fr, c0 = u.pn * 256 + wc * 32 + 8 * fq;
        EPI_ROWLOOP { const int row = row0 + ai * 128 + m * 16; const float rs = rstd_x(ws, row);
#pragma unroll
            for (int bj = 0; bj < 2; ++bj) { f32x4 v0 = acc[ai][bj][m][0] * rs, v1 = acc[ai][bj][m][1] * rs;
#pragma unroll
                for (int j = 0; j < 4; ++j) { const float a = fmaxf(v0[j], 0.f), b = fmaxf(v1[j], 0.f); v0[j] = a * a; v1[j] = b * b; }
                *(u32x4*)(WSP(bf16_t, WS_HID) + (size_t)row * 4096 + c0 + bj * 128) = pack8(v0, v1); }
            EPI_FENCE; }
        return false;
    }
};

namespace att {
constexpr int KSL = 12288, VSL = 8192;
constexpr int L_K = 0, L_V = 2 * KSL, L_WS = L_V + 2 * VSL, L_OST = L_WS + 2048, L_SEL = L_OST + 32768, L_UM = L_SEL + 1024, L_KM = L_UM + 64, L_END = L_KM + 4096;
constexpr float NEG = -1e30f;
__device__ __forceinline__ int crow(int r, int hi) { return (r & 3) + 8 * (r >> 2) + 4 * hi; }
__device__ __forceinline__ void glds16(const void* gsrc, unsigned lds_dst) { unsigned keep;
    asm volatile("s_mov_b32 %0, m0\n\ts_mov_b32 m0, %2\n\ts_nop 0\n\tglobal_load_lds_dwordx4 %1, off\n\ts_mov_b32 m0, %0" : "=&s"(keep) : "v"(gsrc), "s"(lds_dst) : "memory"); }
__device__ __forceinline__ int nth_block(unsigned um, int bi, int qb) { for (int i = 0; i < bi; ++i) um &= um - 1u; return um ? __builtin_ctz(um) : qb; }
__device__ __forceinline__ void pv(f32x16* o, int vb, bf16x8 pa0, bf16x8 pa1, bf16x8 pa2, bf16x8 pa3) {
#pragma unroll
    for (int d0 = 0; d0 < 2; ++d0) { s16x4 lo[4], hi[4];
#pragma unroll
        for (int ks = 0; ks < 4; ++ks) {
            asm volatile("ds_read_b64_tr_b16 %0,%1 offset:%c2" : "=&v"(lo[ks]) : "v"(vb), "i"(d0 * 4096 + ks * 1024) : "memory");
            asm volatile("ds_read_b64_tr_b16 %0,%1 offset:%c2" : "=&v"(hi[ks]) : "v"(vb), "i"(d0 * 4096 + ks * 1024 + 512) : "memory"); }
        asm volatile("s_waitcnt lgkmcnt(0)" ::: "memory"); __builtin_amdgcn_sched_barrier(0);
#define PK(k) (bf16x8){lo[k][0], lo[k][1], lo[k][2], lo[k][3], hi[k][0], hi[k][1], hi[k][2], hi[k][3]}
        o[d0] = __builtin_amdgcn_mfma_f32_32x32x16_bf16(pa0, PK(0), o[d0], 0, 0, 0);
        o[d0] = __builtin_amdgcn_mfma_f32_32x32x16_bf16(pa1, PK(1), o[d0], 0, 0, 0);
        o[d0] = __builtin_amdgcn_mfma_f32_32x32x16_bf16(pa2, PK(2), o[d0], 0, 0, 0);
        o[d0] = __builtin_amdgcn_mfma_f32_32x32x16_bf16(pa3, PK(3), o[d0], 0, 0, 0);
#undef PK
    }
}
#define ATT_WAITBAR() asm volatile("s_waitcnt vmcnt(0) lgkmcnt(0)\n\ts_barrier" ::: "memory")

template <int DQ, bool ROWSEL>
__device__ __forceinline__ void attn_unit(long rowbase, int qb, const bf16_t* Qh, int ldq, const bf16_t* Kh, int ldk, const bf16_t* Kpe, const bf16_t* Vh, int ldv, bf16_t* Oh, int ldo,
                                          LAS unsigned char* lds, unsigned umask) {
    const int tid = opaque_tid(), lane = tid & 63, r32 = lane & 31, hi = lane >> 5; const int wid = __builtin_amdgcn_readfirstlane(tid >> 6);
    const int q0 = qb * 256;
    const unsigned lds0 = (unsigned)(uintptr_t)lds;
    LAS float* wsf = (LAS float*)(lds + L_WS) + wid * 64;
    umask = (unsigned)__builtin_amdgcn_readfirstlane((int)umask);
    const int npast = __builtin_popcount(umask), NT = 4 * (npast + 1);
#define ATT_ISSUE(key0, slot) do { const long kr_ = rowbase + (key0); \
        glds16(Kh + (kr_ + lane) * ldk + wid * 8, (unsigned)__builtin_amdgcn_readfirstlane((int)(lds0 + L_K + (slot) * KSL + wid * 1024))); \
        if (DQ == 96 && wid < 4) glds16(Kpe + (kr_ + lane) * 32 + wid * 8, (unsigned)__builtin_amdgcn_readfirstlane((int)(lds0 + L_K + (slot) * KSL + (8 + wid) * 1024))); \
        glds16(Vh + (kr_ + 16 * (wid & 3) + (lane >> 2)) * ldv + (wid >> 2) * 32 + (lane & 3) * 8, (unsigned)__builtin_amdgcn_readfirstlane((int)(lds0 + L_V + (slot) * VSL + wid * 1024))); } while (0)
    ATT_ISSUE(nth_block(umask, 0, qb) * 256, 0);
    bf16x8 qr[DQ / 16];
    { const bf16_t* Qw = Qh + (rowbase + q0 + wid * 32 + r32) * ldq + hi * 8;
#pragma unroll
      for (int d0 = 0; d0 < DQ / 16; ++d0) qr[d0] = *(const bf16x8*)(Qw + d0 * 16); }
    unsigned rowsel = 0xffffffffu; if (ROWSEL) rowsel = *(const LAS unsigned*)(lds + L_SEL + (wid * 32 + r32) * 4);
    float m_run = NEG, l_run = 0.f; f32x16 o[2]; o[0] = f32x16{}; o[1] = f32x16{};
    const int qrel = wid * 32 + r32;
    const int vb0 = (int)(lds0 + L_V) + ((lane >> 4) & 1) * 32 + (lane & 3) * 8 + (4 * hi + ((lane & 15) >> 2)) * 64;
    ATT_WAITBAR();
    for (int t = 0; t < NT; ++t) {
        const int s = t & 1, sub = t & 3; const int blk = nth_block(umask, t >> 2, qb);
        if (t + 1 < NT) { const int nb = nth_block(umask, (t + 1) >> 2, qb); ATT_ISSUE(nb * 256 + ((t + 1) & 3) * 64, s ^ 1); }
        f32x16 p0 = f32x16{}, p1 = f32x16{};
        { const LAS unsigned char* kp = lds + L_K + s * KSL + hi * 1024 + r32 * 16;
#pragma unroll
          for (int d0 = 0; d0 < DQ / 16; ++d0) { const bf16x8 b0 = *(const LAS bf16x8*)(kp + d0 * 2048), b1 = *(const LAS bf16x8*)(kp + d0 * 2048 + 512);
              p0 = __builtin_amdgcn_mfma_f32_32x32x16_bf16(b0, qr[d0], p0, 0, 0, 0); p1 = __builtin_amdgcn_mfma_f32_32x32x16_bf16(b1, qr[d0], p1, 0, 0, 0); } }
        if (blk == qb) { const int kb = 64 * sub + 4 * hi;
#pragma unroll
            for (int r = 0; r < 16; ++r) { const int kv = kb + (r & 3) + 8 * (r >> 2); if (kv > qrel) p0[r] = NEG; if (kv + 32 > qrel) p1[r] = NEG; }
        } else if (ROWSEL) { if (!((rowsel >> blk) & 1u)) {
#pragma unroll
            for (int r = 0; r < 16; ++r) { p0[r] = NEG; p1[r] = NEG; } } }
        float rm = fmaxf(p0[0], p1[0]);
#pragma unroll
        for (int r = 1; r < 16; ++r) rm = fmaxf(rm, fmaxf(p0[r], p1[r]));
        { auto rr = __builtin_amdgcn_permlane32_swap(__float_as_uint(rm), __float_as_uint(rm), false, false); rm = fmaxf(__uint_as_float(rr[0]), __uint_as_float(rr[1])); }
        const float mn = fmaxf(m_run, rm), f = __builtin_amdgcn_exp2f(m_run - mn); m_run = mn;
        float ls = 0.f;
#pragma unroll
        for (int r = 0; r < 16; ++r) { p0[r] = __builtin_amdgcn_exp2f(p0[r] - mn); p1[r] = __builtin_amdgcn_exp2f(p1[r] - mn); ls += p0[r] + p1[r]; }
        l_run = l_run * f + ls;
        if (__any(f != 1.f)) { if (hi == 0) wsf[r32] = f; asm volatile("s_waitcnt lgkmcnt(0)" ::: "memory");
#pragma unroll
            for (int r = 0; r < 16; ++r) { const float fr_ = wsf[crow(r, hi)]; o[0][r] *= fr_; o[1][r] *= fr_; }
            asm volatile("s_waitcnt lgkmcnt(0)" ::: "memory"); }
        u32x4 pw0 = (u32x4){pk2(p0[0], p0[1]), pk2(p0[2], p0[3]), pk2(p0[4], p0[5]), pk2(p0[6], p0[7])}, pw1 = (u32x4){pk2(p0[8], p0[9]), pk2(p0[10], p0[11]), pk2(p0[12], p0[13]), pk2(p0[14], p0[15])};
        u32x4 pw2 = (u32x4){pk2(p1[0], p1[1]), pk2(p1[2], p1[3]), pk2(p1[4], p1[5]), pk2(p1[6], p1[7])}, pw3 = (u32x4){pk2(p1[8], p1[9]), pk2(p1[10], p1[11]), pk2(p1[12], p1[13]), pk2(p1[14], p1[15])};
        pv(o, vb0 + s * VSL, __builtin_bit_cast(bf16x8, pw0), __builtin_bit_cast(bf16x8, pw1), __builtin_bit_cast(bf16x8, pw2), __builtin_bit_cast(bf16x8, pw3));
        ATT_WAITBAR();
    }
#undef ATT_ISSUE
    { auto rr = __builtin_amdgcn_permlane32_swap(__float_as_uint(l_run), __float_as_uint(l_run), false, false); l_run = __uint_as_float(rr[0]) + __uint_as_float(rr[1]); }
    if (hi == 0) wsf[32 + r32] = l_run; asm volatile("s_waitcnt lgkmcnt(0)" ::: "memory");
    float rli[16];
#pragma unroll
    for (int r = 0; r < 16; ++r) rli[r] = 1.0f / wsf[32 + crow(r, hi)];
    bf16_t* Ow = Oh + (rowbase + q0 + wid * 32) * ldo;
    { LAS bf16_t* stg = (LAS bf16_t*)(lds + L_OST) + wid * 2048;
#pragma unroll
      for (int r = 0; r < 16; ++r) { const int orow = crow(r, hi);
#pragma unroll
          for (int d0 = 0; d0 < 2; ++d0) stg[orow * 64 + d0 * 32 + r32] = (bf16_t)(pk2(o[d0][r] * rli[r], 0.f) & 0xffffu); }
      asm volatile("s_waitcnt lgkmcnt(0)" ::: "memory");
#pragma unroll
      for (int i = 0; i < 4; ++i) { const int row = i * 8 + (lane >> 3), ch = lane & 7; const u32x4 v = *(const LAS u32x4*)(stg + row * 64 + ch * 8); *(u32x4*)(Ow + (long)row * ldo + ch * 8) = v; } }
    ATT_WAITBAR();
}
}

__device__ __forceinline__ f32x16 mfma32f(float a, float b, f32x16 c) { return __builtin_amdgcn_mfma_f32_32x32x2f32(a, b, c, 0, 0, 0); }
__device__ __forceinline__ float ex2(float x) { return __builtin_amdgcn_exp2f(x); }

__device__ __forceinline__ void ret_kv_unit(int un, const bf16_t* RK, const bf16_t* RV, float* RKV, const float* lg2p, LAS unsigned char* lds) {
    const int tid = opaque_tid(), lane = tid & 63, r32 = lane & 31, hi = lane >> 5, wid = tid >> 6;
    const int bh = un >> 5, n = un & 31, b = bh >> 2, h = bh & 3; const long r0 = (long)b * SS + n * 128; const float lg = lg2p[h];
    LAS float* Kz = (LAS float*)lds; LAS float* Vs = (LAS float*)(lds + 32768);
    { const int row = tid >> 2, cs = (tid & 3) * 16; const float z = ex2(lg * (float)(127 - row)); const bf16_t* p = RK + (r0 + row) * 256 + h * 64 + cs;
      f32x4 a, bq; unpack8(*(const u32x4*)p, a, bq); *(LAS f32x4*)(Kz + row * 64 + cs) = a * z; *(LAS f32x4*)(Kz + row * 64 + cs + 4) = bq * z;
      unpack8(*(const u32x4*)(p + 8), a, bq); *(LAS f32x4*)(Kz + row * 64 + cs + 8) = a * z; *(LAS f32x4*)(Kz + row * 64 + cs + 12) = bq * z;
      const int vs = (tid & 3) * 32; const bf16_t* pv_ = RV + (r0 + row) * 512 + h * 128 + vs;
#pragma unroll
      for (int i = 0; i < 4; ++i) { unpack8(*(const u32x4*)(pv_ + 8 * i), a, bq); *(LAS f32x4*)(Vs + row * 128 + vs + 8 * i) = a; *(LAS f32x4*)(Vs + row * 128 + vs + 8 * i + 4) = bq; } }
    __syncthreads();
    const int dt = wid >> 2, et = wid & 3; f32x16 acc = f32x16{};
#pragma unroll 4
    for (int j0 = 0; j0 < 128; j0 += 2) acc = mfma32f(Kz[(j0 + hi) * 64 + dt * 32 + r32], Vs[(j0 + hi) * 128 + et * 32 + r32], acc);
    float* dst = RKV + (size_t)un * 8192;
#pragma unroll
    for (int r = 0; r < 16; ++r) dst[(dt * 32 + att::crow(r, hi)) * 128 + et * 32 + r32] = acc[r];
    __syncthreads();
}
__device__ __forceinline__ void ret_out_unit(int un, const bf16_t* RQ, const bf16_t* RK, bf16_t* RV, const float* RKV, const float* gnw, const float* gnb, const float* lg2p, LAS unsigned char* lds) {
    const int tid = opaque_tid(), lane = tid & 63, r32 = lane & 31, hi = lane >> 5, wid = tid >> 6;
    const int bh = un >> 5, n = un & 31, b = bh >> 2, h = bh & 3; const long r0 = (long)b * SS + n * 128; const float lg = lg2p[h];
    LAS float* Qs = (LAS float*)lds; LAS float* Ks = (LAS float*)(lds + 33280); LAS float* Rs = (LAS float*)(lds + 66560); LAS float* Sm = (LAS float*)(lds + 66560); LAS float* Vs = (LAS float*)lds;
    { const int row = tid >> 2, cs = (tid & 3) * 16; const bf16_t* pq = RQ + (r0 + row) * 256 + h * 64 + cs; const bf16_t* pk = RK + (r0 + row) * 256 + h * 64 + cs;
      f32x4 a, bq;
#pragma unroll
      for (int i = 0; i < 2; ++i) { unpack8(*(const u32x4*)(pq + 8 * i), a, bq);
#pragma unroll
          for (int j = 0; j < 4; ++j) { Qs[row * 65 + cs + 8 * i + j] = a[j]; Qs[row * 65 + cs + 8 * i + 4 + j] = bq[j]; }
          unpack8(*(const u32x4*)(pk + 8 * i), a, bq);
#pragma unroll
          for (int j = 0; j < 4; ++j) { Ks[row * 65 + cs + 8 * i + j] = a[j]; Ks[row * 65 + cs + 8 * i + 4 + j] = bq[j]; } }
#pragma unroll
      for (int i = 0; i < 4; ++i) { const int e4 = (tid + 512 * i) * 4; f32x4 r = (f32x4){0.f, 0.f, 0.f, 0.f};
          for (int j = 0; j < n; ++j) { const float w = ex2(lg * 128.0f * (float)(n - 1 - j)); r += *(const f32x4*)(RKV + ((size_t)(bh * 32 + j)) * 8192 + e4) * w; }
          *(LAS f32x4*)(Rs + e4) = r; } }
    __syncthreads();
    const int it = wid >> 1, eh = wid & 1; f32x16 acc0 = f32x16{}, acc1 = f32x16{};
#pragma unroll 4
    for (int d0 = 0; d0 < 64; d0 += 2) { const float a = Qs[(32 * it + r32) * 65 + d0 + hi]; acc0 = mfma32f(a, Rs[(d0 + hi) * 128 + 64 * eh + r32], acc0); acc1 = mfma32f(a, Rs[(d0 + hi) * 128 + 64 * eh + 32 + r32], acc1); }
#pragma unroll
    for (int r = 0; r < 16; ++r) { const float xi = ex2(lg * (float)(32 * it + att::crow(r, hi) + 1)); acc0[r] *= xi; acc1[r] *= xi; }
    __syncthreads();
#pragma unroll
    for (int jj = 0; jj < 2; ++jj) { const int jt = 2 * eh + jj; if (jt <= it) { f32x16 s = f32x16{};
#pragma unroll 4
        for (int d0 = 0; d0 < 64; d0 += 2) s = mfma32f(Qs[(32 * it + r32) * 65 + d0 + hi], Ks[(32 * jt + r32) * 65 + d0 + hi], s);
#pragma unroll
        for (int r = 0; r < 16; ++r) { const int i = 32 * it + att::crow(r, hi), j = 32 * jt + r32; Sm[i * 129 + j] = (i >= j) ? s[r] * ex2(lg * (float)(i - j)) : 0.f; } } }
    __syncthreads();
    { const int row = tid >> 2, vs = (tid & 3) * 32; const bf16_t* pv_ = RV + (r0 + row) * 512 + h * 128 + vs; f32x4 a, bq;
#pragma unroll
      for (int i = 0; i < 4; ++i) { unpack8(*(const u32x4*)(pv_ + 8 * i), a, bq); *(LAS f32x4*)(Vs + row * 128 + vs + 8 * i) = a; *(LAS f32x4*)(Vs + row * 128 + vs + 8 * i + 4) = bq; } }
    __syncthreads();
    { const int jend = 32 * (it + 1);
#pragma unroll 4
      for (int j0 = 0; j0 < jend; j0 += 2) { const float a = Sm[(32 * it + r32) * 129 + j0 + hi]; acc0 = mfma32f(a, Vs[(j0 + hi) * 128 + 64 * eh + r32], acc0); acc1 = mfma32f(a, Vs[(j0 + hi) * 128 + 64 * eh + 32 + r32], acc1); } }
    __syncthreads();
#pragma unroll
    for (int r = 0; r < 16; ++r) { const int i = 32 * it + att::crow(r, hi); Sm[i * 129 + 64 * eh + r32] = acc0[r]; Sm[i * 129 + 64 * eh + 32 + r32] = acc1[r]; }
    __syncthreads();
    { const int row = tid >> 2, q4 = tid & 3; float v[32]; float s = 0.f;
#pragma unroll
      for (int k = 0; k < 32; ++k) { v[k] = Sm[row * 129 + q4 * 32 + k]; s += v[k]; }
      s += __shfl_xor(s, 1); s += __shfl_xor(s, 2); const float mu = s * (1.f / 128.f); float q = 0.f;
#pragma unroll
      for (int k = 0; k < 32; ++k) { v[k] -= mu; q += v[k] * v[k]; }
      q += __shfl_xor(q, 1); q += __shfl_xor(q, 2); const float rstd = rsqrtf(q * (1.f / 128.f) + GNEPS);
      const float* gw = gnw + h * 128 + q4 * 32; const float* gb = gnb + h * 128 + q4 * 32; bf16_t* po = RV + (r0 + row) * 512 + h * 128 + q4 * 32;
#pragma unroll
      for (int i = 0; i < 4; ++i) { f32x4 a, bq;
#pragma unroll
          for (int j = 0; j < 4; ++j) { a[j] = v[8 * i + j] * rstd * gw[8 * i + j] + gb[8 * i + j]; bq[j] = v[8 * i + 4 + j] * rstd * gw[8 * i + 4 + j] + gb[8 * i + 4 + j]; }
          *(u32x4*)(po + 8 * i) = pack8(a, bq); } }
    __syncthreads();
}

__device__ __forceinline__ float wave_sum(float v) {
#pragma unroll
    for (int o = 1; o < 64; o <<= 1) v += __shfl_xor(v, o);
    return v;
}
__device__ __forceinline__ void sincos_acc(float ang, float& s, float& c) {
    const double a = (double)ang; const double k = rint(a * 0.63661977236758134308); const double r = a - k * 1.57079632679489661923; const double r2 = r * r;
    const double sr = r * (1.0 + r2 * (-1.0 / 6 + r2 * (1.0 / 120 + r2 * (-1.0 / 5040 + r2 * (1.0 / 362880 + r2 * (-1.0 / 39916800 + r2 * (1.0 / 6227020800.0)))))));
    const double cr = 1.0 + r2 * (-0.5 + r2 * (1.0 / 24 + r2 * (-1.0 / 720 + r2 * (1.0 / 40320 + r2 * (-1.0 / 3628800 + r2 * (1.0 / 479001600.0 - r2 * (1.0 / 87178291200.0)))))));
    const int q = ((int)k) & 3;
    const double sv = (q == 0) ? sr : (q == 1) ? cr : (q == 2) ? -sr : -cr, cv = (q == 0) ? cr : (q == 1) ? -sr : (q == 2) ? -cr : sr;
    s = (float)sv; c = (float)cv;
}
__device__ __forceinline__ int perm_pair(int d, int half) { const int i = d < half ? d : d - half; return 8 * (i >> 2) + (i & 3) + (d < half ? 0 : 4); }

__device__ __forceinline__ void map_row(int kind, int n, int& row, float& sc) {
    const float c2m = 0.125f * LOG2E, c2q = 0.10206207261596575f * LOG2E;
    sc = 1.f; row = n;
    if (kind == 1) {
        if (n < 384) row = n;
        else if (n < 416) row = 384 + perm_pair(n - 384, 16);
        else if (n < 1952) { const int s = n - 416, sec = s >> 9, w = s & 511, hd = w >> 6, d = w & 63; row = 512 + sec * 512 + hd * 64 + ((sec < 2 && d < 16) ? perm_pair(d, 8) : d); if (sec == 0) sc = c2m; }
        else if (n < 2464) { const int s = n - 1952, sec = s >> 8, hd = (s & 255) >> 6, d = s & 63; row = 2048 + sec * 256 + hd * 64 + perm_pair(d, 32); if (sec == 1) sc = 0.125f; }
        else if (n < 2976) row = 2560 + (n - 2464);
        else if (n < 3488) row = 6144 + (n - 2976);
        else row = 3072 + (n - 3488);
    } else if (kind == 2) { const int hd = n / 96, d = n % 96; row = hd * 96 + (d < 64 ? d : 64 + perm_pair(d - 64, 16)); sc = c2q; }
}
__device__ __forceinline__ void tr_item(const float* __restrict__ W, int K, int N, bf16_t* WT, const float* gain, int kind, LAS float* scr, int item, int lane) {
    const int nblk = N / 32, kb = item / nblk, nb = item % nblk, k0 = 64 * kb, n0 = 32 * nb;
#pragma unroll 8
    for (int i = 0; i < 32; ++i) { const int kk = 2 * i + (lane >> 5); scr[kk * 33 + (lane & 31)] = W[(size_t)(k0 + kk) * N + n0 + (lane & 31)]; }
    asm volatile("s_waitcnt lgkmcnt(0)" ::: "memory");
    const int c = lane & 7; f32x4 g0 = (f32x4){1.f, 1.f, 1.f, 1.f}, g1 = g0;
    if (gain) { g0 = *(const f32x4*)(gain + k0 + 8 * c); g1 = *(const f32x4*)(gain + k0 + 8 * c + 4); }
#pragma unroll
    for (int j = 0; j < 4; ++j) { const int n = (lane >> 3) + 8 * j; int row; float sc; map_row(kind, n0 + n, row, sc); const LAS float* s = scr + (8 * c) * 33 + n;
        u32x4 o; o.x = pk2(s[0 * 33] * g0[0] * sc, s[1 * 33] * g0[1] * sc); o.y = pk2(s[2 * 33] * g0[2] * sc, s[3 * 33] * g0[3] * sc); o.z = pk2(s[4 * 33] * g1[0] * sc, s[5 * 33] * g1[1] * sc); o.w = pk2(s[6 * 33] * g1[2] * sc, s[7 * 33] * g1[3] * sc);
        *(u32x4*)(WT + (size_t)row * K + k0 + 8 * c) = o; }
    asm volatile("s_waitcnt lgkmcnt(0)" ::: "memory");
}

__global__ void __launch_bounds__(512) mega_fwd(Args args) {
    extern __shared__ __attribute__((aligned(16))) unsigned char lds_raw[];
    LAS unsigned char* lds = (LAS unsigned char*)lds_raw;
#define PHASE_VARS \
    const __attribute__((address_space(4))) Args* ap = (const __attribute__((address_space(4))) Args*)__builtin_amdgcn_kernarg_segment_ptr(); asm volatile("" : "+s"(ap)); \
    unsigned char* ws = ap->ws; float* out = ap->out; (void)out; (void)ws; \
    int G = (int)gridDim.x, bx = (int)blockIdx.x; asm volatile("" : "+s"(G), "+s"(bx)); \
    const int tid = opaque_tid(), lane = tid & 63, wave = __builtin_amdgcn_readfirstlane(tid >> 6); (void)lane; (void)wave; \
    const int vcu = (G % 8 == 0) ? (bx % 8) * (G / 8) + bx / 8 : bx; const int gw = vcu * 8 + wave, NGW = G * 8; (void)gw; (void)NGW; (void)vcu;
#pragma unroll 1
    for (int l = 0; l < 2; ++l) {
        if (PH(0)) {
            PHASE_VARS
            LAS float* scr = (LAS float*)(lds + wave * 16384);
            constexpr int I_IN = 16 * 205, I_QU = 4 * 24, I_KVU = 2 * 32, I_BR = 8 * 32, I_O = 16 * 32, I_UP = 16 * 128, I_DN = 64 * 32;
            constexpr int NITEMS = I_IN + I_QU + I_KVU + 3 * I_BR + I_O + I_UP + I_DN;
            for (int it = gw; it < NITEMS; it += NGW) {
                int r = it;
                if (r < I_IN) { tr_item(ap->in[2] + (size_t)l * 1024 * 6560, 1024, 6560, (bf16_t*)(ws + W_IN), ap->in[1] + l * 1024, 1, scr, r, lane); continue; } r -= I_IN;
                if (r < I_QU) { tr_item(ap->in[5] + (size_t)l * 256 * 768, 256, 768, (bf16_t*)(ws + W_QU), ap->in[3] + l * 256, 2, scr, r, lane); continue; } r -= I_QU;
                if (r < I_KVU) { tr_item(ap->in[6] + (size_t)l * 128 * 1024, 128, 1024, (bf16_t*)(ws + W_KVU), ap->in[4] + l * 128, 0, scr, r, lane); continue; } r -= I_KVU;
                if (r < 3 * I_BR) { const int br = r / I_BR; tr_item(ap->in[9 + br] + (size_t)l * 512 * 1024, 512, 1024, (bf16_t*)(ws + W_BR) + (size_t)br * 1024 * 512, nullptr, 0, scr, r - br * I_BR, lane); continue; } r -= 3 * I_BR;
                if (r < I_O) { tr_item(ap->in[12] + (size_t)l * 1024 * 1024, 1024, 1024, (bf16_t*)(ws + W_OUT), nullptr, 0, scr, r, lane); continue; } r -= I_O;
                if (r < I_UP) { tr_item(ap->in[14] + (size_t)l * 1024 * 4096, 1024, 4096, (bf16_t*)(ws + W_UP), ap->in[13] + l * 1024, 0, scr, r, lane); continue; } r -= I_UP;
                tr_item(ap->in[15] + (size_t)l * 4096 * 1024, 4096, 1024, (bf16_t*)(ws + W_DN), nullptr, 0, scr, r, lane);
            }
            if (l == 0) {
                for (int idx = (vcu * 512 + tid); idx < SS * 56; idx += G * 512) { const int pos = idx / 56, f = idx % 56; float s, c;
                    if (f < 16) { sincos_acc((float)pos * ap->inv_mla[f], s, c); ((float*)(ws + TAB_CM))[pos * 16 + f] = c; ((float*)(ws + TAB_SM))[pos * 16 + f] = s; }
                    else if (f < 24) { sincos_acc((float)pos * ap->inv_moba[f - 16], s, c); ((float*)(ws + TAB_CB))[pos * 8 + f - 16] = c; ((float*)(ws + TAB_SB))[pos * 8 + f - 16] = s; }
                    else { sincos_acc((float)pos * ap->inv_ret[f - 24], s, c); ((float*)(ws + TAB_CR))[pos * 32 + f - 24] = c; ((float*)(ws + TAB_SR))[pos * 32 + f - 24] = s; } }
                const float* x = ap->in[0]; bf16_t* XB = WSP(bf16_t, WS_XB); float* SSQ_X = WSP(float, WS_SSQX);
                for (int m = gw; m < TT; m += NGW) { const f32x4* xr = (const f32x4*)(x + (size_t)m * DM) + lane; f32x4 v[4]; float s = 0.f;
#pragma unroll
                    for (int j = 0; j < 4; ++j) { v[j] = xr[64 * j]; s += dot4(v[j]); }
                    s = wave_sum(s);
                    unsigned long long* o8 = (unsigned long long*)(XB + (size_t)m * DM) + lane;
#pragma unroll
                    for (int j = 0; j < 4; ++j) o8[64 * j] = (unsigned long long)pk2(v[j][0], v[j][1]) | ((unsigned long long)pk2(v[j][2], v[j][3]) << 32);
                    if (lane < 16) SSQ_X[(size_t)m * 16 + lane] = lane == 0 ? s : 0.f; }
            }
        }
        cg::this_grid().sync();
        if (PH(1)) { PHASE_VARS pg8::Gemm g{1024, 1024, 1024}; pg8::SchedStd S; S.init(ws + WS_XB, ws + W_IN, 1024, 1024, 64, 12, G, bx);
          EpiP1 E{ws}; pg8::gemm_phase(lds, g, S, E); }
        cg::this_grid().sync();
        if (PH(2)) { PHASE_VARS pg8::Gemm g{256, 256, 256}; pg8::SchedStd S; S.init(ws + WS_CQ, ws + W_QU, 256, 256, 64, 3, G, bx); EpiQU E{ws}; pg8::gemm_phase(lds, g, S, E); }
        if (PH(3)) { PHASE_VARS pg8::Gemm g{128, 128, 128}; pg8::SchedStd S; S.init(ws + WS_CKV, ws + W_KVU, 128, 128, 64, 4, G, bx); EpiKVU E{ws}; pg8::gemm_phase(lds, g, S, E); }
        __syncthreads();
        if (PH(4)) { PHASE_VARS
          for (int un = vcu; un < 256; un += G) {
            const int bq = un >> 2, qtr = un & 3, b = bq >> 4, blk = bq & 15; const bf16_t* p = WSP(bf16_t, WS_MK) + ((size_t)b * SS + blk * 256 + qtr * 64) * 512 + tid; float s = 0.f;
#pragma unroll 8
            for (int j = 0; j < 64; ++j) s += __uint_as_float((unsigned)p[(size_t)j * 512] << 16);
            WSP(float, WS_KMP)[(size_t)un * 512 + tid] = s; } }
        if (PH(5)) { PHASE_VARS for (int un = vcu; un < 512; un += G) ret_kv_unit(un, WSP(bf16_t, WS_RK), WSP(bf16_t, WS_RV), WSP(float, WS_RKV), (const float*)ap->ret_lg2, lds); }
        cg::this_grid().sync();
        if (PH(6)) { PHASE_VARS
          for (int un = vcu; un < 512; un += G) {
            const int bh = (un & 255) >> 3, qb = un < 256 ? (un & 7) : 15 - (un & 7), b = bh >> 3, h = bh & 7;
            att::attn_unit<96, false>((long)b * SS, qb, WSP(bf16_t, WS_QM) + h * 96, 768, WSP(bf16_t, WS_KVM) + h * 128, 1024, WSP(bf16_t, WS_KPE), WSP(bf16_t, WS_KVM) + h * 128 + 64, 1024, WSP(bf16_t, WS_OM) + h * 64, 512, lds, (1u << qb) - 1u);
          } }
        if (PH(7)) { PHASE_VARS
          for (int un = vcu; un < 512; un += G) {
            const int bh = (un & 255) >> 3, qb = un < 256 ? (un & 7) : 15 - (un & 7), b = bh >> 3, h = bh & 7;
            LAS float* km = (LAS float*)(lds + att::L_KM); LAS unsigned* selp = (LAS unsigned*)(lds + att::L_SEL); LAS unsigned* ump = (LAS unsigned*)(lds + att::L_UM);
            bf16_t* MQ = WSP(bf16_t, WS_MQ);
            if (tid == 0) *ump = 0u;
            for (int e = tid; e < 1024; e += 512) { const int n = e >> 6, d = e & 63; float s = 0.f;
                if (n < qb) { const float* p = WSP(float, WS_KMP) + ((size_t)(b * 16 + n) * 4) * 512 + h * 64 + d; s = (p[0] + p[512]) + (p[1024] + p[1536]); }
                km[e] = s * (1.f / 256.f); }
            __syncthreads();
            if (tid < 256) { const bf16_t* qp = MQ + ((size_t)b * SS + qb * 256 + tid) * 512 + h * 64; float q[64];
#pragma unroll
                for (int i = 0; i < 8; ++i) { f32x4 a, bq; unpack8(*(const u32x4*)(qp + 8 * i), a, bq);
#pragma unroll
                    for (int j = 0; j < 4; ++j) { q[8 * i + j] = a[j]; q[8 * i + 4 + j] = bq[j]; } }
                float v1 = -INFINITY, v2 = -INFINITY, v3 = -INFINITY; int i1 = 0, i2 = 0, i3 = 0;
                for (int n = 0; n < qb; ++n) { float gsum = 0.f;
#pragma unroll
                    for (int d = 0; d < 64; ++d) gsum += q[d] * km[n * 64 + d];
                    if (gsum > v1) { v3 = v2; i3 = i2; v2 = v1; i2 = i1; v1 = gsum; i1 = n; } else if (gsum > v2) { v3 = v2; i3 = i2; v2 = gsum; i2 = n; } else if (gsum > v3) { v3 = gsum; i3 = n; } }
                unsigned sel = qb <= 3 ? ((1u << qb) - 1u) : ((1u << i1) | (1u << i2) | (1u << i3));
                selp[tid] = sel;
                unsigned um = sel;
#pragma unroll
                for (int o = 1; o < 64; o <<= 1) um |= (unsigned)__shfl_xor((int)um, o);
                if (lane == 0) atomicOr((unsigned*)ump, um); }
            __syncthreads();
            const unsigned umask = *ump;
            att::attn_unit<64, true>((long)b * SS, qb, MQ + h * 64, 512, WSP(bf16_t, WS_MK) + h * 64, 512, nullptr, WSP(bf16_t, WS_MV) + h * 64, 512, MQ + h * 64, 512, lds, umask);
          } }
        if (PH(8)) { PHASE_VARS for (int un = vcu; un < 512; un += G) ret_out_unit(un, WSP(bf16_t, WS_RQ), WSP(bf16_t, WS_RK), WSP(bf16_t, WS_RV), WSP(float, WS_RKV), ap->in[7] + l * 512, ap->in[8] + l * 512, (const float*)ap->ret_lg2, lds); }
        cg::this_grid().sync();
        if (PH(9)) { PHASE_VARS pg8::Gemm g{1024, 1024, 1024}; pg8::SchedStd S; S.init(ws + WS_XB, ws + W_IN + (size_t)3072 * 1024 * 2, 1024, 1024, 64, 14, G, bx);
          EpiGate E{ws}; pg8::gemm_phase(lds, g, S, E); }
        cg::this_grid().sync();
        if (PH(10)) { PHASE_VARS pg8::Gemm g{512, 512, 512}; pg8::SchedMerge S{(const char*)(ws + WS_OM), (const char*)(ws + WS_MQ), (const char*)(ws + WS_RV), (const char*)(ws + W_BR), G, bx};
          EpiMerge E{ws}; pg8::gemm_phase(lds, g, S, E); }
        cg::this_grid().sync();
        if (PH(11)) { PHASE_VARS pg8::Gemm g{1024, 1024, 1024}; pg8::SchedStd S; S.init(ws + WS_MB, ws + W_OUT, 1024, 1024, 64, 4, G, bx);
          EpiRes E{l == 0 ? ap->in[0] : (const float*)out, out, ws}; pg8::gemm_phase(lds, g, S, E); }
        cg::this_grid().sync();
        if (PH(12)) { PHASE_VARS pg8::Gemm g{1024, 1024, 1024}; pg8::SchedStd S; S.init(ws + WS_XB, ws + W_UP, 1024, 1024, 64, 16, G, bx); EpiUp E{ws}; pg8::gemm_phase(lds, g, S, E); }
        cg::this_grid().sync();
        if (PH(13)) { PHASE_VARS pg8::Gemm g{4096, 4096, 4096}; pg8::SchedStd S; S.init(ws + WS_HID, ws + W_DN, 4096, 4096, 64, 4, G, bx); EpiRes E{(const float*)out, out, ws}; pg8::gemm_phase(lds, g, S, E); }
        cg::this_grid().sync();
    }
    { PHASE_VARS const float* fn = ap->in[16];
      for (int m = gw; m < TT; m += NGW) { f32x4* xr = (f32x4*)(out + (size_t)m * DM) + lane; f32x4 v[4]; float s = 0.f;
#pragma unroll
          for (int j = 0; j < 4; ++j) { v[j] = xr[64 * j]; s += dot4(v[j]); }
          s = wave_sum(s); const float rs = rsqrtf(s * (1.f / 1024.f) + NEPS);
#pragma unroll
          for (int j = 0; j < 4; ++j) { const f32x4 gsc = *((const f32x4*)fn + lane + 64 * j); xr[64 * j] = v[j] * rs * gsc; } } }
}

extern "C" void kernel_launch(void* const* d_in, const int* in_sizes, int n_in, void* d_out, int out_size, void* d_ws, size_t ws_size, hipStream_t stream) {
    static int grid = 0;
    if (grid == 0) {
        if (n_in != 17 || out_size != TT * DM || ws_size < WS_END) { fprintf(stderr, "kernel_launch: unexpected shapes (n_in %d out %d ws %zu)\n", n_in, out_size, ws_size); grid = -1; return; }
        int dev = 0, cus = 0, per_cu = 0;
        hipGetDevice(&dev); hipDeviceGetAttribute(&cus, hipDeviceAttributeMultiprocessorCount, dev);
        hipFuncSetAttribute((const void*)mega_fwd, hipFuncAttributeMaxDynamicSharedMemorySize, LDS_BYTES);
        hipOccupancyMaxActiveBlocksPerMultiprocessor(&per_cu, (const void*)mega_fwd, 512, LDS_BYTES);
        if (per_cu < 1) per_cu = 1;
        grid = cus * per_cu;
        (void)hipGetLastError();
    }
    if (grid < 0) return;
    Args a{};
    for (int i = 0; i < 17; ++i) a.in[i] = (const float*)d_in[i];
    a.out = (float*)d_out; a.ws = (unsigned char*)d_ws;
    for (int i = 0; i < 16; ++i) a.inv_mla[i] = 1.0f / powf(500000.0f, (float)(2 * i) / 32.0f);
    for (int i = 0; i < 8; ++i) a.inv_moba[i] = 1.0f / powf(500000.0f, (float)(2 * i) / 16.0f);
    for (int i = 0; i < 32; ++i) a.inv_ret[i] = 1.0f / powf(10000.0f, (float)(2 * i) / 64.0f);
    for (int i = 0; i < 4; ++i) a.ret_lg2[i] = (float)log2(1.0 - pow(2.0, -5.0 - (double)i));
    void* kargs[] = {&a};
    hipError_t e = hipLaunchCooperativeKernel((const void*)mega_fwd, dim3(grid), dim3(512), kargs, LDS_BYTES, stream);
    if (e != hipSuccess) fprintf(stderr, "cooperative launch failed: %s (grid %d)\n", hipGetErrorString(e), grid);
}
```

```cpp
#include <hip/hip_runtime.h>
#include <hip/hip_cooperative_groups.h>
#include <cstdio>
#include <cstdint>
#include <cmath>
namespace cg = cooperative_groups;

#define LAS __attribute__((address_space(3)))
typedef unsigned short bf16_t;
typedef short bf16x8 __attribute__((ext_vector_type(8)));
typedef float f32x4 __attribute__((ext_vector_type(4)));
typedef float f32x16 __attribute__((ext_vector_type(16)));
typedef unsigned u32x4 __attribute__((ext_vector_type(4)));
typedef short s16x4 __attribute__((ext_vector_type(4)));
typedef float f32x2_t __attribute__((ext_vector_type(2)));
typedef __bf16 bf16x2_t __attribute__((ext_vector_type(2)));

__device__ __forceinline__ unsigned pk2(float lo, float hi) { f32x2_t v = {lo, hi}; bf16x2_t b = __builtin_convertvector(v, bf16x2_t); return __builtin_bit_cast(unsigned, b); }
__device__ __forceinline__ u32x4 pack8(f32x4 a, f32x4 b) { return (u32x4){pk2(a[0], a[1]), pk2(a[2], a[3]), pk2(b[0], b[1]), pk2(b[2], b[3])}; }
__device__ __forceinline__ void unpack8(u32x4 w, f32x4& a, f32x4& b) {
    a[0] = __uint_as_float(w.x << 16); a[1] = __uint_as_float(w.x & 0xffff0000u); a[2] = __uint_as_float(w.y << 16); a[3] = __uint_as_float(w.y & 0xffff0000u);
    b[0] = __uint_as_float(w.z << 16); b[1] = __uint_as_float(w.z & 0xffff0000u); b[2] = __uint_as_float(w.w << 16); b[3] = __uint_as_float(w.w & 0xffff0000u);
}
__device__ __forceinline__ int opaque_tid() { int t = threadIdx.x; asm volatile("" : "+v"(t)); return t; }
__device__ __forceinline__ float dot4(f32x4 a) { return (a[0] * a[0] + a[1] * a[1]) + (a[2] * a[2] + a[3] * a[3]); }

constexpr int TT = 16384, SS = 4096, DM = 1024;
constexpr float NEPS = 1e-6f, GNEPS = 1e-5f;
constexpr float LOG2E = 1.4426950408889634f;
constexpr size_t MiB = 1u << 20;
constexpr size_t TAB_CM = 0, TAB_SM = 262144, TAB_CB = 524288, TAB_SB = 655360, TAB_CR = 786432, TAB_SR = 1310720;
constexpr size_t WS_SSQX = 2 * MiB, WS_SSQCQ = 3 * MiB, WS_SSQKV = 3 * MiB + 262144, WS_KMP = 3 * MiB + 524288;
constexpr size_t WS_W = 4 * MiB;
constexpr size_t W_IN = WS_W, W_QU = WS_W + 13 * MiB, W_KVU = WS_W + 13 * MiB + 524288, W_BR = WS_W + 14 * MiB, W_OUT = WS_W + 17 * MiB, W_UP = WS_W + 19 * MiB, W_DN = WS_W + 27 * MiB;
constexpr size_t WS_XB = 39 * MiB;
constexpr size_t A0 = 71 * MiB;
constexpr size_t WS_MQ = A0, WS_MK = A0 + 16 * MiB, WS_MV = A0 + 32 * MiB, WS_RQ = A0 + 48 * MiB, WS_RK = A0 + 56 * MiB, WS_RKV = A0 + 64 * MiB, WS_RV = A0 + 80 * MiB,
                 WS_OM = A0 + 96 * MiB, WS_QM = A0 + 112 * MiB, WS_CQ = A0 + 136 * MiB, WS_KVM = A0 + 144 * MiB, WS_CKV = A0 + 176 * MiB, WS_KPE = A0 + 180 * MiB, WS_END = A0 + 181 * MiB;
constexpr size_t WS_GMLA = WS_QM, WS_GMOBA = WS_MK, WS_GRET = WS_KVM, WS_MB = WS_RQ, WS_HID = A0;
constexpr int LDS_BYTES = 147456;
#ifndef PMASK
#define PMASK 0xffff
#endif
#define PH(k) ((PMASK >> (k)) & 1)

struct Args {
    const float* in[17];
    float* out;
    unsigned char* ws;
    float inv_mla[16], inv_moba[8], inv_ret[32], ret_lg2[4];
};

namespace pg8 {
constexpr int BM = 256, BK = 64, HALF = 128, HTB = HALF * BK * 2, STAGE_BYTES = 8 * HTB, NXCD = 8, WGM = 8;
__host__ __device__ __forceinline__ int lds_byte(int r, int c) { const int st = (r >> 4) * 2 + (c >> 5), rr = r & 15, cc = c & 31, ob = rr * 64 + cc * 2; return st * 1024 + (ob ^ (((ob >> 9) & 1) << 5)); }
__host__ __device__ __forceinline__ void stage_rc(int b, int& R, int& C) { const int st = b / 1024, sb = b % 1024, swz = sb ^ (((sb >> 9) & 1) << 5); R = (st >> 1) * 16 + swz / 64; C = (st & 1) * 32 + (swz % 64) / 2; }
__host__ __device__ __forceinline__ int perm32(int rho) { const int n = rho >> 4, i = rho & 15; return 8 * (i >> 2) + 4 * n + (i & 3); }

struct Unit { int pm, pn, aux; const char* a; const char* b; };
struct Gemm { int lda, ldb, K; };

struct SchedStd {
    const char* A; const char* B; int lda, ldb; int nM, nN, nwg, G, c;
    __device__ void init(const void* A_, const void* B_, int lda_, int ldb_, int nM_, int nN_, int G_, int c_) { A = (const char*)A_; B = (const char*)B_; lda = lda_; ldb = ldb_; nM = nM_; nN = nN_; nwg = nM * nN; G = G_; c = c_; }
    __device__ __forceinline__ bool next(int i, Unit& u) const {
        const long L = (long)i * G + c; if (L >= nwg) return false;
        int wgid = (int)L; { const int q = nwg / NXCD, r = nwg % NXCD, xcd = wgid % NXCD, off = wgid / NXCD; wgid = (xcd < r ? xcd * (q + 1) : r * (q + 1) + (xcd - r) * q) + off; }
        const int nig = WGM * nN, gid = wgid / nig, fm = gid * WGM, gsz = (nM - fm) < WGM ? (nM - fm) : WGM;
        u.pm = fm + ((wgid % nig) % gsz); u.pn = (wgid % nig) / gsz; u.aux = 0;
        u.a = A + (size_t)u.pm * BM * lda * 2; u.b = B + (size_t)u.pn * BM * ldb * 2; return true;
    }
};
struct SchedMerge {
    const char* A0; const char* A1; const char* A2; const char* B; int G, c;
    __device__ __forceinline__ bool next(int i, Unit& u) const {
        const int br = i % 3; const long L = (long)(i / 3) * G + c; if (L >= 256) return false;
        int wgid = (int)L; { const int xcd = wgid % NXCD, off = wgid / NXCD; wgid = xcd * 32 + off; }
        const int nN = 4, nig = WGM * nN, gid = wgid / nig, fm = gid * WGM;
        u.pm = fm + ((wgid % nig) % WGM); u.pn = (wgid % nig) / WGM; u.aux = br;
        const char* Ab = br == 0 ? A0 : (br == 1 ? A1 : A2);
        u.a = Ab + (size_t)u.pm * BM * 512 * 2; u.b = B + ((size_t)br * 1024 + (size_t)u.pn * BM) * 512 * 2; return true;
    }
};

template <class Epi, class Sched>
__device__ __forceinline__ void gemm_phase(LAS unsigned char* lds, const Gemm g, const Sched& S, const Epi& E) {
    const int tid = opaque_tid(), wid = __builtin_amdgcn_readfirstlane(tid >> 6), lane = tid & 63, wr = wid >> 2, wc = wid & 3, fr = lane & 15, fq = lane >> 4;
    int K = g.K; asm volatile("" : "+s"(K)); const int nt = K / BK;
    unsigned voffA[2], voffB[2];
#pragma unroll
    for (int i = 0; i < 2; ++i) { int R, C; stage_rc(tid * 16 + i * 8192, R, C); const int Rb = (R & ~31) + perm32(R & 31);
        voffA[i] = (unsigned)(R * g.lda + C) * 2u; voffB[i] = (unsigned)(Rb * g.ldb + C) * 2u; }
    const size_t kstep = (size_t)(BK * 2);
    const size_t hstepA = (size_t)HALF * g.lda * 2, hstepB = (size_t)HALF * g.ldb * 2;
    const unsigned ldsw = (unsigned)wid * 1024u;
    const int aoff = lds_byte(wr * 64 + fr, fq * 8), boff = lds_byte(wc * 32 + fr, fq * 8);
#define PG8_SA(b, h) (((b) * 2 + (h)) * HTB)
#define PG8_SB(b, h) ((4 + (b) * 2 + (h)) * HTB)
#define PG8_STAGE(bufoff, gbase, voff) do { _Pragma("unroll") for (int _i = 0; _i < 2; ++_i) \
        __builtin_amdgcn_global_load_lds((const unsigned*)((const char*)(gbase) + (voff)[_i]), (LAS unsigned*)(lds + (bufoff) + ldsw + _i * 8192), 16, 0, 0); } while (0)
#define PG8_LDA(dst, b, h) do { _Pragma("unroll") for (int m = 0; m < 4; ++m) _Pragma("unroll") for (int k = 0; k < 2; ++k) dst[m][k] = *(const LAS bf16x8*)(lds + PG8_SA(b, h) + aoff + m * 2048 + k * 1024); } while (0)
#define PG8_LDB(dst, b, h) do { _Pragma("unroll") for (int n = 0; n < 2; ++n) _Pragma("unroll") for (int k = 0; k < 2; ++k) dst[n][k] = *(const LAS bf16x8*)(lds + PG8_SB(b, h) + boff + n * 2048 + k * 1024); } while (0)
#define PG8_MMA(ai, bj, At, Bt) do { __builtin_amdgcn_s_setprio(1); _Pragma("unroll") for (int m = 0; m < 4; ++m) _Pragma("unroll") for (int n = 0; n < 2; ++n) _Pragma("unroll") for (int k = 0; k < 2; ++k) \
        acc[ai][bj][m][n] = __builtin_amdgcn_mfma_f32_16x16x32_bf16(Bt[n][k], At[m][k], acc[ai][bj][m][n], 0, 0, 0); __builtin_amdgcn_s_setprio(0); } while (0)
#define PG8_WAIT_V(n) asm volatile("s_waitcnt vmcnt(" #n ")" ::: "memory")
#define PG8_WAIT_L(n) asm volatile("s_waitcnt lgkmcnt(" #n ")" ::: "memory")
#define PG8_BAR __builtin_amdgcn_s_barrier()
#define PG8_SCHED __builtin_amdgcn_sched_barrier(0)
    Unit cur, nxt; int ui = 0;
    if (!S.next(0, cur)) return;
    f32x4 acc[2][2][4][2];
#pragma unroll
    for (int a = 0; a < 2; ++a)
#pragma unroll
        for (int b = 0; b < 2; ++b)
#pragma unroll
            for (int m = 0; m < 4; ++m)
#pragma unroll
                for (int n = 0; n < 2; ++n) acc[a][b][m][n] = (f32x4){0.f, 0.f, 0.f, 0.f};
    bf16x8 At[4][2], B0[2][2], B1[2][2];
    const char* cA = cur.a; const char* cB = cur.b;
    PG8_STAGE(PG8_SB(0, 0), cB, voffB); PG8_STAGE(PG8_SB(0, 1), cB + hstepB, voffB); PG8_STAGE(PG8_SA(0, 0), cA, voffA); PG8_STAGE(PG8_SA(0, 1), cA + hstepA, voffA);
    if (wr == 1) PG8_BAR;
    PG8_WAIT_V(2); PG8_BAR;
    PG8_STAGE(PG8_SB(1, 0), cB + kstep, voffB); PG8_STAGE(PG8_SA(1, 0), cA + kstep, voffA); PG8_STAGE(PG8_SB(1, 1), cB + hstepB + kstep, voffB);
    PG8_WAIT_V(6); PG8_BAR;
    for (;;) {
        const bool has_next = S.next(ui + 1, nxt);
        const char* nA = has_next ? nxt.a : cA; const char* nB = has_next ? nxt.b : cB;
        for (int t = 0; t < nt; t += 2) {
            const bool last = (t == nt - 2);
            const char* a1 = cA + (size_t)(t + 1) * kstep;
            const char* a2 = last ? nA : cA + (size_t)(t + 2) * kstep; const char* b2 = last ? nB : cB + (size_t)(t + 2) * kstep;
            const char* a3 = a2 + kstep; const char* b3 = b2 + kstep;
            PG8_LDB(B0, 0, 0); PG8_LDB(B1, 0, 1); PG8_SCHED; PG8_LDA(At, 0, 0); PG8_STAGE(PG8_SA(1, 1), a1 + hstepA, voffA);
            PG8_WAIT_V(8); PG8_WAIT_L(0); PG8_BAR; PG8_MMA(0, 0, At, B0); PG8_MMA(0, 1, At, B1); PG8_BAR; PG8_SCHED;
            PG8_LDA(At, 0, 1); PG8_STAGE(PG8_SB(0, 0), b2, voffB); PG8_STAGE(PG8_SB(0, 1), b2 + hstepB, voffB); PG8_STAGE(PG8_SA(0, 0), a2, voffA);
            PG8_WAIT_V(8); PG8_WAIT_L(0); PG8_BAR; PG8_MMA(1, 0, At, B0); PG8_MMA(1, 1, At, B1); PG8_BAR; PG8_SCHED;
            PG8_LDB(B0, 1, 0); PG8_LDB(B1, 1, 1); PG8_SCHED; PG8_LDA(At, 1, 0); PG8_STAGE(PG8_SA(0, 1), a2 + hstepA, voffA);
            PG8_WAIT_V(8); PG8_WAIT_L(0); PG8_BAR; PG8_MMA(0, 0, At, B0); PG8_MMA(0, 1, At, B1); PG8_BAR; PG8_SCHED;
            PG8_LDA(At, 1, 1); PG8_STAGE(PG8_SB(1, 0), b3, voffB); PG8_STAGE(PG8_SB(1, 1), b3 + hstepB, voffB); PG8_STAGE(PG8_SA(1, 0), a3, voffA);
            PG8_WAIT_V(8); PG8_WAIT_L(0); PG8_BAR; PG8_MMA(1, 0, At, B0); PG8_MMA(1, 1, At, B1); PG8_BAR; PG8_SCHED;
        }
        if (wr == 0) PG8_BAR;
        const bool keep = E(acc, cur, wr, wc, fr, fq);
        if (!has_next) break;
        if (!keep) {
#pragma unroll
        for (int a = 0; a < 2; ++a)
#pragma unroll
            for (int b = 0; b < 2; ++b)
#pragma unroll
                for (int m = 0; m < 4; ++m)
#pragma unroll
                    for (int n = 0; n < 2; ++n) acc[a][b][m][n] = (f32x4){0.f, 0.f, 0.f, 0.f};
        }
        cur = nxt; cA = nA; cB = nB; ++ui;
        if (wr == 1) PG8_BAR;
    }
    PG8_WAIT_V(0);
    PG8_BAR;
#undef PG8_SA
#undef PG8_SB
#undef PG8_STAGE
#undef PG8_LDA
#undef PG8_LDB
#undef PG8_MMA
#undef PG8_WAIT_V
#undef PG8_WAIT_L
#undef PG8_BAR
#undef PG8_SCHED
}
}
using pg8::Unit;

__device__ __forceinline__ float ssq16(const float* p) { const f32x4 a = *(const f32x4*)p, b = *(const f32x4*)(p + 4), c = *(const f32x4*)(p + 8), d = *(const f32x4*)(p + 12);
    return ((a[0] + a[1]) + (a[2] + a[3])) + ((b[0] + b[1]) + (b[2] + b[3])) + ((c[0] + c[1]) + (c[2] + c[3])) + ((d[0] + d[1]) + (d[2] + d[3])); }
__device__ __forceinline__ float ssq4(const float* p) { const f32x4 a = *(const f32x4*)p; return (a[0] + a[1]) + (a[2] + a[3]); }
__device__ __forceinline__ void rope8(f32x4& v0, f32x4& v1, const float* ct, const float* st, int pos, int NF, int fb) {
    const f32x4 c = *(const f32x4*)(ct + (size_t)pos * NF + fb), s = *(const f32x4*)(st + (size_t)pos * NF + fb);
    const f32x4 a = v0 * c - v1 * s, b = v0 * s + v1 * c; v0 = a; v1 = b;
}
#define EPI_ROWLOOP _Pragma("unroll") for (int ai = 0; ai < 2; ++ai) _Pragma("unroll") for (int m = 0; m < 4; ++m)
#define EPI_FENCE asm volatile("" ::: "memory")

#define WSP(T, off) ((T*)(ws + (off)))
__device__ __forceinline__ float rstd_x(const unsigned char* ws, int row) { return rsqrtf(ssq16((const float*)(ws + WS_SSQX) + (size_t)row * 16) * (1.f / 1024.f) + NEPS); }
struct EpiP1 {
    unsigned char* ws;
    __device__ __forceinline__ bool operator()(f32x4 (&acc)[2][2][4][2], const Unit& u, int wr, int wc, int fr, int fq) const {
        const int pn = u.pn, row0 = u.pm * 256 + wr * 64 + fr, cl0 = wc * 32 + 8 * fq;
        size_t d0, d1; int l0, l1, c0, c1, md0 = 0, md1 = 0; bool st1 = true; size_t ssqo = 0;
        if (pn == 0) { d0 = d1 = WS_CQ; l0 = l1 = 256; c0 = cl0; c1 = 128 + cl0; ssqo = WS_SSQCQ; }
        else if (pn == 1) { d0 = WS_CKV; l0 = 128; c0 = cl0; d1 = WS_KPE; l1 = 32; c1 = 8 * fq; md1 = 1; st1 = (wc == 0); ssqo = WS_SSQKV; }
        else if (pn < 8) { const int sec = (pn - 2) >> 1; d0 = d1 = WS_MQ + (size_t)sec * (16 * MiB); l0 = l1 = 512; c0 = ((pn - 2) & 1) * 256 + cl0; c1 = c0 + 128; md0 = md1 = (sec < 2) ? 2 : 0; }
        else if (pn < 10) { d0 = d1 = (pn == 8 ? WS_RQ : WS_RK); l0 = l1 = 256; c0 = cl0; c1 = 128 + cl0; md0 = md1 = 3; }
        else { d0 = d1 = WS_RV; l0 = l1 = 512; c0 = (pn - 10) * 256 + cl0; c1 = c0 + 128; }
        const int md = md0 | md1; const int NF = md == 1 ? 16 : (md == 2 ? 8 : 32);
        const float* ct = (const float*)(ws + (md == 1 ? TAB_CM : (md == 2 ? TAB_CB : TAB_CR))); const float* st = (const float*)(ws + (md == 1 ? TAB_SM : (md == 2 ? TAB_SB : TAB_SR)));
        const bool rp0 = md0 == 2 ? ((c0 & 63) < 16) : (md0 != 0), rp1 = md1 == 2 ? ((c1 & 63) < 16) : (md1 != 0);
        const int fb0 = 4 * ((c0 & 63) >> 3), fb1 = 4 * ((c1 & 63) >> 3);
        bf16_t* p0 = (bf16_t*)(ws + d0) + c0; bf16_t* p1 = (bf16_t*)(ws + d1) + c1;
        EPI_ROWLOOP { const int row = row0 + ai * 128 + m * 16; const float rs = rstd_x(ws, row); const int pos = row & (SS - 1);
            f32x4 v0 = acc[ai][0][m][0] * rs, v1 = acc[ai][0][m][1] * rs; float ss = dot4(v0) + dot4(v1);
            if (rp0) rope8(v0, v1, ct, st, pos, NF, fb0);
            *(u32x4*)(p0 + (size_t)row * l0) = pack8(v0, v1);
            v0 = acc[ai][1][m][0] * rs; v1 = acc[ai][1][m][1] * rs; if (pn == 0) ss += dot4(v0) + dot4(v1);
            if (rp1) rope8(v0, v1, ct, st, pos, NF, fb1);
            if (st1) *(u32x4*)(p1 + (size_t)row * l1) = pack8(v0, v1);
            if (ssqo) { ss += __shfl_xor(ss, 16); ss += __shfl_xor(ss, 32); if (fq == 0) ((float*)(ws + ssqo))[(size_t)row * 4 + wc] = ss; }
            EPI_FENCE; }
        return false;
    }
};
struct EpiQU {
    unsigned char* ws;
    __device__ __forceinline__ bool operator()(f32x4 (&acc)[2][2][4][2], const Unit& u, int wr, int wc, int fr, int fq) const {
        const int row0 = u.pm * 256 + wr * 64 + fr, c0 = u.pn * 256 + wc * 32 + 8 * fq;
        EPI_ROWLOOP { const int row = row0 + ai * 128 + m * 16; const float rs = rsqrtf(ssq4(WSP(const float, WS_SSQCQ) + (size_t)row * 4) * (1.f / 256.f) + NEPS);
#pragma unroll
            for (int bj = 0; bj < 2; ++bj) { const int c = c0 + bj * 128, d = c % 96; f32x4 v0 = acc[ai][bj][m][0] * rs, v1 = acc[ai][bj][m][1] * rs;
                if (d >= 64) rope8(v0, v1, WSP(const float, TAB_CM), WSP(const float, TAB_SM), row & (SS - 1), 16, 4 * ((d - 64) >> 3));
                *(u32x4*)(WSP(bf16_t, WS_QM) + (size_t)row * 768 + c) = pack8(v0, v1); }
            EPI_FENCE; }
        return false;
    }
};
struct EpiKVU {
    unsigned char* ws;
    __device__ __forceinline__ bool operator()(f32x4 (&acc)[2][2][4][2], const Unit& u, int wr, int wc, int fr, int fq) const {
        const int row0 = u.pm * 256 + wr * 64 + fr, c0 = u.pn * 256 + wc * 32 + 8 * fq;
        EPI_ROWLOOP { const int row = row0 + ai * 128 + m * 16; const float rs = rsqrtf(ssq4(WSP(const float, WS_SSQKV) + (size_t)row * 4) * (1.f / 128.f) + NEPS);
#pragma unroll
            for (int bj = 0; bj < 2; ++bj) { const int c = c0 + bj * 128; const f32x4 v0 = acc[ai][bj][m][0] * rs, v1 = acc[ai][bj][m][1] * rs;
                *(u32x4*)(WSP(bf16_t, WS_KVM) + (size_t)row * 1024 + c) = pack8(v0, v1); }
            EPI_FENCE; }
        return false;
    }
};
__device__ __forceinline__ float sigm(float v) { return 1.f / (1.f + __expf(-v)); }
struct EpiGate {
    unsigned char* ws;
    __device__ __forceinline__ bool operator()(f32x4 (&acc)[2][2][4][2], const Unit& u, int wr, int wc, int fr, int fq) const {
        const int pn = u.pn, row0 = u.pm * 256 + wr * 64 + fr, cl0 = wc * 32 + 8 * fq;
        if (pn < 12) {
            bf16_t* dst = (pn < 4 ? WSP(bf16_t, WS_GMLA) : (pn < 8 ? WSP(bf16_t, WS_GMOBA) : WSP(bf16_t, WS_GRET))); const int cb0 = (pn & 3) * 256;
            EPI_ROWLOOP { const int row = row0 + ai * 128 + m * 16; const float rs = rstd_x(ws, row);
#pragma unroll
                for (int bj = 0; bj < 2; ++bj) { f32x4 v0 = acc[ai][bj][m][0] * rs, v1 = acc[ai][bj][m][1] * rs;
#pragma unroll
                    for (int j = 0; j < 4; ++j) { v0[j] = fmaxf(sigm(v0[j]), 1e-30f); v1[j] = fmaxf(sigm(v1[j]), 1e-30f); }
                    *(u32x4*)(dst + (size_t)row * 1024 + cb0 + bj * 128 + cl0) = pack8(v0, v1); }
                EPI_FENCE; }
        } else {
            const int cb0 = (pn - 12) * 256;
            EPI_ROWLOOP { const int row = row0 + ai * 128 + m * 16; const float rs = rstd_x(ws, row);
#pragma unroll
                for (int bj = 0; bj < 2; ++bj) { f32x4 v0 = acc[ai][bj][m][0] * rs, v1 = acc[ai][bj][m][1] * rs; bf16_t* p = WSP(bf16_t, WS_RV) + (size_t)row * 512 + cb0 + bj * 128 + cl0;
                    f32x4 o0, o1; unpack8(*(const u32x4*)p, o0, o1);
#pragma unroll
                    for (int j = 0; j < 4; ++j) { v0[j] = v0[j] * sigm(v0[j]) * o0[j]; v1[j] = v1[j] * sigm(v1[j]) * o1[j]; }
                    *(u32x4*)p = pack8(v0, v1); }
                EPI_FENCE; }
        }
        return false;
    }
};
struct EpiMerge {
    unsigned char* ws;
    __device__ __forceinline__ bool operator()(f32x4 (&acc)[2][2][4][2], const Unit& u, int wr, int wc, int fr, int fq) const {
        const int br = u.aux, row0 = u.pm * 256 + wr * 64 + fr, c0 = u.pn * 256 + wc * 32 + 8 * fq;
        const bf16_t* Ga = br == 0 ? WSP(bf16_t, WS_GMLA) : (br == 1 ? WSP(bf16_t, WS_GMOBA) : WSP(bf16_t, WS_GRET)); const bf16_t* Gb = br == 0 ? WSP(bf16_t, WS_GMOBA) : WSP(bf16_t, WS_GRET);
        EPI_ROWLOOP { const int row = row0 + ai * 128 + m * 16;
#pragma unroll
            for (int bj = 0; bj < 2; ++bj) { const size_t off = (size_t)row * 1024 + c0 + bj * 128; f32x4 a0, a1; unpack8(*(const u32x4*)(Ga + off), a0, a1);
                if (br < 2) { f32x4 b0, b1; unpack8(*(const u32x4*)(Gb + off), b0, b1);
#pragma unroll
                    for (int j = 0; j < 4; ++j) { acc[ai][bj][m][0][j] *= a0[j] / b0[j]; acc[ai][bj][m][1][j] *= a1[j] / b1[j]; } }
                else { const f32x4 v0 = acc[ai][bj][m][0] * a0, v1 = acc[ai][bj][m][1] * a1; *(u32x4*)(WSP(bf16_t, WS_MB) + off) = pack8(v0, v1); } }
            EPI_FENCE; }
        return br < 2;
    }
};
struct EpiRes {
    const float* res; float* out; unsigned char* ws;
    __device__ __forceinline__ bool operator()(f32x4 (&acc)[2][2][4][2], const Unit& u, int wr, int wc, int fr, int fq) const {
        const int row0 = u.pm * 256 + wr * 64 + fr, c0 = u.pn * 256 + wc * 32 + 8 * fq;
        EPI_ROWLOOP { const int row = row0 + ai * 128 + m * 16; float ss = 0.f;
#pragma unroll
            for (int bj = 0; bj < 2; ++bj) { const size_t off = (size_t)row * 1024 + c0 + bj * 128;
                const f32x4 v0 = acc[ai][bj][m][0] + *(const f32x4*)(res + off), v1 = acc[ai][bj][m][1] + *(const f32x4*)(res + off + 4);
                *(f32x4*)(out + off) = v0; *(f32x4*)(out + off + 4) = v1; *(u32x4*)(WSP(bf16_t, WS_XB) + off) = pack8(v0, v1); ss += dot4(v0) + dot4(v1); }
            ss += __shfl_xor(ss, 16); ss += __shfl_xor(ss, 32); if (fq == 0) WSP(float, WS_SSQX)[(size_t)row * 16 + u.pn * 4 + wc] = ss;
            EPI_FENCE; }
        return false;
    }
};
struct EpiUp {
    unsigned char* ws;
    __device__ __forceinline__ bool operator()(f32x4 (&acc)[2][2][4][2], const Unit& u, int wr, int wc, int fr, int fq) const {
        const int row0 = u.pm * 256 + wr * 64 + fr, c0 = u.pn * 256 + wc * 32 + 8 * fq;
        EPI_ROWLOOP { const int row = row0 + ai * 128 + m * 16; const float rs = rstd_x(ws, row);
#pragma unroll
            for (int bj = 0; bj < 2; ++bj) { f32x4 v0 = acc[ai][bj][m][0] * rs, v1 = acc[ai][bj][m][1] * rs;
#pragma unroll
                for (int j = 0; j < 4; ++j) { const float a = fmaxf(v0[j], 0.f), b = fmaxf(v1[j], 0.f); v0[j] = a * a; v1[j] = b * b; }
                *(u32x4*)(WSP(bf16_t, WS_HID) + (size_t)row * 4096 + c0 + bj * 128) = pack8(v0, v1); }
            EPI_FENCE; }
        return false;
    }
};

namespace att {
constexpr int KSL = 12288, VSL = 8192;
constexpr int L_K = 0, L_V = 2 * KSL, L_WS = L_V + 2 * VSL, L_OST = L_WS + 2048, L_SEL = L_OST + 32768, L_UM = L_SEL + 1024, L_KM = L_UM + 64, L_END = L_KM + 4096;
constexpr float NEG = -1e30f;
__device__ __forceinline__ int crow(int r, int hi) { return (r & 3) + 8 * (r >> 2) + 4 * hi; }
__device__ __forceinline__ void glds16(const void* gsrc, unsigned lds_dst) { unsigned keep;
    asm volatile("s_mov_b32 %0, m0\n\ts_mov_b32 m0, %2\n\ts_nop 0\n\tglobal_load_lds_dwordx4 %1, off\n\ts_mov_b32 m0, %0" : "=&s"(keep) : "v"(gsrc), "s"(lds_dst) : "memory"); }
__device__ __forceinline__ int nth_block(unsigned um, int bi, int qb) { for (int i = 0; i < bi; ++i) um &= um - 1u; return um ? __builtin_ctz(um) : qb; }
__device__ __forceinline__ void pv(f32x16* o, int vb, bf16x8 pa0, bf16x8 pa1, bf16x8 pa2, bf16x8 pa3) {
#pragma unroll
    for (int d0 = 0; d0 < 2; ++d0) { s16x4 lo[4], hi[4];
#pragma unroll
        for (int ks = 0; ks < 4; ++ks) {
            asm volatile("ds_read_b64_tr_b16 %0,%1 offset:%c2" : "=&v"(lo[ks]) : "v"(vb), "i"(d0 * 4096 + ks * 1024) : "memory");
            asm volatile("ds_read_b64_tr_b16 %0,%1 offset:%c2" : "=&v"(hi[ks]) : "v"(vb), "i"(d0 * 4096 + ks * 1024 + 512) : "memory"); }
        asm volatile("s_waitcnt lgkmcnt(0)" ::: "memory"); __builtin_amdgcn_sched_barrier(0);
#define PK(k) (bf16x8){lo[k][0], lo[k][1], lo[k][2], lo[k][3], hi[k][0], hi[k][1], hi[k][2], hi[k][3]}
        o[d0] = __builtin_amdgcn_mfma_f32_32x32x16_bf16(pa0, PK(0), o[d0], 0, 0, 0);
        o[d0] = __builtin_amdgcn_mfma_f32_32x32x16_bf16(pa1, PK(1), o[d0], 0, 0, 0);
        o[d0] = __builtin_amdgcn_mfma_f32_32x32x16_bf16(pa2, PK(2), o[d0], 0, 0, 0);
        o[d0] = __builtin_amdgcn_mfma_f32_32x32x16_bf16(pa3, PK(3), o[d0], 0, 0, 0);
#undef PK
    }
}
#define ATT_WAITBAR() asm volatile("s_waitcnt vmcnt(0) lgkmcnt(0)\n\ts_barrier" ::: "memory")

template <int DQ, bool ROWSEL>
__device__ __forceinline__ void attn_unit(long rowbase, int qb, const bf16_t* Qh, int ldq, const bf16_t* Kh, int ldk, const bf16_t* Kpe, const bf16_t* Vh, int ldv, bf16_t* Oh, int ldo,
                                          LAS unsigned char* lds, unsigned umask) {
    const int tid = opaque_tid(), lane = tid & 63, r32 = lane & 31, hi = lane >> 5; const int wid = __builtin_amdgcn_readfirstlane(tid >> 6);
    const int q0 = qb * 256;
    const unsigned lds0 = (unsigned)(uintptr_t)lds;
    LAS float* wsf = (LAS float*)(lds + L_WS) + wid * 64;
    umask = (unsigned)__builtin_amdgcn_readfirstlane((int)umask);
    const int npast = __builtin_popcount(umask), NT = 4 * (npast + 1);
#define ATT_ISSUE(key0, slot) do { const long kr_ = rowbase + (key0); \
        glds16(Kh + (kr_ + lane) * ldk + wid * 8, (unsigned)__builtin_amdgcn_readfirstlane((int)(lds0 + L_K + (slot) * KSL + wid * 1024))); \
        if (DQ == 96 && wid < 4) glds16(Kpe + (kr_ + lane) * 32 + wid * 8, (unsigned)__builtin_amdgcn_readfirstlane((int)(lds0 + L_K + (slot) * KSL + (8 + wid) * 1024))); \
        glds16(Vh + (kr_ + 16 * (wid & 3) + (lane >> 2)) * ldv + (wid >> 2) * 32 + (lane & 3) * 8, (unsigned)__builtin_amdgcn_readfirstlane((int)(lds0 + L_V + (slot) * VSL + wid * 1024))); } while (0)
    ATT_ISSUE(nth_block(umask, 0, qb) * 256, 0);
    bf16x8 qr[DQ / 16];
    { const bf16_t* Qw = Qh + (rowbase + q0 + wid * 32 + r32) * ldq + hi * 8;
#pragma unroll
      for (int d0 = 0; d0 < DQ / 16; ++d0) qr[d0] = *(const bf16x8*)(Qw + d0 * 16); }
    unsigned rowsel = 0xffffffffu; if (ROWSEL) rowsel = *(const LAS unsigned*)(lds + L_SEL + (wid * 32 + r32) * 4);
    float m_run = NEG, l_run = 0.f; f32x16 o[2]; o[0] = f32x16{}; o[1] = f32x16{};
    const int qrel = wid * 32 + r32;
    const int vb0 = (int)(lds0 + L_V) + ((lane >> 4) & 1) * 32 + (lane & 3) * 8 + (4 * hi + ((lane & 15) >> 2)) * 64;
    ATT_WAITBAR();
    for (int t = 0; t < NT; ++t) {
        const int s = t & 1, sub = t & 3; const int blk = nth_block(umask, t >> 2, qb);
        if (t + 1 < NT) { const int nb = nth_block(umask, (t + 1) >> 2, qb); ATT_ISSUE(nb * 256 + ((t + 1) & 3) * 64, s ^ 1); }
        f32x16 p0 = f32x16{}, p1 = f32x16{};
        { const LAS unsigned char* kp = lds + L_K + s * KSL + hi * 1024 + r32 * 16;
#pragma unroll
          for (int d0 = 0; d0 < DQ / 16; ++d0) { const bf16x8 b0 = *(const LAS bf16x8*)(kp + d0 * 2048), b1 = *(const LAS bf16x8*)(kp + d0 * 2048 + 512);
              p0 = __builtin_amdgcn_mfma_f32_32x32x16_bf16(b0, qr[d0], p0, 0, 0, 0); p1 = __builtin_amdgcn_mfma_f32_32x32x16_bf16(b1, qr[d0], p1, 0, 0, 0); } }
        if (blk == qb) { const int kb = 64 * sub + 4 * hi;
#pragma unroll
            for (int r = 0; r < 16; ++r) { const int kv = kb + (r & 3) + 8 * (r >> 2); if (kv > qrel) p0[r] = NEG; if (kv + 32 > qrel) p1[r] = NEG; }
        } else if (ROWSEL) { if (!((rowsel >> blk) & 1u)) {
#pragma unroll
            for (int r = 0; r < 16; ++r) { p0[r] = NEG; p1[r] = NEG; } } }
        float rm = fmaxf(p0[0], p1[0]);
#pragma unroll
        for (int r = 1; r < 16; ++r) rm = fmaxf(rm, fmaxf(p0[r], p1[r]));
        { auto rr = __builtin_amdgcn_permlane32_swap(__float_as_uint(rm), __float_as_uint(rm), false, false); rm = fmaxf(__uint_as_float(rr[0]), __uint_as_float(rr[1])); }
        const float mn = fmaxf(m_run, rm), f = __builtin_amdgcn_exp2f(m_run - mn); m_run = mn;
        float ls = 0.f;
#pragma unroll
        for (int r = 0; r < 16; ++r) { p0[r] = __builtin_amdgcn_exp2f(p0[r] - mn); p1[r] = __builtin_amdgcn_exp2f(p1[r] - mn); ls += p0[r] + p1[r]; }
        l_run = l_run * f + ls;
        if (__any(f != 1.f)) { if (hi == 0) wsf[r32] = f; asm volatile("s_waitcnt lgkmcnt(0)" ::: "memory");
#pragma unroll
            for (int r = 0; r < 16; ++r) { const float fr_ = wsf[crow(r, hi)]; o[0][r] *= fr_; o[1][r] *= fr_; }
            asm volatile("s_waitcnt lgkmcnt(0)" ::: "memory"); }
        u32x4 pw0 = (u32x4){pk2(p0[0], p0[1]), pk2(p0[2], p0[3]), pk2(p0[4], p0[5]), pk2(p0[6], p0[7])}, pw1 = (u32x4){pk2(p0[8], p0[9]), pk2(p0[10], p0[11]), pk2(p0[12], p0[13]), pk2(p0[14], p0[15])};
        u32x4 pw2 = (u32x4){pk2(p1[0], p1[1]), pk2(p1[2], p1[3]), pk2(p1[4], p1[5]), pk2(p1[6], p1[7])}, pw3 = (u32x4){pk2(p1[8], p1[9]), pk2(p1[10], p1[11]), pk2(p1[12], p1[13]), pk2(p1[14], p1[15])};
        pv(o, vb0 + s * VSL, __builtin_bit_cast(bf16x8, pw0), __builtin_bit_cast(bf16x8, pw1), __builtin_bit_cast(bf16x8, pw2), __builtin_bit_cast(bf16x8, pw3));
        ATT_WAITBAR();
    }
#undef ATT_ISSUE
    { auto rr = __builtin_amdgcn_permlane32_swap(__float_as_uint(l_run), __float_as_uint(l_run), false, false); l_run = __uint_as_float(rr[0]) + __uint_as_float(rr[1]); }
    if (hi == 0) wsf[32 + r32] = l_run; asm volatile("s_waitcnt lgkmcnt(0)" ::: "memory");
    float rli[16];
#pragma unroll
    for (int r = 0; r < 16; ++r) rli[r] = 1.0f / wsf[32 + crow(r, hi)];
    bf16_t* Ow = Oh + (rowbase + q0 + wid * 32) * ldo;
    { LAS bf16_t* stg = (LAS bf16_t*)(lds + L_OST) + wid * 2048;
#pragma unroll
      for (int r = 0; r < 16; ++r) { const int orow = crow(r, hi);
#pragma unroll
          for (int d0 = 0; d0 < 2; ++d0) stg[orow * 64 + d0 * 32 + r32] = (bf16_t)(pk2(o[d0][r] * rli[r], 0.f) & 0xffffu); }
      asm volatile("s_waitcnt lgkmcnt(0)" ::: "memory");
#pragma unroll
      for (int i = 0; i < 4; ++i) { const int row = i * 8 + (lane >> 3), ch = lane & 7; const u32x4 v = *(const LAS u32x4*)(stg + row * 64 + ch * 8); *(u32x4*)(Ow + (long)row * ldo + ch * 8) = v; } }
    ATT_WAITBAR();
}
}

__device__ __forceinline__ f32x16 mfma32f(float a, float b, f32x16 c) { return __builtin_amdgcn_mfma_f32_32x32x2f32(a, b, c, 0, 0, 0); }
__device__ __forceinline__ float ex2(float x) { return __builtin_amdgcn_exp2f(x); }

__device__ __forceinline__ void ret_kv_unit(int un, const bf16_t* RK, const bf16_t* RV, float* RKV, const float* lg2p, LAS unsigned char* lds) {
    const int tid = opaque_tid(), lane = tid & 63, r32 = lane & 31, hi = lane >> 5, wid = tid >> 6;
    const int bh = un >> 5, n = un & 31, b = bh >> 2, h = bh & 3; const long r0 = (long)b * SS + n * 128; const float lg = lg2p[h];
    LAS float* Kz = (LAS float*)lds; LAS float* Vs = (LAS float*)(lds + 32768);
    { const int row = tid >> 2, cs = (tid & 3) * 16; const float z = ex2(lg * (float)(127 - row)); const bf16_t* p = RK + (r0 + row) * 256 + h * 64 + cs;
      f32x4 a, bq; unpack8(*(const u32x4*)p, a, bq); *(LAS f32x4*)(Kz + row * 64 + cs) = a * z; *(LAS f32x4*)(Kz + row * 64 + cs + 4) = bq * z;
      unpack8(*(const u32x4*)(p + 8), a, bq); *(LAS f32x4*)(Kz + row * 64 + cs + 8) = a * z; *(LAS f32x4*)(Kz + row * 64 + cs + 12) = bq * z;
      const int vs = (tid & 3) * 32; const bf16_t* pv_ = RV + (r0 + row) * 512 + h * 128 + vs;
#pragma unroll
      for (int i = 0; i < 4; ++i) { unpack8(*(const u32x4*)(pv_ + 8 * i), a, bq); *(LAS f32x4*)(Vs + row * 128 + vs + 8 * i) = a; *(LAS f32x4*)(Vs + row * 128 + vs + 8 * i + 4) = bq; } }
    __syncthreads();
    const int dt = wid >> 2, et = wid & 3; f32x16 acc = f32x16{};
#pragma unroll 4
    for (int j0 = 0; j0 < 128; j0 += 2) acc = mfma32f(Kz[(j0 + hi) * 64 + dt * 32 + r32], Vs[(j0 + hi) * 128 + et * 32 + r32], acc);
    float* dst = RKV + (size_t)un * 8192;
#pragma unroll
    for (int r = 0; r < 16; ++r) dst[(dt * 32 + att::crow(r, hi)) * 128 + et * 32 + r32] = acc[r];
    __syncthreads();
}
__device__ __forceinline__ void ret_out_unit(int un, const bf16_t* RQ, const bf16_t* RK, bf16_t* RV, const float* RKV, const float* gnw, const float* gnb, const float* lg2p, LAS unsigned char* lds) {
    const int tid = opaque_tid(), lane = tid & 63, r32 = lane & 31, hi = lane >> 5, wid = tid >> 6;
    const int bh = un >> 5, n = un & 31, b = bh >> 2, h = bh & 3; const long r0 = (long)b * SS + n * 128; const float lg = lg2p[h];
    LAS float* Qs = (LAS float*)lds; LAS float* Ks = (LAS float*)(lds + 33280); LAS float* Rs = (LAS float*)(lds + 66560); LAS float* Sm = (LAS float*)(lds + 66560); LAS float* Vs = (LAS float*)lds;
    { const int row = tid >> 2, cs = (tid & 3) * 16; const bf16_t* pq = RQ + (r0 + row) * 256 + h * 64 + cs; const bf16_t* pk = RK + (r0 + row) * 256 + h * 64 + cs;
      f32x4 a, bq;
#pragma unroll
      for (int i = 0; i < 2; ++i) { unpack8(*(const u32x4*)(pq + 8 * i), a, bq);
#pragma unroll
          for (int j = 0; j < 4; ++j) { Qs[row * 65 + cs + 8 * i + j] = a[j]; Qs[row * 65 + cs + 8 * i + 4 + j] = bq[j]; }
          unpack8(*(const u32x4*)(pk + 8 * i), a, bq);
#pragma unroll
          for (int j = 0; j < 4; ++j) { Ks[row * 65 + cs + 8 * i + j] = a[j]; Ks[row * 65 + cs + 8 * i + 4 + j] = bq[j]; } }
#pragma unroll
      for (int i = 0; i < 4; ++i) { const int e4 = (tid + 512 * i) * 4; f32x4 r = (f32x4){0.f, 0.f, 0.f, 0.f};
          for (int j = 0; j < n; ++j) { const float w = ex2(lg * 128.0f * (float)(n - 1 - j)); r += *(const f32x4*)(RKV + ((size_t)(bh * 32 + j)) * 8192 + e4) * w; }
          *(LAS f32x4*)(Rs + e4) = r; } }
    __syncthreads();
    const int it = wid >> 1, eh = wid & 1; f32x16 acc0 = f32x16{}, acc1 = f32x16{};
#pragma unroll 4
    for (int d0 = 0; d0 < 64; d0 += 2) { const float a = Qs[(32 * it + r32) * 65 + d0 + hi]; acc0 = mfma32f(a, Rs[(d0 + hi) * 128 + 64 * eh + r32], acc0); acc1 = mfma32f(a, Rs[(d0 + hi) * 128 + 64 * eh + 32 + r32], acc1); }
#pragma unroll
    for (int r = 0; r < 16; ++r) { const float xi = ex2(lg * (float)(32 * it + att::crow(r, hi) + 1)); acc0[r] *= xi; acc1[r] *= xi; }
    __syncthreads();
#pragma unroll
    for (int jj = 0; jj < 2; ++jj) { const int jt = 2 * eh + jj; if (jt <= it) { f32x16 s = f32x16{};
#pragma unroll 4
        for (int d0 = 0; d0 < 64; d0 += 2) s = mfma32f(Qs[(32 * it + r32) * 65 + d0 + hi], Ks[(32 * jt + r32) * 65 + d0 + hi], s);
#pragma unroll
        for (int r = 0; r < 16; ++r) { const int i = 32 * it + att::crow(r, hi), j = 32 * jt + r32; Sm[i * 129 + j] = (i >= j) ? s[r] * ex2(lg * (float)(i - j)) : 0.f; } } }
    __syncthreads();
    { const int row = tid >> 2, vs = (tid & 3) * 32; const bf16_t* pv_ = RV + (r0 + row) * 512 + h * 128 + vs; f32x4 a, bq;
#pragma unroll
      for (int i = 0; i < 4; ++i) { unpack8(*(const u32x4*)(pv_ + 8 * i), a, bq); *(LAS f32x4*)(Vs + row * 128 + vs + 8 * i) = a; *(LAS f32x4*)(Vs + row * 128 + vs + 8 * i + 4) = bq; } }
    __syncthreads();
    { const int jend = 32 * (it + 1);
#pragma unroll 4
      for (int j0 = 0; j0 < jend; j0 += 2) { const float a = Sm[(32 * it + r32) * 129 + j0 + hi]; acc0 = mfma32f(a, Vs[(j0 + hi) * 128 + 64 * eh + r32], acc0); acc1 = mfma32f(a, Vs[(j0 + hi) * 128 + 64 * eh + 32 + r32], acc1); } }
    __syncthreads();
#pragma unroll
    for (int r = 0; r < 16; ++r) { const int i = 32 * it + att::crow(r, hi); Sm[i * 129 + 64 * eh + r32] = acc0[r]; Sm[i * 129 + 64 * eh + 32 + r32] = acc1[r]; }
    __syncthreads();
    { const int row = tid >> 2, q4 = tid & 3; float v[32]; float s = 0.f;
#pragma unroll
      for (int k = 0; k < 32; ++k) { v[k] = Sm[row * 129 + q4 * 32 + k]; s += v[k]; }
      s += __shfl_xor(s, 1); s += __shfl_xor(s, 2); const float mu = s * (1.f / 128.f); float q = 0.f;
#pragma unroll
      for (int k = 0; k < 32; ++k) { v[k] -= mu; q += v[k] * v[k]; }
      q += __shfl_xor(q, 1); q += __shfl_xor(q, 2); const float rstd = rsqrtf(q * (1.f / 128.f) + GNEPS);
      const float* gw = gnw + h * 128 + q4 * 32; const float* gb = gnb + h * 128 + q4 * 32; bf16_t* po = RV + (r0 + row) * 512 + h * 128 + q4 * 32;
#pragma unroll
      for (int i = 0; i < 4; ++i) { f32x4 a, bq;
#pragma unroll
          for (int j = 0; j < 4; ++j) { a[j] = v[8 * i + j] * rstd * gw[8 * i + j] + gb[8 * i + j]; bq[j] = v[8 * i + 4 + j] * rstd * gw[8 * i + 4 + j] + gb[8 * i + 4 + j]; }
          *(u32x4*)(po + 8 * i) = pack8(a, bq); } }
    __syncthreads();
}

__device__ __forceinline__ float wave_sum(float v) {
#pragma unroll
    for (int o = 1; o < 64; o <<= 1) v += __shfl_xor(v, o);
    return v;
}
__device__ __forceinline__ void sincos_acc(float ang, float& s, float& c) {
    const double a = (double)ang; const double k = rint(a * 0.63661977236758134308); const double r = a - k * 1.57079632679489661923; const double r2 = r * r;
    const double sr = r * (1.0 + r2 * (-1.0 / 6 + r2 * (1.0 / 120 + r2 * (-1.0 / 5040 + r2 * (1.0 / 362880 + r2 * (-1.0 / 39916800 + r2 * (1.0 / 6227020800.0)))))));
    const double cr = 1.0 + r2 * (-0.5 + r2 * (1.0 / 24 + r2 * (-1.0 / 720 + r2 * (1.0 / 40320 + r2 * (-1.0 / 3628800 + r2 * (1.0 / 479001600.0 - r2 * (1.0 / 87178291200.0)))))));
    const int q = ((int)k) & 3;
    const double sv = (q == 0) ? sr : (q == 1) ? cr : (q == 2) ? -sr : -cr, cv = (q == 0) ? cr : (q == 1) ? -sr : (q == 2) ? -cr : sr;
    s = (float)sv; c = (float)cv;
}
__device__ __forceinline__ int perm_pair(int d, int half) { const int i = d < half ? d : d - half; return 8 * (i >> 2) + (i & 3) + (d < half ? 0 : 4); }

__device__ __forceinline__ void map_row(int kind, int n, int& row, float& sc) {
    const float c2m = 0.125f * LOG2E, c2q = 0.10206207261596575f * LOG2E;
    sc = 1.f; row = n;
    if (kind == 1) {
        if (n < 384) row = n;
        else if (n < 416) row = 384 + perm_pair(n - 384, 16);
        else if (n < 1952) { const int s = n - 416, sec = s >> 9, w = s & 511, hd = w >> 6, d = w & 63; row = 512 + sec * 512 + hd * 64 + ((sec < 2 && d < 16) ? perm_pair(d, 8) : d); if (sec == 0) sc = c2m; }
        else if (n < 2464) { const int s = n - 1952, sec = s >> 8, hd = (s & 255) >> 6, d = s & 63; row = 2048 + sec * 256 + hd * 64 + perm_pair(d, 32); if (sec == 1) sc = 0.125f; }
        else if (n < 2976) row = 2560 + (n - 2464);
        else if (n < 3488) row = 6144 + (n - 2976);
        else row = 3072 + (n - 3488);
    } else if (kind == 2) { const int hd = n / 96, d = n % 96; row = hd * 96 + (d < 64 ? d : 64 + perm_pair(d - 64, 16)); sc = c2q; }
}
__device__ __forceinline__ void tr_item(const float* __restrict__ W, int K, int N, bf16_t* WT, const float* gain, int kind, LAS float* scr, int item, int lane) {
    const int nblk = N / 32, kb = item / nblk, nb = item % nblk, k0 = 64 * kb, n0 = 32 * nb;
#pragma unroll 8
    for (int i = 0; i < 32; ++i) { const int kk = 2 * i + (lane >> 5); scr[kk * 33 + (lane & 31)] = W[(size_t)(k0 + kk) * N + n0 + (lane & 31)]; }
    asm volatile("s_waitcnt lgkmcnt(0)" ::: "memory");
    const int c = lane & 7; f32x4 g0 = (f32x4){1.f, 1.f, 1.f, 1.f}, g1 = g0;
    if (gain) { g0 = *(const f32x4*)(gain + k0 + 8 * c); g1 = *(const f32x4*)(gain + k0 + 8 * c + 4); }
#pragma unroll
    for (int j = 0; j < 4; ++j) { const int n = (lane >> 3) + 8 * j; int row; float sc; map_row(kind, n0 + n, row, sc); const LAS float* s = scr + (8 * c) * 33 + n;
        u32x4 o; o.x = pk2(s[0 * 33] * g0[0] * sc, s[1 * 33] * g0[1] * sc); o.y = pk2(s[2 * 33] * g0[2] * sc, s[3 * 33] * g0[3] * sc); o.z = pk2(s[4 * 33] * g1[0] * sc, s[5 * 33] * g1[1] * sc); o.w = pk2(s[6 * 33] * g1[2] * sc, s[7 * 33] * g1[3] * sc);
        *(u32x4*)(WT + (size_t)row * K + k0 + 8 * c) = o; }
    asm volatile("s_waitcnt lgkmcnt(0)" ::: "memory");
}


constexpr size_t WS_BAR = 1835008;
constexpr int LDS_MISC = 140000;
#define XB_TMO      128
#define XB_XCNT(j)  (256  + 64 * (j))
#define XB_XSUB(j)  (1280 + 64 * (j))
#define XB_XGEN(j)  (2304 + 64 * (j))
#define XB_TOP      3328
#define XB_TOPGEN   3392
#define XCD_BAR_WORDS 3456
#define XB_SPIN_CAP (1u << 22)
__device__ __forceinline__ unsigned xb_ld(unsigned* p)              { return __hip_atomic_load(p, __ATOMIC_RELAXED, __HIP_MEMORY_SCOPE_AGENT); }
__device__ __forceinline__ unsigned xb_add(unsigned* p, unsigned v) { return __hip_atomic_fetch_add(p, v, __ATOMIC_RELAXED, __HIP_MEMORY_SCOPE_AGENT); }
__device__ __forceinline__ unsigned xb_xcc_id() { return (unsigned)__builtin_amdgcn_s_getreg((3 << 11) | 20) & 0xFu; }
#define XB_SPIN(cond, bar) do { unsigned _sp = 0; while (cond) { __builtin_amdgcn_s_sleep(1); \
    if ((++_sp & 255u) == 0u) { if (xb_ld(&(bar)[XB_TMO])) break; if (_sp > XB_SPIN_CAP) { atomicAdd(&(bar)[XB_TMO], 1u); break; } } } } while (0)
__device__ __forceinline__ void xcd_barrier_complete(unsigned* bar, unsigned x, unsigned& nloc, unsigned& nx) {
    const unsigned G = gridDim.x;
    unsigned sum, cnt, mine, sp = 0u;
    for (;;) {
        sum = 0u; cnt = 0u; mine = 0u;
#pragma unroll
        for (unsigned j = 0; j < 16; ++j) { const unsigned c = xb_ld(&bar[XB_XCNT(j)]); sum += c; cnt += (c > 0u) ? 1u : 0u; mine = (j == x) ? c : mine; }
        if (sum == G) break;
        __builtin_amdgcn_s_sleep(1);
        if ((++sp & 255u) == 0u) { if (xb_ld(&bar[XB_TMO])) break; if (sp > XB_SPIN_CAP) { atomicAdd(&bar[XB_TMO], 1u); break; } }
    }
    nloc = mine > 0u ? mine : 1u; nx = cnt > 0u ? cnt : 1u;
}
__device__ __forceinline__ void grid_bar(unsigned char* wsb, LAS unsigned char* ldsb) {
    asm volatile("s_waitcnt vmcnt(0)" ::: "memory");
    __syncthreads();
    if (threadIdx.x == 0) {
        unsigned* bar = (unsigned*)(wsb + WS_BAR); volatile LAS unsigned* st = (volatile LAS unsigned*)(ldsb + LDS_MISC); const unsigned x = xb_xcc_id();
        __builtin_amdgcn_s_waitcnt(0);
        unsigned nloc = st[0], nx = st[1];
        if (nloc == 0u) { xcd_barrier_complete(bar, x, nloc, nx); st[0] = nloc; st[1] = nx; }
        const unsigned old = xb_add(&bar[XB_XSUB(x)], 1u);
        const unsigned gen = old / nloc;
        if (old + 1u == (gen + 1u) * nloc) {
            __builtin_amdgcn_fence(__ATOMIC_RELEASE, "agent");
            asm volatile("s_waitcnt vmcnt(0)" ::: "memory");
            const unsigned og = xb_add(&bar[XB_TOP], 1u);
            const unsigned tg = og / nx;
            if (og + 1u == (tg + 1u) * nx) xb_add(&bar[XB_TOPGEN], 1u);
            else XB_SPIN(xb_ld(&bar[XB_TOPGEN]) == tg, bar);
            __builtin_amdgcn_fence(__ATOMIC_ACQUIRE, "agent");
            xb_add(&bar[XB_XGEN(x)], 1u);
            asm volatile("s_waitcnt vmcnt(0)" ::: "memory");
        } else {
            XB_SPIN(xb_ld(&bar[XB_XGEN(x)]) == gen, bar);
            __builtin_amdgcn_fence(__ATOMIC_ACQUIRE, "agent");
            asm volatile("s_waitcnt vmcnt(0)" ::: "memory");
        }
    }
    __syncthreads();
}

__device__ __forceinline__ unsigned char* ap_ws() { const __attribute__((address_space(4))) Args* ap = (const __attribute__((address_space(4))) Args*)__builtin_amdgcn_kernarg_segment_ptr(); asm volatile("" : "+s"(ap)); return ap->ws; }
__global__ void __launch_bounds__(512) mega_fwd(Args args) {
    extern __shared__ __attribute__((aligned(16))) unsigned char lds_raw[];
    LAS unsigned char* lds = (LAS unsigned char*)lds_raw;
    {
      unsigned* bar = (unsigned*)(args.ws + WS_BAR);
      if (blockIdx.x == 0) for (int i = threadIdx.x; i < XCD_BAR_WORDS; i += 512) __hip_atomic_store(bar + i, 0u, __ATOMIC_RELAXED, __HIP_MEMORY_SCOPE_AGENT);
      if (threadIdx.x < 2) ((volatile LAS unsigned*)(lds + LDS_MISC))[threadIdx.x] = 0u;
      __threadfence();
      cg::this_grid().sync();
      if (threadIdx.x == 0) (void)xb_add(&bar[XB_XCNT(xb_xcc_id())], 1u);
    }
#define PHASE_VARS \
    const __attribute__((address_space(4))) Args* ap = (const __attribute__((address_space(4))) Args*)__builtin_amdgcn_kernarg_segment_ptr(); asm volatile("" : "+s"(ap)); \
    unsigned char* ws = ap->ws; float* out = ap->out; (void)out; (void)ws; \
    int G = (int)gridDim.x, bx = (int)blockIdx.x; asm volatile("" : "+s"(G), "+s"(bx)); \
    const int tid = opaque_tid(), lane = tid & 63, wave = __builtin_amdgcn_readfirstlane(tid >> 6); (void)lane; (void)wave; \
    const int vcu = (G % 8 == 0) ? (bx % 8) * (G / 8) + bx / 8 : bx; const int gw = vcu * 8 + wave, NGW = G * 8; (void)gw; (void)NGW; (void)vcu;
#pragma unroll 1
    for (int l = 0; l < 2; ++l) {
        if (PH(0)) {
            PHASE_VARS
            LAS float* scr = (LAS float*)(lds + wave * 16384);
            constexpr int I_IN = 16 * 205, I_QU = 4 * 24, I_KVU = 2 * 32, I_BR = 8 * 32, I_O = 16 * 32, I_UP = 16 * 128, I_DN = 64 * 32;
            constexpr int NITEMS = I_IN + I_QU + I_KVU + 3 * I_BR + I_O + I_UP + I_DN;
            for (int it = gw; it < NITEMS; it += NGW) {
                int r = it;
                if (r < I_IN) { tr_item(ap->in[2] + (size_t)l * 1024 * 6560, 1024, 6560, (bf16_t*)(ws + W_IN), ap->in[1] + l * 1024, 1, scr, r, lane); continue; } r -= I_IN;
                if (r < I_QU) { tr_item(ap->in[5] + (size_t)l * 256 * 768, 256, 768, (bf16_t*)(ws + W_QU), ap->in[3] + l * 256, 2, scr, r, lane); continue; } r -= I_QU;
                if (r < I_KVU) { tr_item(ap->in[6] + (size_t)l * 128 * 1024, 128, 1024, (bf16_t*)(ws + W_KVU), ap->in[4] + l * 128, 0, scr, r, lane); continue; } r -= I_KVU;
                if (r < 3 * I_BR) { const int br = r / I_BR; tr_item(ap->in[9 + br] + (size_t)l * 512 * 1024, 512, 1024, (bf16_t*)(ws + W_BR) + (size_t)br * 1024 * 512, nullptr, 0, scr, r - br * I_BR, lane); continue; } r -= 3 * I_BR;
                if (r < I_O) { tr_item(ap->in[12] + (size_t)l * 1024 * 1024, 1024, 1024, (bf16_t*)(ws + W_OUT), nullptr, 0, scr, r, lane); continue; } r -= I_O;
                if (r < I_UP) { tr_item(ap->in[14] + (size_t)l * 1024 * 4096, 1024, 4096, (bf16_t*)(ws + W_UP), ap->in[13] + l * 1024, 0, scr, r, lane); continue; } r -= I_UP;
                tr_item(ap->in[15] + (size_t)l * 4096 * 1024, 4096, 1024, (bf16_t*)(ws + W_DN), nullptr, 0, scr, r, lane);
            }
            if (l == 0) {
                for (int idx = (vcu * 512 + tid); idx < SS * 56; idx += G * 512) { const int pos = idx / 56, f = idx % 56; float s, c;
                    if (f < 16) { sincos_acc((float)pos * ap->inv_mla[f], s, c); ((float*)(ws + TAB_CM))[pos * 16 + f] = c; ((float*)(ws + TAB_SM))[pos * 16 + f] = s; }
                    else if (f < 24) { sincos_acc((float)pos * ap->inv_moba[f - 16], s, c); ((float*)(ws + TAB_CB))[pos * 8 + f - 16] = c; ((float*)(ws + TAB_SB))[pos * 8 + f - 16] = s; }
                    else { sincos_acc((float)pos * ap->inv_ret[f - 24], s, c); ((float*)(ws + TAB_CR))[pos * 32 + f - 24] = c; ((float*)(ws + TAB_SR))[pos * 32 + f - 24] = s; } }
                const float* x = ap->in[0]; bf16_t* XB = WSP(bf16_t, WS_XB); float* SSQ_X = WSP(float, WS_SSQX);
                for (int m = gw; m < TT; m += NGW) { const f32x4* xr = (const f32x4*)(x + (size_t)m * DM) + lane; f32x4 v[4]; float s = 0.f;
#pragma unroll
                    for (int j = 0; j < 4; ++j) { v[j] = xr[64 * j]; s += dot4(v[j]); }
                    s = wave_sum(s);
                    unsigned long long* o8 = (unsigned long long*)(XB + (size_t)m * DM) + lane;
#pragma unroll
                    for (int j = 0; j < 4; ++j) o8[64 * j] = (unsigned long long)pk2(v[j][0], v[j][1]) | ((unsigned long long)pk2(v[j][2], v[j][3]) << 32);
                    if (lane < 16) SSQ_X[(size_t)m * 16 + lane] = lane == 0 ? s : 0.f; }
            }
        }
        grid_bar(ap_ws(), lds);
        if (PH(1)) { PHASE_VARS pg8::Gemm g{1024, 1024, 1024}; pg8::SchedStd S; S.init(ws + WS_XB, ws + W_IN, 1024, 1024, 64, 12, G, bx);
          EpiP1 E{ws}; pg8::gemm_phase(lds, g, S, E); }
        grid_bar(ap_ws(), lds);
        if (PH(2)) { PHASE_VARS pg8::Gemm g{256, 256, 256}; pg8::SchedStd S; S.init(ws + WS_CQ, ws + W_QU, 256, 256, 64, 3, G, bx); EpiQU E{ws}; pg8::gemm_phase(lds, g, S, E); }
        if (PH(3)) { PHASE_VARS pg8::Gemm g{128, 128, 128}; pg8::SchedStd S; S.init(ws + WS_CKV, ws + W_KVU, 128, 128, 64, 4, G, bx); EpiKVU E{ws}; pg8::gemm_phase(lds, g, S, E); }
        __syncthreads();
        if (PH(4)) { PHASE_VARS
          for (int un = vcu; un < 256; un += G) {
            const int bq = un >> 2, qtr = un & 3, b = bq >> 4, blk = bq & 15; const bf16_t* p = WSP(bf16_t, WS_MK) + ((size_t)b * SS + blk * 256 + qtr * 64) * 512 + tid; float s = 0.f;
#pragma unroll 8
            for (int j = 0; j < 64; ++j) s += __uint_as_float((unsigned)p[(size_t)j * 512] << 16);
            WSP(float, WS_KMP)[(size_t)un * 512 + tid] = s; } }
        if (PH(5)) { PHASE_VARS for (int un = vcu; un < 512; un += G) ret_kv_unit(un, WSP(bf16_t, WS_RK), WSP(bf16_t, WS_RV), WSP(float, WS_RKV), (const float*)ap->ret_lg2, lds); }
        grid_bar(ap_ws(), lds);
        if (PH(6)) { PHASE_VARS
          for (int un = vcu; un < 512; un += G) {
            const int bh = (un & 255) >> 3, qb = un < 256 ? (un & 7) : 15 - (un & 7), b = bh >> 3, h = bh & 7;
            att::attn_unit<96, false>((long)b * SS, qb, WSP(bf16_t, WS_QM) + h * 96, 768, WSP(bf16_t, WS_KVM) + h * 128, 1024, WSP(bf16_t, WS_KPE), WSP(bf16_t, WS_KVM) + h * 128 + 64, 1024, WSP(bf16_t, WS_OM) + h * 64, 512, lds, (1u << qb) - 1u);
          } }
        if (PH(7)) { PHASE_VARS
          for (int un = vcu; un < 512; un += G) {
            const int bh = (un & 255) >> 3, qb = un < 256 ? (un & 7) : 15 - (un & 7), b = bh >> 3, h = bh & 7;
            LAS float* km = (LAS float*)(lds + att::L_KM); LAS unsigned* selp = (LAS unsigned*)(lds + att::L_SEL); LAS unsigned* ump = (LAS unsigned*)(lds + att::L_UM);
            bf16_t* MQ = WSP(bf16_t, WS_MQ);
            if (tid == 0) *ump = 0u;
            for (int e = tid; e < 1024; e += 512) { const int n = e >> 6, d = e & 63; float s = 0.f;
                if (n < qb) { const float* p = WSP(float, WS_KMP) + ((size_t)(b * 16 + n) * 4) * 512 + h * 64 + d; s = (p[0] + p[512]) + (p[1024] + p[1536]); }
                km[e] = s * (1.f / 256.f); }
            __syncthreads();
            if (tid < 256) { const bf16_t* qp = MQ + ((size_t)b * SS + qb * 256 + tid) * 512 + h * 64; float q[64];
#pragma unroll
                for (int i = 0; i < 8; ++i) { f32x4 a, bq; unpack8(*(const u32x4*)(qp + 8 * i), a, bq);
#pragma unroll
                    for (int j = 0; j < 4; ++j) { q[8 * i + j] = a[j]; q[8 * i + 4 + j] = bq[j]; } }
                float v1 = -INFINITY, v2 = -INFINITY, v3 = -INFINITY; int i1 = 0, i2 = 0, i3 = 0;
                for (int n = 0; n < qb; ++n) { float gsum = 0.f;
#pragma unroll
                    for (int d = 0; d < 64; ++d) gsum += q[d] * km[n * 64 + d];
                    if (gsum > v1) { v3 = v2; i3 = i2; v2 = v1; i2 = i1; v1 = gsum; i1 = n; } else if (gsum > v2) { v3 = v2; i3 = i2; v2 = gsum; i2 = n; } else if (gsum > v3) { v3 = gsum; i3 = n; } }
                unsigned sel = qb <= 3 ? ((1u << qb) - 1u) : ((1u << i1) | (1u << i2) | (1u << i3));
                selp[tid] = sel;
                unsigned um = sel;
#pragma unroll
                for (int o = 1; o < 64; o <<= 1) um |= (unsigned)__shfl_xor((int)um, o);
                if (lane == 0) atomicOr((unsigned*)ump, um); }
            __syncthreads();
            const unsigned umask = *ump;
            att::attn_unit<64, true>((long)b * SS, qb, MQ + h * 64, 512, WSP(bf16_t, WS_MK) + h * 64, 512, nullptr, WSP(bf16_t, WS_MV) + h * 64, 512, MQ + h * 64, 512, lds, umask);
          } }
        if (PH(8)) { PHASE_VARS for (int un = vcu; un < 512; un += G) ret_out_unit(un, WSP(bf16_t, WS_RQ), WSP(bf16_t, WS_RK), WSP(bf16_t, WS_RV), WSP(float, WS_RKV), ap->in[7] + l * 512, ap->in[8] + l * 512, (const float*)ap->ret_lg2, lds); }
        grid_bar(ap_ws(), lds);
        if (PH(9)) { PHASE_VARS pg8::Gemm g{1024, 1024, 1024}; pg8::SchedStd S; S.init(ws + WS_XB, ws + W_IN + (size_t)3072 * 1024 * 2, 1024, 1024, 64, 14, G, bx);
          EpiGate E{ws}; pg8::gemm_phase(lds, g, S, E); }
        grid_bar(ap_ws(), lds);
        if (PH(10)) { PHASE_VARS pg8::Gemm g{512, 512, 512}; pg8::SchedMerge S{(const char*)(ws + WS_OM), (const char*)(ws + WS_MQ), (const char*)(ws + WS_RV), (const char*)(ws + W_BR), G, bx};
          EpiMerge E{ws}; pg8::gemm_phase(lds, g, S, E); }
        grid_bar(ap_ws(), lds);
        if (PH(11)) { PHASE_VARS pg8::Gemm g{1024, 1024, 1024}; pg8::SchedStd S; S.init(ws + WS_MB, ws + W_OUT, 1024, 1024, 64, 4, G, bx);
          EpiRes E{l == 0 ? ap->in[0] : (const float*)out, out, ws}; pg8::gemm_phase(lds, g, S, E); }
        grid_bar(ap_ws(), lds);
        if (PH(12)) { PHASE_VARS pg8::Gemm g{1024, 1024, 1024}; pg8::SchedStd S; S.init(ws + WS_XB, ws + W_UP, 1024, 1024, 64, 16, G, bx); EpiUp E{ws}; pg8::gemm_phase(lds, g, S, E); }
        grid_bar(ap_ws(), lds);
        if (PH(13)) { PHASE_VARS pg8::Gemm g{4096, 4096, 4096}; pg8::SchedStd S; S.init(ws + WS_HID, ws + W_DN, 4096, 4096, 64, 4, G, bx); EpiRes E{(const float*)out, out, ws}; pg8::gemm_phase(lds, g, S, E); }
        grid_bar(ap_ws(), lds);
    }
    { PHASE_VARS const float* fn = ap->in[16];
      for (int m = gw; m < TT; m += NGW) { f32x4* xr = (f32x4*)(out + (size_t)m * DM) + lane; f32x4 v[4]; float s = 0.f;
#pragma unroll
          for (int j = 0; j < 4; ++j) { v[j] = xr[64 * j]; s += dot4(v[j]); }
          s = wave_sum(s); const float rs = rsqrtf(s * (1.f / 1024.f) + NEPS);
#pragma unroll
          for (int j = 0; j < 4; ++j) { const f32x4 gsc = *((const f32x4*)fn + lane + 64 * j); xr[64 * j] = v[j] * rs * gsc; } } }
}

extern "C" void kernel_launch(void* const* d_in, const int* in_sizes, int n_in, void* d_out, int out_size, void* d_ws, size_t ws_size, hipStream_t stream) {
    static int grid = 0;
    if (grid == 0) {
        if (n_in != 17 || out_size != TT * DM || ws_size < WS_END) { fprintf(stderr, "kernel_launch: unexpected shapes (n_in %d out %d ws %zu)\n", n_in, out_size, ws_size); grid = -1; return; }
        int dev = 0, cus = 0, per_cu = 0;
        hipGetDevice(&dev); hipDeviceGetAttribute(&cus, hipDeviceAttributeMultiprocessorCount, dev);
        hipFuncSetAttribute((const void*)mega_fwd, hipFuncAttributeMaxDynamicSharedMemorySize, LDS_BYTES);
        hipOccupancyMaxActiveBlocksPerMultiprocessor(&per_cu, (const void*)mega_fwd, 512, LDS_BYTES);
        if (per_cu < 1) per_cu = 1;
        grid = cus * per_cu;
        (void)hipGetLastError();
    }
    if (grid < 0) return;
    Args a{};
    for (int i = 0; i < 17; ++i) a.in[i] = (const float*)d_in[i];
    a.out = (float*)d_out; a.ws = (unsigned char*)d_ws;
    for (int i = 0; i < 16; ++i) a.inv_mla[i] = 1.0f / powf(500000.0f, (float)(2 * i) / 32.0f);
    for (int i = 0; i < 8; ++i) a.inv_moba[i] = 1.0f / powf(500000.0f, (float)(2 * i) / 16.0f);
    for (int i = 0; i < 32; ++i) a.inv_ret[i] = 1.0f / powf(10000.0f, (float)(2 * i) / 64.0f);
    for (int i = 0; i < 4; ++i) a.ret_lg2[i] = (float)log2(1.0 - pow(2.0, -5.0 - (double)i));
    void* kargs[] = {&a};
    hipError_t e = hipLaunchCooperativeKernel((const void*)mega_fwd, dim3(grid), dim3(512), kargs, LDS_BYTES, stream);
    if (e != hipSuccess) fprintf(stderr, "cooperative launch failed: %s (grid %d)\n", hipGetErrorString(e), grid);
}
```

```cpp
#include <hip/hip_runtime.h>
#include <hip/hip_cooperative_groups.h>
#include <cstdio>
#include <cstdint>
#include <cmath>
namespace cg = cooperative_groups;

#define LAS __attribute__((address_space(3)))
typedef unsigned short bf16_t;
typedef short bf16x8 __attribute__((ext_vector_type(8)));
typedef float f32x4 __attribute__((ext_vector_type(4)));
typedef float f32x16 __attribute__((ext_vector_type(16)));
typedef unsigned u32x4 __attribute__((ext_vector_type(4)));
typedef short s16x4 __attribute__((ext_vector_type(4)));
typedef float f32x2_t __attribute__((ext_vector_type(2)));
typedef __bf16 bf16x2_t __attribute__((ext_vector_type(2)));

__device__ __forceinline__ unsigned pk2(float lo, float hi) { f32x2_t v = {lo, hi}; bf16x2_t b = __builtin_convertvector(v, bf16x2_t); return __builtin_bit_cast(unsigned, b); }
__device__ __forceinline__ u32x4 pack8(f32x4 a, f32x4 b) { return (u32x4){pk2(a[0], a[1]), pk2(a[2], a[3]), pk2(b[0], b[1]), pk2(b[2], b[3])}; }
__device__ __forceinline__ void unpack8(u32x4 w, f32x4& a, f32x4& b) {
    a[0] = __uint_as_float(w.x << 16); a[1] = __uint_as_float(w.x & 0xffff0000u); a[2] = __uint_as_float(w.y << 16); a[3] = __uint_as_float(w.y & 0xffff0000u);
    b[0] = __uint_as_float(w.z << 16); b[1] = __uint_as_float(w.z & 0xffff0000u); b[2] = __uint_as_float(w.w << 16); b[3] = __uint_as_float(w.w & 0xffff0000u);
}
__device__ __forceinline__ int opaque_tid() { int t = threadIdx.x; asm volatile("" : "+v"(t)); return t; }
__device__ __forceinline__ float dot4(f32x4 a) { return (a[0] * a[0] + a[1] * a[1]) + (a[2] * a[2] + a[3] * a[3]); }

constexpr int TT = 16384, SS = 4096, DM = 1024;
constexpr float NEPS = 1e-6f, GNEPS = 1e-5f;
constexpr float LOG2E = 1.4426950408889634f;
constexpr size_t MiB = 1u << 20;
constexpr size_t TAB_CM = 0, TAB_SM = 262144, TAB_CB = 524288, TAB_SB = 655360, TAB_CR = 786432, TAB_SR = 1310720;
constexpr size_t WS_SSQX = 2 * MiB, WS_SSQCQ = 3 * MiB, WS_SSQKV = 3 * MiB + 262144, WS_KMP = 3 * MiB + 524288;
constexpr size_t WS_W = 4 * MiB;
constexpr size_t W_IN = WS_W, W_QU = WS_W + 13 * MiB, W_KVU = WS_W + 13 * MiB + 524288, W_BR = WS_W + 14 * MiB, W_OUT = WS_W + 17 * MiB, W_UP = WS_W + 19 * MiB, W_DN = WS_W + 27 * MiB;
constexpr size_t WS_XB = 39 * MiB;
constexpr size_t A0 = 71 * MiB;
constexpr size_t WS_MQ = A0, WS_MK = A0 + 16 * MiB, WS_MV = A0 + 32 * MiB, WS_RQ = A0 + 48 * MiB, WS_RK = A0 + 56 * MiB, WS_RKV = A0 + 64 * MiB, WS_RV = A0 + 80 * MiB,
                 WS_OM = A0 + 96 * MiB, WS_QM = A0 + 112 * MiB, WS_CQ = A0 + 136 * MiB, WS_KVM = A0 + 144 * MiB, WS_CKV = A0 + 176 * MiB, WS_KPE = A0 + 180 * MiB, WS_END = A0 + 181 * MiB;
constexpr size_t WS_GMLA = WS_QM, WS_GMOBA = WS_MK, WS_GRET = WS_KVM, WS_MB = WS_RQ, WS_HID = A0;
constexpr int LDS_BYTES = 147456;
constexpr size_t WS_TS = 1835008 + 16384;
#ifndef PMASK
#define PMASK 0xffff
#endif
#define PH(k) ((PMASK >> (k)) & 1)

struct Args {
    const float* in[17];
    float* out;
    unsigned char* ws;
    float inv_mla[16], inv_moba[8], inv_ret[32], ret_lg2[4];
    int use_cg_sync, pad_;
};

namespace pg8 {
constexpr int BM = 256, BK = 64, HALF = 128, HTB = HALF * BK * 2, STAGE_BYTES = 8 * HTB, NXCD = 8, WGM = 8;
__host__ __device__ __forceinline__ int lds_byte(int r, int c) { const int st = (r >> 4) * 2 + (c >> 5), rr = r & 15, cc = c & 31, ob = rr * 64 + cc * 2; return st * 1024 + (ob ^ (((ob >> 9) & 1) << 5)); }
__host__ __device__ __forceinline__ void stage_rc(int b, int& R, int& C) { const int st = b / 1024, sb = b % 1024, swz = sb ^ (((sb >> 9) & 1) << 5); R = (st >> 1) * 16 + swz / 64; C = (st & 1) * 32 + (swz % 64) / 2; }
__host__ __device__ __forceinline__ int perm32(int rho) { const int n = rho >> 4, i = rho & 15; return 8 * (i >> 2) + 4 * n + (i & 3); }

struct Unit { int pm, pn, aux; const char* a; const char* b; };
struct Gemm { int lda, ldb, K; };

struct SchedStd {
    const char* A; const char* B; int lda, ldb; int nM, nN, nwg, G, c;
    __device__ void init(const void* A_, const void* B_, int lda_, int ldb_, int nM_, int nN_, int G_, int c_) { A = (const char*)A_; B = (const char*)B_; lda = lda_; ldb = ldb_; nM = nM_; nN = nN_; nwg = nM * nN; G = G_; c = c_; }
    __device__ __forceinline__ bool next(int i, Unit& u) const {
        const long L = (long)i * G + c; if (L >= nwg) return false;
        int wgid = (int)L; { const int q = nwg / NXCD, r = nwg % NXCD, xcd = wgid % NXCD, off = wgid / NXCD; wgid = (xcd < r ? xcd * (q + 1) : r * (q + 1) + (xcd - r) * q) + off; }
        const int nig = WGM * nN, gid = wgid / nig, fm = gid * WGM, gsz = (nM - fm) < WGM ? (nM - fm) : WGM;
        u.pm = fm + ((wgid % nig) % gsz); u.pn = (wgid % nig) / gsz; u.aux = 0;
        u.a = A + (size_t)u.pm * BM * lda * 2; u.b = B + (size_t)u.pn * BM * ldb * 2; return true;
    }
};
struct SchedMerge {
    const char* A0; const char* A1; const char* A2; const char* B; int G, c;
    __device__ __forceinline__ bool next(int i, Unit& u) const {
        const int br = i % 3; const long L = (long)(i / 3) * G + c; if (L >= 256) return false;
        int wgid = (int)L; { const int xcd = wgid % NXCD, off = wgid / NXCD; wgid = xcd * 32 + off; }
        const int nN = 4, nig = WGM * nN, gid = wgid / nig, fm = gid * WGM;
        u.pm = fm + ((wgid % nig) % WGM); u.pn = (wgid % nig) / WGM; u.aux = br;
        const char* Ab = br == 0 ? A0 : (br == 1 ? A1 : A2);
        u.a = Ab + (size_t)u.pm * BM * 512 * 2; u.b = B + ((size_t)br * 1024 + (size_t)u.pn * BM) * 512 * 2; return true;
    }
};

template <class Epi, class Sched>
__device__ __forceinline__ void gemm_phase(LAS unsigned char* lds, const Gemm g, const Sched& S, const Epi& E) {
    const int tid = opaque_tid(), wid = __builtin_amdgcn_readfirstlane(tid >> 6), lane = tid & 63, wr = wid >> 2, wc = wid & 3, fr = lane & 15, fq = lane >> 4;
    int K = g.K; asm volatile("" : "+s"(K)); const int nt = K / BK;
    unsigned voffA[2], voffB[2];
#pragma unroll
    for (int i = 0; i < 2; ++i) { int R, C; stage_rc(tid * 16 + i * 8192, R, C); const int Rb = Epi::PERM ? ((R & ~31) + perm32(R & 31)) : R;
        voffA[i] = (unsigned)(R * g.lda + C) * 2u; voffB[i] = (unsigned)(Rb * g.ldb + C) * 2u; }
    const size_t kstep = (size_t)(BK * 2);
    const size_t hstepA = (size_t)HALF * g.lda * 2, hstepB = (size_t)HALF * g.ldb * 2;
    const unsigned ldsw = (unsigned)wid * 1024u;
    const int aoff = lds_byte(wr * 64 + fr, fq * 8), boff = lds_byte(wc * 32 + fr, fq * 8);
#define PG8_SA(b, h) (((b) * 2 + (h)) * HTB)
#define PG8_SB(b, h) ((4 + (b) * 2 + (h)) * HTB)
#define PG8_STAGE(bufoff, gbase, voff) do { _Pragma("unroll") for (int _i = 0; _i < 2; ++_i) \
        __builtin_amdgcn_global_load_lds((const unsigned*)((const char*)(gbase) + (voff)[_i]), (LAS unsigned*)(lds + (bufoff) + ldsw + _i * 8192), 16, 0, 0); } while (0)
#define PG8_LDA(dst, b, h) do { _Pragma("unroll") for (int m = 0; m < 4; ++m) _Pragma("unroll") for (int k = 0; k < 2; ++k) dst[m][k] = *(const LAS bf16x8*)(lds + PG8_SA(b, h) + aoff + m * 2048 + k * 1024); } while (0)
#define PG8_LDB(dst, b, h) do { _Pragma("unroll") for (int n = 0; n < 2; ++n) _Pragma("unroll") for (int k = 0; k < 2; ++k) dst[n][k] = *(const LAS bf16x8*)(lds + PG8_SB(b, h) + boff + n * 2048 + k * 1024); } while (0)
#define PG8_MMA(ai, bj, At, Bt) do { __builtin_amdgcn_s_setprio(1); _Pragma("unroll") for (int m = 0; m < 4; ++m) _Pragma("unroll") for (int n = 0; n < 2; ++n) _Pragma("unroll") for (int k = 0; k < 2; ++k) \
        acc[ai][bj][m][n] = __builtin_amdgcn_mfma_f32_16x16x32_bf16(Bt[n][k], At[m][k], acc[ai][bj][m][n], 0, 0, 0); __builtin_amdgcn_s_setprio(0); } while (0)
#define PG8_WAIT_V(n) asm volatile("s_waitcnt vmcnt(" #n ")" ::: "memory")
#define PG8_WAIT_L(n) asm volatile("s_waitcnt lgkmcnt(" #n ")" ::: "memory")
#define PG8_BAR __builtin_amdgcn_s_barrier()
#define PG8_SCHED __builtin_amdgcn_sched_barrier(0)
    Unit cur, nxt; int ui = 0;
    if (!S.next(0, cur)) return;
    f32x4 acc[2][2][4][2];
#pragma unroll
    for (int a = 0; a < 2; ++a)
#pragma unroll
        for (int b = 0; b < 2; ++b)
#pragma unroll
            for (int m = 0; m < 4; ++m)
#pragma unroll
                for (int n = 0; n < 2; ++n) acc[a][b][m][n] = (f32x4){0.f, 0.f, 0.f, 0.f};
    bf16x8 At[4][2], B0[2][2], B1[2][2];
    const char* cA = cur.a; const char* cB = cur.b;
    PG8_STAGE(PG8_SB(0, 0), cB, voffB); PG8_STAGE(PG8_SB(0, 1), cB + hstepB, voffB); PG8_STAGE(PG8_SA(0, 0), cA, voffA); PG8_STAGE(PG8_SA(0, 1), cA + hstepA, voffA);
    if (wr == 1) PG8_BAR;
    PG8_WAIT_V(2); PG8_BAR;
    PG8_STAGE(PG8_SB(1, 0), cB + kstep, voffB); PG8_STAGE(PG8_SA(1, 0), cA + kstep, voffA); PG8_STAGE(PG8_SB(1, 1), cB + hstepB + kstep, voffB);
    PG8_WAIT_V(6); PG8_BAR;
    for (;;) {
        const bool has_next = S.next(ui + 1, nxt);
        const char* nA = has_next ? nxt.a : cA; const char* nB = has_next ? nxt.b : cB;
        for (int t = 0; t < nt; t += 2) {
            const bool last = (t == nt - 2);
            const char* a1 = cA + (size_t)(t + 1) * kstep;
            const char* a2 = last ? nA : cA + (size_t)(t + 2) * kstep; const char* b2 = last ? nB : cB + (size_t)(t + 2) * kstep;
            const char* a3 = a2 + kstep; const char* b3 = b2 + kstep;
            PG8_LDB(B0, 0, 0); PG8_LDB(B1, 0, 1); PG8_SCHED; PG8_LDA(At, 0, 0); PG8_STAGE(PG8_SA(1, 1), a1 + hstepA, voffA);
            PG8_WAIT_V(8); PG8_WAIT_L(0); PG8_BAR; PG8_MMA(0, 0, At, B0); PG8_MMA(0, 1, At, B1); PG8_BAR; PG8_SCHED;
            PG8_LDA(At, 0, 1); PG8_STAGE(PG8_SB(0, 0), b2, voffB); PG8_STAGE(PG8_SB(0, 1), b2 + hstepB, voffB); PG8_STAGE(PG8_SA(0, 0), a2, voffA);
            PG8_WAIT_V(8); PG8_WAIT_L(0); PG8_BAR; PG8_MMA(1, 0, At, B0); PG8_MMA(1, 1, At, B1); PG8_BAR; PG8_SCHED;
            PG8_LDB(B0, 1, 0); PG8_LDB(B1, 1, 1); PG8_SCHED; PG8_LDA(At, 1, 0); PG8_STAGE(PG8_SA(0, 1), a2 + hstepA, voffA);
            PG8_WAIT_V(8); PG8_WAIT_L(0); PG8_BAR; PG8_MMA(0, 0, At, B0); PG8_MMA(0, 1, At, B1); PG8_BAR; PG8_SCHED;
            PG8_LDA(At, 1, 1); PG8_STAGE(PG8_SB(1, 0), b3, voffB); PG8_STAGE(PG8_SB(1, 1), b3 + hstepB, voffB); PG8_STAGE(PG8_SA(1, 0), a3, voffA);
            PG8_WAIT_V(8); PG8_WAIT_L(0); PG8_BAR; PG8_MMA(1, 0, At, B0); PG8_MMA(1, 1, At, B1); PG8_BAR; PG8_SCHED;
        }
        if (wr == 0) PG8_BAR;
        const bool keep = E(acc, cur, wr, wc, fr, fq);
        if (!has_next) break;
        if (!keep) {
#pragma unroll
        for (int a = 0; a < 2; ++a)
#pragma unroll
            for (int b = 0; b < 2; ++b)
#pragma unroll
                for (int m = 0; m < 4; ++m)
#pragma unroll
                    for (int n = 0; n < 2; ++n) acc[a][b][m][n] = (f32x4){0.f, 0.f, 0.f, 0.f};
        }
        cur = nxt; cA = nA; cB = nB; ++ui;
        if (wr == 1) PG8_BAR;
    }
    PG8_WAIT_V(0);
    PG8_BAR;
#undef PG8_SA
#undef PG8_SB
#undef PG8_STAGE
#undef PG8_LDA
#undef PG8_LDB
#undef PG8_MMA
#undef PG8_WAIT_V
#undef PG8_WAIT_L
#undef PG8_BAR
#undef PG8_SCHED
}
}
using pg8::Unit;

__device__ __forceinline__ float ssq16(const float* p) { const f32x4 a = *(const f32x4*)p, b = *(const f32x4*)(p + 4), c = *(const f32x4*)(p + 8), d = *(const f32x4*)(p + 12);
    return ((a[0] + a[1]) + (a[2] + a[3])) + ((b[0] + b[1]) + (b[2] + b[3])) + ((c[0] + c[1]) + (c[2] + c[3])) + ((d[0] + d[1]) + (d[2] + d[3])); }
__device__ __forceinline__ float ssq4(const float* p) { const f32x4 a = *(const f32x4*)p; return (a[0] + a[1]) + (a[2] + a[3]); }
__device__ __forceinline__ void rope8(f32x4& v0, f32x4& v1, const float* ct, const float* st, int pos, int NF, int fb) {
    const f32x4 c = *(const f32x4*)(ct + (size_t)pos * NF + fb), s = *(const f32x4*)(st + (size_t)pos * NF + fb);
    const f32x4 a = v0 * c - v1 * s, b = v0 * s + v1 * c; v0 = a; v1 = b;
}
#define EPI_ROWLOOP _Pragma("unroll") for (int ai = 0; ai < 2; ++ai) _Pragma("unroll") for (int m = 0; m < 4; ++m)
#define EPI_FENCE asm volatile("" ::: "memory")

#define WSP(T, off) ((T*)(ws + (off)))
constexpr unsigned LDS_RSTAB = 132096;
__device__ __forceinline__ void rstd_table(const unsigned char* ws, int pm) {
    LAS float* rsl = (LAS float*)(size_t)LDS_RSTAB; const int t = threadIdx.x;
    if (t < 256) rsl[t] = rsqrtf(ssq16((const float*)(ws + WS_SSQX) + (size_t)(pm * 256 + t) * 16) * (1.f / 1024.f) + NEPS);
    asm volatile("s_waitcnt lgkmcnt(0)" ::: "memory"); __builtin_amdgcn_s_barrier(); asm volatile("" ::: "memory");
}
#define RSTAB(lrow) (((const LAS float*)(size_t)LDS_RSTAB)[(lrow)])
__device__ __forceinline__ float rstd_x(const unsigned char* ws, int row) { return rsqrtf(ssq16((const float*)(ws + WS_SSQX) + (size_t)row * 16) * (1.f / 1024.f) + NEPS); }
struct EpiP1 {
    static constexpr bool PERM = true;
    unsigned char* ws;
    __device__ __forceinline__ bool operator()(f32x4 (&acc)[2][2][4][2], const Unit& u, int wr, int wc, int fr, int fq) const {
        const int pn = u.pn, row0 = u.pm * 256 + wr * 64 + fr, cl0 = wc * 32 + 8 * fq;
        size_t d0, d1; int l0, l1, c0, c1, md0 = 0, md1 = 0; bool st1 = true; size_t ssqo = 0;
        if (pn == 0) { d0 = d1 = WS_CQ; l0 = l1 = 256; c0 = cl0; c1 = 128 + cl0; ssqo = WS_SSQCQ; }
        else if (pn == 1) { d0 = WS_CKV; l0 = 128; c0 = cl0; d1 = WS_KPE; l1 = 32; c1 = 8 * fq; md1 = 1; st1 = (wc == 0); ssqo = WS_SSQKV; }
        else if (pn < 8) { const int sec = (pn - 2) >> 1; d0 = d1 = WS_MQ + (size_t)sec * (16 * MiB); l0 = l1 = 512; c0 = ((pn - 2) & 1) * 256 + cl0; c1 = c0 + 128; md0 = md1 = (sec < 2) ? 2 : 0; }
        else if (pn < 10) { d0 = d1 = (pn == 8 ? WS_RQ : WS_RK); l0 = l1 = 256; c0 = cl0; c1 = 128 + cl0; md0 = md1 = 3; }
        else { d0 = d1 = WS_RV; l0 = l1 = 512; c0 = (pn - 10) * 256 + cl0; c1 = c0 + 128; }
        const int md = md0 | md1; const int NF = md == 1 ? 16 : (md == 2 ? 8 : 32);
        const float* ct = (const float*)(ws + (md == 1 ? TAB_CM : (md == 2 ? TAB_CB : TAB_CR))); const float* st = (const float*)(ws + (md == 1 ? TAB_SM : (md == 2 ? TAB_SB : TAB_SR)));
        const bool rp0 = md0 == 2 ? ((c0 & 63) < 16) : (md0 != 0), rp1 = md1 == 2 ? ((c1 & 63) < 16) : (md1 != 0);
        const int fb0 = 4 * ((c0 & 63) >> 3), fb1 = 4 * ((c1 & 63) >> 3);
        bf16_t* p0 = (bf16_t*)(ws + d0) + c0; bf16_t* p1 = (bf16_t*)(ws + d1) + c1;
        rstd_table(ws, u.pm); const int lrow0 = wr * 64 + fr;
#pragma unroll
        for (int ai = 0; ai < 2; ++ai)
#pragma unroll
          for (int mp = 0; mp < 4; mp += 2) { f32x4 tc0[2], ts0[2], tc1[2], ts1[2];
#pragma unroll
            for (int q = 0; q < 2; ++q) { const int pos = (row0 + ai * 128 + (mp + q) * 16) & (SS - 1); tc0[q] = ts0[q] = tc1[q] = ts1[q] = (f32x4){0.f, 0.f, 0.f, 0.f};
                if (rp0) { tc0[q] = *(const f32x4*)(ct + (size_t)pos * NF + fb0); ts0[q] = *(const f32x4*)(st + (size_t)pos * NF + fb0); }
                if (rp1) { tc1[q] = *(const f32x4*)(ct + (size_t)pos * NF + fb1); ts1[q] = *(const f32x4*)(st + (size_t)pos * NF + fb1); } }
#pragma unroll
            for (int q = 0; q < 2; ++q) { const int m = mp + q; const int row = row0 + ai * 128 + m * 16; const float rs = RSTAB(lrow0 + ai * 128 + m * 16);
                f32x4 v0 = acc[ai][0][m][0] * rs, v1 = acc[ai][0][m][1] * rs; float ss = 0.f; if (ssqo) ss = dot4(v0) + dot4(v1);
                if (rp0) { const f32x4 a = v0 * tc0[q] - v1 * ts0[q], b = v0 * ts0[q] + v1 * tc0[q]; v0 = a; v1 = b; }
                *(u32x4*)(p0 + (size_t)row * l0) = pack8(v0, v1);
                v0 = acc[ai][1][m][0] * rs; v1 = acc[ai][1][m][1] * rs; if (pn == 0) ss += dot4(v0) + dot4(v1);
                if (rp1) { const f32x4 a = v0 * tc1[q] - v1 * ts1[q], b = v0 * ts1[q] + v1 * tc1[q]; v0 = a; v1 = b; }
                if (st1) *(u32x4*)(p1 + (size_t)row * l1) = pack8(v0, v1);
                if (ssqo) { ss += __shfl_xor(ss, 16); ss += __shfl_xor(ss, 32); if (fq == 0) ((float*)(ws + ssqo))[(size_t)row * 4 + wc] = ss; } }
            EPI_FENCE; }
        return false;
    }
};
struct EpiQU {
    static constexpr bool PERM = true;
    unsigned char* ws;
    __device__ __forceinline__ bool operator()(f32x4 (&acc)[2][2][4][2], const Unit& u, int wr, int wc, int fr, int fq) const {
        const int row0 = u.pm * 256 + wr * 64 + fr, c0 = u.pn * 256 + wc * 32 + 8 * fq;
        const int d0 = c0 % 96, d1 = (c0 + 128) % 96; const bool rp0 = d0 >= 64, rp1 = d1 >= 64; const int fb0 = rp0 ? 4 * ((d0 - 64) >> 3) : 0, fb1 = rp1 ? 4 * ((d1 - 64) >> 3) : 0;
        const float* ct = WSP(const float, TAB_CM); const float* st = WSP(const float, TAB_SM);
        float rsv[2][4];
        EPI_ROWLOOP rsv[ai][m] = rsqrtf(ssq4(WSP(const float, WS_SSQCQ) + (size_t)(row0 + ai * 128 + m * 16) * 4) * (1.f / 256.f) + NEPS);
#pragma unroll
        for (int ai = 0; ai < 2; ++ai)
#pragma unroll
          for (int mp = 0; mp < 4; mp += 2) { f32x4 tc0[2], ts0[2], tc1[2], ts1[2];
#pragma unroll
            for (int q = 0; q < 2; ++q) { const int pos = (row0 + ai * 128 + (mp + q) * 16) & (SS - 1); tc0[q] = ts0[q] = tc1[q] = ts1[q] = (f32x4){0.f, 0.f, 0.f, 0.f};
                if (rp0) { tc0[q] = *(const f32x4*)(ct + (size_t)pos * 16 + fb0); ts0[q] = *(const f32x4*)(st + (size_t)pos * 16 + fb0); }
                if (rp1) { tc1[q] = *(const f32x4*)(ct + (size_t)pos * 16 + fb1); ts1[q] = *(const f32x4*)(st + (size_t)pos * 16 + fb1); } }
#pragma unroll
            for (int q = 0; q < 2; ++q) { const int m = mp + q; const int row = row0 + ai * 128 + m * 16; const float rs = rsv[ai][m];
                f32x4 v0 = acc[ai][0][m][0] * rs, v1 = acc[ai][0][m][1] * rs;
                if (rp0) { const f32x4 a = v0 * tc0[q] - v1 * ts0[q], b = v0 * ts0[q] + v1 * tc0[q]; v0 = a; v1 = b; }
                *(u32x4*)(WSP(bf16_t, WS_QM) + (size_t)row * 768 + c0) = pack8(v0, v1);
                v0 = acc[ai][1][m][0] * rs; v1 = acc[ai][1][m][1] * rs;
                if (rp1) { const f32x4 a = v0 * tc1[q] - v1 * ts1[q], b = v0 * ts1[q] + v1 * tc1[q]; v0 = a; v1 = b; }
                *(u32x4*)(WSP(bf16_t, WS_QM) + (size_t)row * 768 + c0 + 128) = pack8(v0, v1); }
            EPI_FENCE; }
        return false;
    }
};
struct EpiKVU {
    static constexpr bool PERM = true;
    unsigned char* ws;
    __device__ __forceinline__ bool operator()(f32x4 (&acc)[2][2][4][2], const Unit& u, int wr, int wc, int fr, int fq) const {
        const int row0 = u.pm * 256 + wr * 64 + fr, c0 = u.pn * 256 + wc * 32 + 8 * fq;
        float rsv[2][4];
        EPI_ROWLOOP rsv[ai][m] = rsqrtf(ssq4(WSP(const float, WS_SSQKV) + (size_t)(row0 + ai * 128 + m * 16) * 4) * (1.f / 128.f) + NEPS);
        EPI_ROWLOOP { const int row = row0 + ai * 128 + m * 16; const float rs = rsv[ai][m];
#pragma unroll
            for (int bj = 0; bj < 2; ++bj) { const int c = c0 + bj * 128; const f32x4 v0 = acc[ai][bj][m][0] * rs, v1 = acc[ai][bj][m][1] * rs;
                *(u32x4*)(WSP(bf16_t, WS_KVM) + (size_t)row * 1024 + c) = pack8(v0, v1); }
            EPI_FENCE; }
        return false;
    }
};
__device__ __forceinline__ float sigm(float v) { return __builtin_amdgcn_rcpf(1.f + __builtin_amdgcn_exp2f(-LOG2E * v)); }
struct EpiGate {
    static constexpr bool PERM = true;
    unsigned char* ws;
    __device__ __forceinline__ bool operator()(f32x4 (&acc)[2][2][4][2], const Unit& u, int wr, int wc, int fr, int fq) const {
        const int pn = u.pn, row0 = u.pm * 256 + wr * 64 + fr, cl0 = wc * 32 + 8 * fq;
        rstd_table(ws, u.pm); const int lrow0 = wr * 64 + fr;
        if (pn < 12) {
            bf16_t* dst = (pn < 4 ? WSP(bf16_t, WS_GMLA) : (pn < 8 ? WSP(bf16_t, WS_GMOBA) : WSP(bf16_t, WS_GRET))); const int cb0 = (pn & 3) * 256;
            EPI_ROWLOOP { const int row = row0 + ai * 128 + m * 16; const float rs = RSTAB(lrow0 + ai * 128 + m * 16);
#pragma unroll
                for (int bj = 0; bj < 2; ++bj) { const float nrs = -LOG2E * rs; f32x4 v0 = acc[ai][bj][m][0] * nrs, v1 = acc[ai][bj][m][1] * nrs;
#pragma unroll
                    for (int j = 0; j < 4; ++j) { v0[j] = fminf(1.f + __builtin_amdgcn_exp2f(v0[j]), 1e30f); v1[j] = fminf(1.f + __builtin_amdgcn_exp2f(v1[j]), 1e30f); }
                    *(u32x4*)(dst + (size_t)row * 1024 + cb0 + bj * 128 + cl0) = pack8(v0, v1); }
                EPI_FENCE; }
        } else {
            const int cb0 = (pn - 12) * 256;
#pragma unroll
            for (int ai = 0; ai < 2; ++ai) { u32x4 ov[4][2];
#pragma unroll
                for (int m = 0; m < 4; ++m)
#pragma unroll
                    for (int bj = 0; bj < 2; ++bj) ov[m][bj] = *(const u32x4*)(WSP(bf16_t, WS_RV) + (size_t)(row0 + ai * 128 + m * 16) * 512 + cb0 + bj * 128 + cl0);
#pragma unroll
                for (int m = 0; m < 4; ++m) { const int row = row0 + ai * 128 + m * 16; const float rs = RSTAB(lrow0 + ai * 128 + m * 16);
#pragma unroll
                    for (int bj = 0; bj < 2; ++bj) { f32x4 v0 = acc[ai][bj][m][0] * rs, v1 = acc[ai][bj][m][1] * rs; bf16_t* p = WSP(bf16_t, WS_RV) + (size_t)row * 512 + cb0 + bj * 128 + cl0;
                        f32x4 o0, o1; unpack8(ov[m][bj], o0, o1);
#pragma unroll
                        for (int j = 0; j < 4; ++j) { v0[j] = v0[j] * sigm(v0[j]) * o0[j]; v1[j] = v1[j] * sigm(v1[j]) * o1[j]; }
                        *(u32x4*)p = pack8(v0, v1); } }
                EPI_FENCE; }
        }
        return false;
    }
};
struct EpiMerge {
    static constexpr bool PERM = true;
    unsigned char* ws;
    __device__ __forceinline__ bool operator()(f32x4 (&acc)[2][2][4][2], const Unit& u, int wr, int wc, int fr, int fq) const {
        const int br = u.aux, row0 = u.pm * 256 + wr * 64 + fr, c0 = u.pn * 256 + wc * 32 + 8 * fq;
        const bf16_t* Ga = br == 0 ? WSP(bf16_t, WS_GMLA) : (br == 1 ? WSP(bf16_t, WS_GMOBA) : WSP(bf16_t, WS_GRET)); const bf16_t* Gb = br == 0 ? WSP(bf16_t, WS_GMOBA) : WSP(bf16_t, WS_GRET);
#pragma unroll
        for (int ai = 0; ai < 2; ++ai) { u32x4 ga[4][2], gb[4][2];
#pragma unroll
            for (int m = 0; m < 4; ++m)
#pragma unroll
                for (int bj = 0; bj < 2; ++bj) { const size_t off = (size_t)(row0 + ai * 128 + m * 16) * 1024 + c0 + bj * 128; ga[m][bj] = *(const u32x4*)(Ga + off); if (br < 2) gb[m][bj] = *(const u32x4*)(Gb + off); else gb[m][bj] = ga[m][bj]; }
#pragma unroll
            for (int m = 0; m < 4; ++m)
#pragma unroll
                for (int bj = 0; bj < 2; ++bj) { const size_t off = (size_t)(row0 + ai * 128 + m * 16) * 1024 + c0 + bj * 128; f32x4 a0, a1; unpack8(ga[m][bj], a0, a1);
                    if (br < 2) { f32x4 b0, b1; unpack8(gb[m][bj], b0, b1);
#pragma unroll
                        for (int j = 0; j < 4; ++j) { acc[ai][bj][m][0][j] *= b0[j] * __builtin_amdgcn_rcpf(a0[j]); acc[ai][bj][m][1][j] *= b1[j] * __builtin_amdgcn_rcpf(a1[j]); } }
                    else { f32x4 v0 = acc[ai][bj][m][0], v1 = acc[ai][bj][m][1];
#pragma unroll
                        for (int j = 0; j < 4; ++j) { v0[j] *= __builtin_amdgcn_rcpf(a0[j]); v1[j] *= __builtin_amdgcn_rcpf(a1[j]); }
                        *(u32x4*)(WSP(bf16_t, WS_MB) + off) = pack8(v0, v1); } }
            EPI_FENCE; }
        return br < 2;
    }
};
struct EpiRes {
    static constexpr bool PERM = false;
    const float* res; float* out; unsigned char* ws; int wxb;
    __device__ __forceinline__ bool operator()(f32x4 (&acc)[2][2][4][2], const Unit& u, int wr, int wc, int fr, int fq) const {
        const int row0 = u.pm * 256 + wr * 64 + fr, c0 = u.pn * 256 + wc * 32 + 4 * fq;
#pragma unroll
        for (int ai = 0; ai < 2; ++ai) { f32x4 rv[4][2][2];
#pragma unroll
            for (int m = 0; m < 4; ++m)
#pragma unroll
                for (int bj = 0; bj < 2; ++bj)
#pragma unroll
                    for (int n = 0; n < 2; ++n) rv[m][bj][n] = *(const f32x4*)(res + (size_t)(row0 + ai * 128 + m * 16) * 1024 + c0 + bj * 128 + n * 16);
#pragma unroll
            for (int m = 0; m < 4; ++m) { const int row = row0 + ai * 128 + m * 16; float ss = 0.f;
#pragma unroll
                for (int bj = 0; bj < 2; ++bj)
#pragma unroll
                    for (int n = 0; n < 2; ++n) { const size_t off = (size_t)row * 1024 + c0 + bj * 128 + n * 16;
                        const f32x4 v = acc[ai][bj][m][n] + rv[m][bj][n];
                        *(f32x4*)(out + off) = v; ss += dot4(v);
                        if (wxb) { const unsigned lo = pk2(v[0], v[1]), hi2 = pk2(v[2], v[3]); *(unsigned long long*)(WSP(bf16_t, WS_XB) + off) = (unsigned long long)lo | ((unsigned long long)hi2 << 32); } }
                ss += __shfl_xor(ss, 16); ss += __shfl_xor(ss, 32); if (fq == 0) WSP(float, WS_SSQX)[(size_t)row * 16 + u.pn * 4 + wc] = ss; }
            EPI_FENCE; }
        return false;
    }
};
struct EpiUp {
    static constexpr bool PERM = true;
    unsigned char* ws;
    __device__ __forceinline__ bool operator()(f32x4 (&acc)[2][2][4][2], const Unit& u, int wr, int wc, int fr, int fq) const {
        const int row0 = u.pm * 256 + wr * 64 + fr, c0 = u.pn * 256 + wc * 32 + 8 * fq;
        rstd_table(ws, u.pm); const int lrow0 = wr * 64 + fr;
        EPI_ROWLOOP { const int row = row0 + ai * 128 + m * 16; const float rs = RSTAB(lrow0 + ai * 128 + m * 16);
#pragma unroll
            for (int bj = 0; bj < 2; ++bj) { f32x4 v0 = acc[ai][bj][m][0] * rs, v1 = acc[ai][bj][m][1] * rs;
#pragma unroll
                for (int j = 0; j < 4; ++j) { const float a = fmaxf(v0[j], 0.f), b = fmaxf(v1[j], 0.f); v0[j] = a * a; v1[j] = b * b; }
                *(u32x4*)(WSP(bf16_t, WS_HID) + (size_t)row * 4096 + c0 + bj * 128) = pack8(v0, v1); }
            EPI_FENCE; }
        return false;
    }
};

namespace att {
constexpr int KSL = 12288, VSL = 8192;
constexpr int NSL = 4;
constexpr int L_K = 0, L_V = NSL * KSL, L_WS = L_V + NSL * VSL, L_OST = L_WS + 2048, L_SEL = L_OST + 32768, L_UM = L_SEL + 1024, L_KM = L_UM + 64, L_END = L_KM + 4096;
constexpr float NEG = -1e30f;
__device__ __forceinline__ int crow(int r, int hi) { return (r & 3) + 8 * (r >> 2) + 4 * hi; }
__device__ __forceinline__ void glds16(const void* gsrc, unsigned lds_dst) { unsigned keep;
    asm volatile("s_mov_b32 %0, m0\n\ts_mov_b32 m0, %2\n\ts_nop 0\n\tglobal_load_lds_dwordx4 %1, off\n\ts_mov_b32 m0, %0" : "=&s"(keep) : "v"(gsrc), "s"(lds_dst) : "memory"); }
__device__ __forceinline__ unsigned long long blk_list(unsigned um, int qb, bool own_first) { unsigned long long l = 0ull; int i = 0; if (own_first) { l = (unsigned long long)qb; i = 1; }
    for (; um; um &= um - 1u, ++i) l |= (unsigned long long)__builtin_ctz(um) << (4 * i); for (; i < 16; ++i) l |= (unsigned long long)qb << (4 * i); return l; }
#define nth_block(um, bi, qb) ((int)((blist >> (4 * (bi))) & 15ull))
__device__ __forceinline__ void pv(f32x16* o, int vb, bf16x8 pa0, bf16x8 pa1, bf16x8 pa2, bf16x8 pa3) {
#pragma unroll
    for (int d0 = 0; d0 < 2; ++d0) { s16x4 lo[4], hi[4];
#pragma unroll
        for (int ks = 0; ks < 4; ++ks) {
            asm volatile("ds_read_b64_tr_b16 %0,%1 offset:%c2" : "=&v"(lo[ks]) : "v"(vb), "i"(d0 * 4096 + ks * 1024) : "memory");
            asm volatile("ds_read_b64_tr_b16 %0,%1 offset:%c2" : "=&v"(hi[ks]) : "v"(vb), "i"(d0 * 4096 + ks * 1024 + 512) : "memory"); }
        asm volatile("s_waitcnt lgkmcnt(0)" ::: "memory"); __builtin_amdgcn_sched_barrier(0);
#define PK(k) (bf16x8){lo[k][0], lo[k][1], lo[k][2], lo[k][3], hi[k][0], hi[k][1], hi[k][2], hi[k][3]}
        o[d0] = __builtin_amdgcn_mfma_f32_32x32x16_bf16(pa0, PK(0), o[d0], 0, 0, 0);
        o[d0] = __builtin_amdgcn_mfma_f32_32x32x16_bf16(pa1, PK(1), o[d0], 0, 0, 0);
        o[d0] = __builtin_amdgcn_mfma_f32_32x32x16_bf16(pa2, PK(2), o[d0], 0, 0, 0);
        o[d0] = __builtin_amdgcn_mfma_f32_32x32x16_bf16(pa3, PK(3), o[d0], 0, 0, 0);
#undef PK
    }
}
#define ATT_WAITBAR() asm volatile("s_waitcnt vmcnt(0) lgkmcnt(0)\n\ts_barrier" ::: "memory")
__device__ __forceinline__ float max3a(float a, float b, float c) { float r; asm("v_max3_f32 %0, %1, %2, %3" : "=v"(r) : "v"(a), "v"(b), "v"(c)); return r; }
__device__ __forceinline__ float max2a(float a, float b) { float r; asm("v_max_f32_e32 %0, %1, %2" : "=v"(r) : "v"(a), "v"(b)); return r; }

template <int DQ, bool ROWSEL>
__device__ __forceinline__ void attn_unit(long rowbase, int qb, const bf16_t* Qh, int ldq, const bf16_t* Kh, int ldk, const bf16_t* Kpe, const bf16_t* Vh, int ldv, bf16_t* Oh, int ldo,
                                          LAS unsigned char* lds, unsigned umask) {
    const int tid = opaque_tid(), lane = tid & 63, r32 = lane & 31, hi = lane >> 5; const int wid = __builtin_amdgcn_readfirstlane(tid >> 6);
    const int q0 = qb * 256;
    const unsigned lds0 = (unsigned)(uintptr_t)lds;
    LAS float* wsf = (LAS float*)(lds + L_WS) + wid * 64;
    umask = (unsigned)__builtin_amdgcn_readfirstlane((int)umask);
    const int npast = __builtin_popcount(umask), NT = 4 * (npast + 1);
    const unsigned long long blist = blk_list(umask, qb, ROWSEL);
    const bf16_t* kl_ = Kh + (rowbase + lane) * ldk + wid * 8;
    const bf16_t* pl_ = (DQ == 96) ? Kpe + (rowbase + lane) * 32 + wid * 8 : Kh;
    const bf16_t* vl_ = Vh + (rowbase + 16 * (wid & 3) + (lane >> 2)) * ldv + (wid >> 2) * 32 + (lane & 3) * 8;
#define ATT_ISSUE(key0, slot) do { const long ko_ = (long)(key0); \
        glds16(kl_ + ko_ * ldk, (unsigned)__builtin_amdgcn_readfirstlane((int)(lds0 + L_K + (slot) * KSL + wid * 1024))); \
        if (DQ == 96 && wid < 4) glds16(pl_ + ko_ * 32, (unsigned)__builtin_amdgcn_readfirstlane((int)(lds0 + L_K + (slot) * KSL + (8 + wid) * 1024))); \
        glds16(vl_ + ko_ * ldv, (unsigned)__builtin_amdgcn_readfirstlane((int)(lds0 + L_V + (slot) * VSL + wid * 1024))); } while (0)
    bf16x8 qr[DQ / 16];
    { const bf16_t* Qw = Qh + (rowbase + q0 + wid * 32 + r32) * ldq + hi * 8;
#pragma unroll
      for (int d0 = 0; d0 < DQ / 16; ++d0) qr[d0] = *(const bf16x8*)(Qw + d0 * 16); }
#define ATT_WAITK(k) do { if (DQ == 96 && wid < 4) { if ((k) == 2) asm volatile("s_waitcnt vmcnt(6)" ::: "memory"); else if ((k) == 1) asm volatile("s_waitcnt vmcnt(3)" ::: "memory"); else asm volatile("s_waitcnt vmcnt(0)" ::: "memory"); } \
        else { if ((k) == 2) asm volatile("s_waitcnt vmcnt(4)" ::: "memory"); else if ((k) == 1) asm volatile("s_waitcnt vmcnt(2)" ::: "memory"); else asm volatile("s_waitcnt vmcnt(0)" ::: "memory"); } } while (0)
    ATT_ISSUE(nth_block(umask, 0, qb) * 256, 0); ATT_ISSUE(nth_block(umask, 0, qb) * 256 + 64, 1); ATT_ISSUE(nth_block(umask, 0, qb) * 256 + 128, 2);
    unsigned rowsel = 0xffffffffu; if (ROWSEL) rowsel = *(const LAS unsigned*)(lds + L_SEL + (wid * 32 + r32) * 4);
    float m_run = NEG, l_run = 0.f; f32x16 o[2]; o[0] = f32x16{}; o[1] = f32x16{};
    const int qrel = wid * 32 + r32;
    const int vb0 = (int)(lds0 + L_V) + ((lane >> 4) & 1) * 32 + (lane & 3) * 8 + (4 * hi + ((lane & 15) >> 2)) * 64;
    ATT_WAITK(2); asm volatile("s_waitcnt lgkmcnt(0)\n\ts_barrier" ::: "memory");
    constexpr int NP = DQ / 16;
#define SBAR() __builtin_amdgcn_sched_barrier(0)
#define EX2(x) __builtin_amdgcn_exp2f(x)
#define VTR(dst, off) asm volatile("ds_read_b64_tr_b16 %0,%1 offset:%c2" : "=&v"(dst) : "v"(vb_), "i"(off) : "memory")
#define MASK_TILE(P0, P1, tt) do { const int blk_ = nth_block(umask, (tt) >> 2, qb); \
        if (blk_ == qb) { const int kb = 64 * ((tt) & 3) + 4 * hi; \
            _Pragma("unroll") for (int r = 0; r < 16; ++r) { const int kv = kb + (r & 3) + 8 * (r >> 2); if (kv > qrel) P0[r] = NEG; if (kv + 32 > qrel) P1[r] = NEG; } \
        } } while (0)
#define ROWMAX_FIN(a_, b_, X0, X1) do { float rm_ = max2a(a_, b_); auto rr_ = __builtin_amdgcn_permlane32_swap(__float_as_uint(rm_), __float_as_uint(rm_), false, false); \
        rm_ = max2a(__uint_as_float(rr_[0]), __uint_as_float(rr_[1])); \
        if (NEGM) {   \
            if (__any(rm_ > 8.0f)) { const float dl_ = fmaxf(rm_, 0.f); m_run += dl_; fsc = EX2(-dl_); cupd = true; \
                _Pragma("unroll") for (int r = 0; r < 16; ++r) { X0[r] -= dl_; X1[r] -= dl_; } } else fsc = 1.f; } \
        else if (__any(rm_ - m_run > 8.0f)) { mn = fmaxf(m_run, rm_); fsc = EX2(m_run - mn); m_run = mn; } else { fsc = 1.f; mn = m_run; } } while (0)
#define ATT_STEP(MORE, P0, P1, N0, N1) do { \
        const int s = t & 3; \
        if (t + 3 < NT) { const int nb = nth_block(umask, (t + 3) >> 2, qb); ATT_ISSUE(nb * 256 + ((t + 3) & 3) * 64, (t + 3) & 3); } \
        const int vb_ = vb0 + s * VSL; const LAS unsigned char* kp_ = lds + L_K + ((t + 1) & 3) * KSL + hi * 1024 + r32 * 16; \
        const float mnc = mn, fc = fsc; s16x4 vlo[8], vhi[8]; bf16x8 ka = bf16x8{}, kb2 = bf16x8{}; \
        if (MORE) { ka = *(const LAS bf16x8*)(kp_); kb2 = *(const LAS bf16x8*)(kp_ + 512); } \
        SBAR(); \
        _Pragma("unroll") for (int i = 0; i < NP; ++i) { \
            if (MORE) { if (i == 0) { N0 = __builtin_amdgcn_mfma_f32_32x32x16_bf16(ka, qr[0], NEGM ? negm : f32x16{}, 0, 0, 0); N1 = __builtin_amdgcn_mfma_f32_32x32x16_bf16(kb2, qr[0], NEGM ? negm : f32x16{}, 0, 0, 0); } \
                        else { N0 = __builtin_amdgcn_mfma_f32_32x32x16_bf16(ka, qr[i], N0, 0, 0, 0); N1 = __builtin_amdgcn_mfma_f32_32x32x16_bf16(kb2, qr[i], N1, 0, 0, 0); } } \
            if (MORE && i + 1 < NP) { ka = *(const LAS bf16x8*)(kp_ + (i + 1) * 2048); kb2 = *(const LAS bf16x8*)(kp_ + (i + 1) * 2048 + 512); } \
            _Pragma("unroll") for (int v = (i * 8) / NP; v < ((i + 1) * 8) / NP; ++v) { const int q_ = v >> 1, idx = (q_ & 1) + 4 * (q_ >> 1), off = (idx >> 2) * 4096 + (idx & 3) * 1024 + (v & 1) * 512; if (v & 1) VTR(vhi[idx], off); else VTR(vlo[idx], off); }     \
            _Pragma("unroll") for (int e = (i * 32) / NP; e < ((i + 1) * 32) / NP; ++e) { if (e < 16) P0[e] = NEGM ? EX2(P0[e]) : EX2(P0[e] - mnc); else P1[e - 16] = NEGM ? EX2(P1[e - 16]) : EX2(P1[e - 16] - mnc); } \
            asm volatile("" : "+v"(P0), "+v"(P1)); SBAR(); } \
        const u32x4 pw0 = (u32x4){pk2(P0[0], P0[1]), pk2(P0[2], P0[3]), pk2(P0[4], P0[5]), pk2(P0[6], P0[7])}, pw1 = (u32x4){pk2(P0[8], P0[9]), pk2(P0[10], P0[11]), pk2(P0[12], P0[13]), pk2(P0[14], P0[15])}; \
        const u32x4 pw2 = (u32x4){pk2(P1[0], P1[1]), pk2(P1[2], P1[3]), pk2(P1[4], P1[5]), pk2(P1[6], P1[7])}, pw3 = (u32x4){pk2(P1[8], P1[9]), pk2(P1[10], P1[11]), pk2(P1[12], P1[13]), pk2(P1[14], P1[15])}; \
        asm volatile("s_waitcnt lgkmcnt(0)" ::: "memory"); \
        if (__any(fc != 1.f)) { if (hi == 0) wsf[r32] = fc; asm volatile("s_waitcnt lgkmcnt(0)" ::: "memory"); \
            _Pragma("unroll") for (int r = 0; r < 16; ++r) { const float fr_ = wsf[crow(r, hi)]; o[0][r] *= fr_; o[1][r] *= fr_; } \
            asm volatile("s_waitcnt lgkmcnt(0)" ::: "memory"); } \
        if (MORE) MASK_TILE(N0, N1, t + 1); \
        SBAR(); \
        float ma = NEG, mb = NEG, sa = 0.f, sb2 = 0.f; \
        _Pragma("unroll") for (int j = 0; j < 8; ++j) { const int d = j & 1, k = j >> 1; \
            if (j == 4) asm volatile("s_waitcnt lgkmcnt(0)" ::: "memory"); \
            const bf16x8 vf = (bf16x8){vlo[d * 4 + k][0], vlo[d * 4 + k][1], vlo[d * 4 + k][2], vlo[d * 4 + k][3], vhi[d * 4 + k][0], vhi[d * 4 + k][1], vhi[d * 4 + k][2], vhi[d * 4 + k][3]}; \
            const bf16x8 pa = __builtin_bit_cast(bf16x8, k == 0 ? pw0 : (k == 1 ? pw1 : (k == 2 ? pw2 : pw3))); \
            o[d] = __builtin_amdgcn_mfma_f32_32x32x16_bf16(pa, vf, o[d], 0, 0, 0); \
            if (MORE) { ma = max3a(ma, N0[2 * j], N0[2 * j + 1]); mb = max3a(mb, N1[2 * j], N1[2 * j + 1]); } \
            sa += P0[2 * j] + P0[2 * j + 1]; sb2 += P1[2 * j] + P1[2 * j + 1]; \
            if (j < 4) { const int idx2 = (j & 1) * 4 + 2 + (j >> 1), off2 = (idx2 >> 2) * 4096 + (idx2 & 3) * 1024; VTR(vlo[idx2], off2); VTR(vhi[idx2], off2 + 512); } \
            asm volatile("" : "+v"(sa), "+v"(sb2), "+v"(ma), "+v"(mb)); SBAR(); } \
        l_run = l_run * fc + (sa + sb2); \
        if (MORE) { bool cupd = false; ROWMAX_FIN(ma, mb, N0, N1); \
            if (cupd || (ROWSEL && ((t + 2) & 3) == 0)) { const int nb_ = nth_block(umask, (t + 2) >> 2, qb); \
                const float cv_ = (!ROWSEL || nb_ == qb || ((rowsel >> nb_) & 1u)) ? -m_run : NEG; \
                _Pragma("unroll") for (int r = 0; r < 16; ++r) negm[r] = cv_; } } \
        { const int k_ = (t + 3 < NT) ? 1 : 0; ATT_WAITK(k_); asm volatile("s_waitcnt lgkmcnt(0)\n\ts_barrier" ::: "memory"); } \
    } while (0)
    constexpr bool NEGM = true;
    f32x16 pa0, pa1, pb0, pb1, negm = f32x16{}; float mn = NEG, fsc = 1.f;
    { const LAS unsigned char* kp_ = lds + L_K + hi * 1024 + r32 * 16; pa0 = f32x16{}; pa1 = f32x16{};
#pragma unroll
      for (int d0 = 0; d0 < NP; ++d0) { const bf16x8 b0_ = *(const LAS bf16x8*)(kp_ + d0 * 2048), b1_ = *(const LAS bf16x8*)(kp_ + d0 * 2048 + 512);
          pa0 = __builtin_amdgcn_mfma_f32_32x32x16_bf16(b0_, qr[d0], pa0, 0, 0, 0); pa1 = __builtin_amdgcn_mfma_f32_32x32x16_bf16(b1_, qr[d0], pa1, 0, 0, 0); } }
    MASK_TILE(pa0, pa1, 0);
    { float ma = NEG, mb = NEG; bool cupd = false; (void)cupd;
#pragma unroll
      for (int j = 0; j < 8; ++j) { ma = fmaxf(ma, fmaxf(pa0[2 * j], pa0[2 * j + 1])); mb = fmaxf(mb, fmaxf(pa1[2 * j], pa1[2 * j + 1])); }
      if (NEGM) { float rm_ = fmaxf(ma, mb); auto rr_ = __builtin_amdgcn_permlane32_swap(__float_as_uint(rm_), __float_as_uint(rm_), false, false); rm_ = fmaxf(__uint_as_float(rr_[0]), __uint_as_float(rr_[1]));
          m_run = rm_; fsc = 1.f;
#pragma unroll
          for (int r = 0; r < 16; ++r) { pa0[r] -= rm_; pa1[r] -= rm_; negm[r] = -rm_; } }
      else ROWMAX_FIN(ma, mb, pa0, pa1); }
    ATT_WAITK(1); asm volatile("s_waitcnt lgkmcnt(0)\n\ts_barrier" ::: "memory");
    int t = 0;
    for (; t < NT - 2; t += 2) { ATT_STEP(true, pa0, pa1, pb0, pb1); ++t; ATT_STEP(true, pb0, pb1, pa0, pa1); --t; }
    ATT_STEP(true, pa0, pa1, pb0, pb1); ++t;
    ATT_STEP(false, pb0, pb1, pa0, pa1);
#undef ATT_STEP
#undef ROWMAX_FIN
#undef MASK_TILE
#undef VTR
#undef EX2
#undef SBAR
#undef ATT_ISSUE
#undef ATT_WAITK
    { auto rr = __builtin_amdgcn_permlane32_swap(__float_as_uint(l_run), __float_as_uint(l_run), false, false); l_run = __uint_as_float(rr[0]) + __uint_as_float(rr[1]); }
    if (hi == 0) wsf[32 + r32] = l_run; asm volatile("s_waitcnt lgkmcnt(0)" ::: "memory");
    float rli[16];
#pragma unroll
    for (int r = 0; r < 16; ++r) rli[r] = __builtin_amdgcn_rcpf(wsf[32 + crow(r, hi)]);
    bf16_t* Ow = Oh + (rowbase + q0 + wid * 32) * ldo;
    { LAS bf16_t* stg = (LAS bf16_t*)(lds + L_OST) + wid * 2048;
#pragma unroll
      for (int r = 0; r < 16; ++r) { const int orow = crow(r, hi);
#pragma unroll
          for (int d0 = 0; d0 < 2; ++d0) stg[orow * 64 + d0 * 32 + r32] = (bf16_t)(pk2(o[d0][r] * rli[r], 0.f) & 0xffffu); }
      asm volatile("s_waitcnt lgkmcnt(0)" ::: "memory");
#pragma unroll
      for (int i = 0; i < 4; ++i) { const int row = i * 8 + (lane >> 3), ch = lane & 7; const u32x4 v = *(const LAS u32x4*)(stg + row * 64 + ch * 8); *(u32x4*)(Ow + (long)row * ldo + ch * 8) = v; } }
    ATT_WAITBAR();
}
}

__device__ __forceinline__ f32x16 mfma32f(float a, float b, f32x16 c) { return __builtin_amdgcn_mfma_f32_32x32x2f32(a, b, c, 0, 0, 0); }
__device__ __forceinline__ bf16x8 ldpack(const LAS float* p, int stride) {
    const u32x4 w = (u32x4){pk2(p[0], p[stride]), pk2(p[2 * stride], p[3 * stride]), pk2(p[4 * stride], p[5 * stride]), pk2(p[6 * stride], p[7 * stride])};
    return __builtin_bit_cast(bf16x8, w);
}
__device__ __forceinline__ f32x16 mfma16b(bf16x8 a, bf16x8 b, f32x16 c) { return __builtin_amdgcn_mfma_f32_32x32x16_bf16(a, b, c, 0, 0, 0); }
__device__ __forceinline__ float ex2(float x) { return __builtin_amdgcn_exp2f(x); }

__device__ __forceinline__ void ret_kv_unit(int un, const bf16_t* RK, const bf16_t* RV, float* RKV, const float* lg2p, LAS unsigned char* lds) {
    const int tid = opaque_tid(), lane = tid & 63, r32 = lane & 31, hi = lane >> 5, wid = tid >> 6;
    const int bh = un >> 5, n = un & 31, b = bh >> 2, h = bh & 3; const long r0 = (long)b * SS + n * 128; const float lg = lg2p[h];
    LAS float* Kz = (LAS float*)lds; LAS float* Vs = (LAS float*)(lds + 32768);
    { const int row = tid >> 2, cs = (tid & 3) * 16; const float z = ex2(lg * (float)(127 - row)); const bf16_t* p = RK + (r0 + row) * 256 + h * 64 + cs;
      f32x4 a, bq; unpack8(*(const u32x4*)p, a, bq); *(LAS f32x4*)(Kz + row * 64 + cs) = a * z; *(LAS f32x4*)(Kz + row * 64 + cs + 4) = bq * z;
      unpack8(*(const u32x4*)(p + 8), a, bq); *(LAS f32x4*)(Kz + row * 64 + cs + 8) = a * z; *(LAS f32x4*)(Kz + row * 64 + cs + 12) = bq * z;
      const int vs = (tid & 3) * 32; const bf16_t* pv_ = RV + (r0 + row) * 512 + h * 128 + vs;
#pragma unroll
      for (int i = 0; i < 4; ++i) { unpack8(*(const u32x4*)(pv_ + 8 * i), a, bq); *(LAS f32x4*)(Vs + row * 128 + vs + 8 * i) = a; *(LAS f32x4*)(Vs + row * 128 + vs + 8 * i + 4) = bq; } }
    __syncthreads();
    const int dt = wid >> 2, et = wid & 3; f32x16 acc = f32x16{};
#pragma unroll 2
    for (int j0 = 0; j0 < 128; j0 += 16) acc = mfma16b(ldpack(Kz + (j0 + 8 * hi) * 64 + dt * 32 + r32, 64), ldpack(Vs + (j0 + 8 * hi) * 128 + et * 32 + r32, 128), acc);
    float* dst = RKV + (size_t)un * 8192;
#pragma unroll
    for (int r = 0; r < 16; ++r) dst[(dt * 32 + att::crow(r, hi)) * 128 + et * 32 + r32] = acc[r];
    __syncthreads();
}
__device__ __forceinline__ void ret_out_unit(int un, const bf16_t* RQ, const bf16_t* RK, bf16_t* RV, const float* RKV, const float* gnw, const float* gnb, const float* lg2p, LAS unsigned char* lds) {
    const int tid = opaque_tid(), lane = tid & 63, r32 = lane & 31, hi = lane >> 5, wid = tid >> 6;
    const int bh = un >> 5, n = un < 256 ? (un & 31) : 31 - (un & 31), b = bh >> 2, h = bh & 3; const long r0 = (long)b * SS + n * 128; const float lg = lg2p[h];
    LAS float* Qs = (LAS float*)lds; LAS float* Ks = (LAS float*)(lds + 33280); LAS float* Rs = (LAS float*)(lds + 66560); LAS float* Sm = (LAS float*)(lds + 66560); LAS float* Vs = (LAS float*)lds;
    { const int row = tid >> 2, cs = (tid & 3) * 16; const bf16_t* pq = RQ + (r0 + row) * 256 + h * 64 + cs; const bf16_t* pk = RK + (r0 + row) * 256 + h * 64 + cs;
      f32x4 a, bq;
#pragma unroll
      for (int i = 0; i < 2; ++i) { unpack8(*(const u32x4*)(pq + 8 * i), a, bq);
#pragma unroll
          for (int j = 0; j < 4; ++j) { Qs[row * 65 + cs + 8 * i + j] = a[j]; Qs[row * 65 + cs + 8 * i + 4 + j] = bq[j]; }
          unpack8(*(const u32x4*)(pk + 8 * i), a, bq);
#pragma unroll
          for (int j = 0; j < 4; ++j) { Ks[row * 65 + cs + 8 * i + j] = a[j]; Ks[row * 65 + cs + 8 * i + 4 + j] = bq[j]; } }
      { f32x4 r0 = (f32x4){0.f, 0.f, 0.f, 0.f}, r1 = r0, r2 = r0, r3 = r0; const float* base = RKV + (size_t)(bh * 32) * 8192 + tid * 4; int j = 0;
#pragma unroll 1
        for (; j + 7 < n; j += 8) { const float* p = base + (size_t)j * 8192; f32x4 a[8][4];
#pragma unroll
            for (int u = 0; u < 8; ++u)
#pragma unroll
                for (int q = 0; q < 4; ++q) a[u][q] = *(const f32x4*)(p + u * 8192 + q * 2048);
#pragma unroll
            for (int u = 0; u < 8; ++u) { const float w = ex2(lg * 128.0f * (float)(n - 1 - j - u)); r0 += a[u][0] * w; r1 += a[u][1] * w; r2 += a[u][2] * w; r3 += a[u][3] * w; } }
#pragma unroll 1
        for (; j + 3 < n; j += 4) { const float* p = base + (size_t)j * 8192; f32x4 a[4][4];
#pragma unroll
            for (int u = 0; u < 4; ++u)
#pragma unroll
                for (int q = 0; q < 4; ++q) a[u][q] = *(const f32x4*)(p + u * 8192 + q * 2048);
#pragma unroll
            for (int u = 0; u < 4; ++u) { const float w = ex2(lg * 128.0f * (float)(n - 1 - j - u)); r0 += a[u][0] * w; r1 += a[u][1] * w; r2 += a[u][2] * w; r3 += a[u][3] * w; } }
#pragma unroll 1
        for (; j < n; ++j) { const float w0 = ex2(lg * 128.0f * (float)(n - 1 - j)); const float* p = base + (size_t)j * 8192;
            r0 += *(const f32x4*)(p) * w0; r1 += *(const f32x4*)(p + 2048) * w0; r2 += *(const f32x4*)(p + 4096) * w0; r3 += *(const f32x4*)(p + 6144) * w0; }
        *(LAS f32x4*)(Rs + tid * 4) = r0; *(LAS f32x4*)(Rs + tid * 4 + 2048) = r1; *(LAS f32x4*)(Rs + tid * 4 + 4096) = r2; *(LAS f32x4*)(Rs + tid * 4 + 6144) = r3; } }
    __syncthreads();
    const int it = wid >> 1, eh = wid & 1; f32x16 acc0 = f32x16{}, acc1 = f32x16{};
    bf16x8 qa[4];
#pragma unroll
    for (int ks = 0; ks < 4; ++ks) { qa[ks] = ldpack(Qs + (32 * it + r32) * 65 + 16 * ks + 8 * hi, 1);
        acc0 = mfma16b(qa[ks], ldpack(Rs + (16 * ks + 8 * hi) * 128 + 64 * eh + r32, 128), acc0); acc1 = mfma16b(qa[ks], ldpack(Rs + (16 * ks + 8 * hi) * 128 + 64 * eh + 32 + r32, 128), acc1); }
#pragma unroll
    for (int r = 0; r < 16; ++r) { const float xi = ex2(lg * (float)(32 * it + att::crow(r, hi) + 1)); acc0[r] *= xi; acc1[r] *= xi; }
    __syncthreads();
#pragma unroll
    for (int jj = 0; jj < 2; ++jj) { const int jt = 2 * eh + jj; if (jt <= it) { f32x16 s = f32x16{};
#pragma unroll
        for (int ks = 0; ks < 4; ++ks) s = mfma16b(qa[ks], ldpack(Ks + (32 * jt + r32) * 65 + 16 * ks + 8 * hi, 1), s);
#pragma unroll
        for (int r = 0; r < 16; ++r) { const int i = 32 * it + att::crow(r, hi), j = 32 * jt + r32; Sm[i * 129 + j] = (i >= j) ? s[r] * ex2(lg * (float)(i - j)) : 0.f; } } }
    __syncthreads();
    { const int row = tid >> 2, vs = (tid & 3) * 32; const bf16_t* pv_ = RV + (r0 + row) * 512 + h * 128 + vs; f32x4 a, bq;
#pragma unroll
      for (int i = 0; i < 4; ++i) { unpack8(*(const u32x4*)(pv_ + 8 * i), a, bq); *(LAS f32x4*)(Vs + row * 128 + vs + 8 * i) = a; *(LAS f32x4*)(Vs + row * 128 + vs + 8 * i + 4) = bq; } }
    __syncthreads();
    { const int jend = 32 * (it + 1);
#pragma unroll 2
      for (int j0 = 0; j0 < jend; j0 += 16) { const bf16x8 a = ldpack(Sm + (32 * it + r32) * 129 + j0 + 8 * hi, 1);
          acc0 = mfma16b(a, ldpack(Vs + (j0 + 8 * hi) * 128 + 64 * eh + r32, 128), acc0); acc1 = mfma16b(a, ldpack(Vs + (j0 + 8 * hi) * 128 + 64 * eh + 32 + r32, 128), acc1); } }
    __syncthreads();
#pragma unroll
    for (int r = 0; r < 16; ++r) { const int i = 32 * it + att::crow(r, hi); Sm[i * 129 + 64 * eh + r32] = acc0[r]; Sm[i * 129 + 64 * eh + 32 + r32] = acc1[r]; }
    __syncthreads();
    { const int row = tid >> 2, q4 = tid & 3; float v[32]; float s = 0.f;
#pragma unroll
      for (int k = 0; k < 32; ++k) { v[k] = Sm[row * 129 + q4 * 32 + k]; s += v[k]; }
      s += __shfl_xor(s, 1); s += __shfl_xor(s, 2); const float mu = s * (1.f / 128.f); float q = 0.f;
#pragma unroll
      for (int k = 0; k < 32; ++k) { v[k] -= mu; q += v[k] * v[k]; }
      q += __shfl_xor(q, 1); q += __shfl_xor(q, 2); const float rstd = rsqrtf(q * (1.f / 128.f) + GNEPS);
      const float* gw = gnw + h * 128 + q4 * 32; const float* gb = gnb + h * 128 + q4 * 32; bf16_t* po = RV + (r0 + row) * 512 + h * 128 + q4 * 32;
#pragma unroll
      for (int i = 0; i < 4; ++i) { f32x4 a, bq; const f32x4 w0 = *(const f32x4*)(gw + 8 * i), w1 = *(const f32x4*)(gw + 8 * i + 4), b0 = *(const f32x4*)(gb + 8 * i), b1 = *(const f32x4*)(gb + 8 * i + 4);
#pragma unroll
          for (int j = 0; j < 4; ++j) { a[j] = v[8 * i + j] * rstd * w0[j] + b0[j]; bq[j] = v[8 * i + 4 + j] * rstd * w1[j] + b1[j]; }
          *(u32x4*)(po + 8 * i) = pack8(a, bq); } }
    __syncthreads();
}

__device__ __forceinline__ float wave_sum(float v) {
#pragma unroll
    for (int o = 1; o < 64; o <<= 1) v += __shfl_xor(v, o);
    return v;
}
__device__ __forceinline__ void sincos_acc(float ang, float& s, float& c) {
    const double a = (double)ang; const double k = rint(a * 0.63661977236758134308); const double r = a - k * 1.57079632679489661923; const double r2 = r * r;
    const double sr = r * (1.0 + r2 * (-1.0 / 6 + r2 * (1.0 / 120 + r2 * (-1.0 / 5040 + r2 * (1.0 / 362880 + r2 * (-1.0 / 39916800 + r2 * (1.0 / 6227020800.0)))))));
    const double cr = 1.0 + r2 * (-0.5 + r2 * (1.0 / 24 + r2 * (-1.0 / 720 + r2 * (1.0 / 40320 + r2 * (-1.0 / 3628800 + r2 * (1.0 / 479001600.0 - r2 * (1.0 / 87178291200.0)))))));
    const int q = ((int)k) & 3;
    const double sv = (q == 0) ? sr : (q == 1) ? cr : (q == 2) ? -sr : -cr, cv = (q == 0) ? cr : (q == 1) ? -sr : (q == 2) ? -cr : sr;
    s = (float)sv; c = (float)cv;
}
__device__ __forceinline__ int perm_pair(int d, int half) { const int i = d < half ? d : d - half; return 8 * (i >> 2) + (i & 3) + (d < half ? 0 : 4); }

__device__ __forceinline__ void map_row(int kind, int n, int& row, float& sc) {
    const float c2m = 0.125f * LOG2E, c2q = 0.10206207261596575f * LOG2E;
    sc = 1.f; row = n;
    if (kind == 1) {
        if (n < 384) row = n;
        else if (n < 416) row = 384 + perm_pair(n - 384, 16);
        else if (n < 1952) { const int s = n - 416, sec = s >> 9, w = s & 511, hd = w >> 6, d = w & 63; row = 512 + sec * 512 + hd * 64 + ((sec < 2 && d < 16) ? perm_pair(d, 8) : d); if (sec == 0) sc = c2m; }
        else if (n < 2464) { const int s = n - 1952, sec = s >> 8, hd = (s & 255) >> 6, d = s & 63; row = 2048 + sec * 256 + hd * 64 + perm_pair(d, 32); if (sec == 1) sc = 0.125f; }
        else if (n < 2976) row = 2560 + (n - 2464);
        else if (n < 3488) row = 6144 + (n - 2976);
        else row = 3072 + (n - 3488);
    } else if (kind == 2) { const int hd = n / 96, d = n % 96; row = hd * 96 + (d < 64 ? d : 64 + perm_pair(d - 64, 16)); sc = c2q; }
}
__device__ __forceinline__ void tr_item(const float* __restrict__ W, int K, int N, bf16_t* WT, const float* gain, int kind, LAS float* scr, int item, int lane) {
    const int nblk = N / 32, kb = item / nblk, nb = item % nblk, k0 = 64 * kb, n0 = 32 * nb;
#pragma unroll
    for (int i = 0; i < 32; ++i) { const int kk = 2 * i + (lane >> 5); scr[kk * 33 + (lane & 31)] = W[(size_t)(k0 + kk) * N + n0 + (lane & 31)]; }
    asm volatile("s_waitcnt lgkmcnt(0)" ::: "memory");
    const int c = lane & 7; f32x4 g0 = (f32x4){1.f, 1.f, 1.f, 1.f}, g1 = g0;
    if (gain) { g0 = *(const f32x4*)(gain + k0 + 8 * c); g1 = *(const f32x4*)(gain + k0 + 8 * c + 4); }
#pragma unroll
    for (int j = 0; j < 4; ++j) { const int n = (lane >> 3) + 8 * j; int row; float sc; map_row(kind, n0 + n, row, sc); const LAS float* s = scr + (8 * c) * 33 + n;
        u32x4 o; o.x = pk2(s[0 * 33] * g0[0] * sc, s[1 * 33] * g0[1] * sc); o.y = pk2(s[2 * 33] * g0[2] * sc, s[3 * 33] * g0[3] * sc); o.z = pk2(s[4 * 33] * g1[0] * sc, s[5 * 33] * g1[1] * sc); o.w = pk2(s[6 * 33] * g1[2] * sc, s[7 * 33] * g1[3] * sc);
        *(u32x4*)(WT + (size_t)row * K + k0 + 8 * c) = o; }
    asm volatile("s_waitcnt lgkmcnt(0)" ::: "memory");
}


constexpr size_t WS_BAR = 1835008;
constexpr int LDS_MISC = 140000;
#define XB_TMO      128
#define XB_XCNT(j)  (256  + 64 * (j))
#define XB_XSUB(j)  (1280 + 64 * (j))
#define XB_XGEN(j)  (2304 + 64 * (j))
#define XB_TOP      3328
#define XB_TOPGEN   3392
#define XCD_BAR_WORDS 3456
#define XB_SPIN_CAP (1u << 22)
__device__ __forceinline__ unsigned xb_ld(unsigned* p)              { return __hip_atomic_load(p, __ATOMIC_RELAXED, __HIP_MEMORY_SCOPE_AGENT); }
__device__ __forceinline__ unsigned xb_add(unsigned* p, unsigned v) { return __hip_atomic_fetch_add(p, v, __ATOMIC_RELAXED, __HIP_MEMORY_SCOPE_AGENT); }
__device__ __forceinline__ unsigned xb_xcc_id() { return (unsigned)__builtin_amdgcn_s_getreg((3 << 11) | 20) & 0xFu; }
#define XB_SPIN(cond, bar) do { unsigned _sp = 0; while (cond) { __builtin_amdgcn_s_sleep(1); \
    if ((++_sp & 255u) == 0u) { if (xb_ld(&(bar)[XB_TMO])) break; if (_sp > XB_SPIN_CAP) { atomicAdd(&(bar)[XB_TMO], 1u); break; } } } } while (0)
__device__ __forceinline__ void xcd_barrier_complete(unsigned* bar, unsigned x, unsigned& nloc, unsigned& nx) {
    const unsigned G = gridDim.x;
    unsigned sum, cnt, mine, sp = 0u;
    for (;;) {
        sum = 0u; cnt = 0u; mine = 0u;
#pragma unroll
        for (unsigned j = 0; j < 16; ++j) { const unsigned c = xb_ld(&bar[XB_XCNT(j)]); sum += c; cnt += (c > 0u) ? 1u : 0u; mine = (j == x) ? c : mine; }
        if (sum == G) break;
        __builtin_amdgcn_s_sleep(1);
        if ((++sp & 255u) == 0u) { if (xb_ld(&bar[XB_TMO])) break; if (sp > XB_SPIN_CAP) { atomicAdd(&bar[XB_TMO], 1u); break; } }
    }
    nloc = mine > 0u ? mine : 1u; nx = cnt > 0u ? cnt : 1u;
}
__device__ __forceinline__ void grid_bar(unsigned char* wsb, LAS unsigned char* ldsb) {
    asm volatile("s_waitcnt vmcnt(0)" ::: "memory");
    __syncthreads();
    if (threadIdx.x == 0) {
        unsigned* bar = (unsigned*)(wsb + WS_BAR); volatile LAS unsigned* st = (volatile LAS unsigned*)(ldsb + LDS_MISC); const unsigned x = xb_xcc_id();
        __builtin_amdgcn_s_waitcnt(0);
        unsigned nloc = st[0], nx = st[1];
        if (nloc == 0u) { xcd_barrier_complete(bar, x, nloc, nx); st[0] = nloc; st[1] = nx; }
        const unsigned old = xb_add(&bar[XB_XSUB(x)], 1u);
        const unsigned gen = old / nloc;
        if (old + 1u == (gen + 1u) * nloc) {
            __builtin_amdgcn_fence(__ATOMIC_RELEASE, "agent");
            asm volatile("s_waitcnt vmcnt(0)" ::: "memory");
            const unsigned og = xb_add(&bar[XB_TOP], 1u);
            const unsigned tg = og / nx;
            if (og + 1u == (tg + 1u) * nx) xb_add(&bar[XB_TOPGEN], 1u);
            else XB_SPIN(xb_ld(&bar[XB_TOPGEN]) == tg, bar);
            __builtin_amdgcn_fence(__ATOMIC_ACQUIRE, "agent");
            xb_add(&bar[XB_XGEN(x)], 1u);
            asm volatile("s_waitcnt vmcnt(0)" ::: "memory");
        } else {
            XB_SPIN(xb_ld(&bar[XB_XGEN(x)]) == gen, bar);
            __builtin_amdgcn_fence(__ATOMIC_ACQUIRE, "agent");
            asm volatile("s_waitcnt vmcnt(0)" ::: "memory");
        }
    }
    __syncthreads();
}

__device__ __forceinline__ unsigned char* ap_ws() { const __attribute__((address_space(4))) Args* ap = (const __attribute__((address_space(4))) Args*)__builtin_amdgcn_kernarg_segment_ptr(); asm volatile("" : "+s"(ap)); return ap->ws; }
#ifdef PROBE_A
#define STAMP(k) do { unsigned long long* tsp_ = (unsigned long long*)(ap_ws() + WS_TS); if (blockIdx.x == 0 && threadIdx.x == 0) tsp_[(k)] = __builtin_amdgcn_s_memrealtime(); } while (0)
#else
#define STAMP(k) do {} while (0)
#endif
__global__ void __launch_bounds__(512) mega_fwd(Args args) {
    extern __shared__ __attribute__((aligned(16))) unsigned char lds_raw[];
    LAS unsigned char* lds = (LAS unsigned char*)lds_raw;
    {
      unsigned* bar = (unsigned*)(args.ws + WS_BAR);
      if (threadIdx.x < 2) ((volatile LAS unsigned*)(lds + LDS_MISC))[threadIdx.x] = 0u;
      if (args.use_cg_sync) cg::this_grid().sync();
      if (threadIdx.x == 0) (void)xb_add(&bar[XB_XCNT(xb_xcc_id())], 1u);
      __syncthreads();
    }
    STAMP(0);
#define PHASE_VARS \
    const __attribute__((address_space(4))) Args* ap = (const __attribute__((address_space(4))) Args*)__builtin_amdgcn_kernarg_segment_ptr(); asm volatile("" : "+s"(ap)); \
    unsigned char* ws = ap->ws; float* out = ap->out; (void)out; (void)ws; \
    int G = (int)gridDim.x, bx = (int)blockIdx.x; asm volatile("" : "+s"(G), "+s"(bx)); \
    const int tid = opaque_tid(), lane = tid & 63, wave = __builtin_amdgcn_readfirstlane(tid >> 6); (void)lane; (void)wave; \
    const int vcu = (G % 8 == 0) ? (bx % 8) * (G / 8) + bx / 8 : bx; const int gw = vcu * 8 + wave, NGW = G * 8; (void)gw; (void)NGW; (void)vcu;
    if (PH(0)) { PHASE_VARS
            {
                for (int idx = (vcu * 512 + tid); idx < SS * 56; idx += G * 512) { const int pos = idx / 56, f = idx % 56; float s, c;
                    if (f < 16) { sincos_acc((float)pos * ap->inv_mla[f], s, c); ((float*)(ws + TAB_CM))[pos * 16 + f] = c; ((float*)(ws + TAB_SM))[pos * 16 + f] = s; }
                    else if (f < 24) { sincos_acc((float)pos * ap->inv_moba[f - 16], s, c); ((float*)(ws + TAB_CB))[pos * 8 + f - 16] = c; ((float*)(ws + TAB_SB))[pos * 8 + f - 16] = s; }
                    else { sincos_acc((float)pos * ap->inv_ret[f - 24], s, c); ((float*)(ws + TAB_CR))[pos * 32 + f - 24] = c; ((float*)(ws + TAB_SR))[pos * 32 + f - 24] = s; } }
                const float* x = ap->in[0]; bf16_t* XB = WSP(bf16_t, WS_XB); float* SSQ_X = WSP(float, WS_SSQX);
                for (int m = gw; m < TT; m += NGW) { const f32x4* xr = (const f32x4*)(x + (size_t)m * DM) + lane; f32x4 v[4]; float s = 0.f;
#pragma unroll
                    for (int j = 0; j < 4; ++j) { v[j] = xr[64 * j]; s += dot4(v[j]); }
                    s = wave_sum(s);
                    unsigned long long* o8 = (unsigned long long*)(XB + (size_t)m * DM) + lane;
#pragma unroll
                    for (int j = 0; j < 4; ++j) o8[64 * j] = (unsigned long long)pk2(v[j][0], v[j][1]) | ((unsigned long long)pk2(v[j][2], v[j][3]) << 32);
                    if (lane < 16) SSQ_X[(size_t)m * 16 + lane] = lane == 0 ? s : 0.f; }
            }
    }
#pragma unroll 1
    for (int l = 0; l < 2; ++l) {
        if (PH(0)) {
            PHASE_VARS
            LAS float* scr = (LAS float*)(lds + wave * 16384);
            constexpr int I_IN = 16 * 205, I_QU = 4 * 24, I_KVU = 2 * 32, I_BR = 8 * 32, I_O = 16 * 32, I_UP = 16 * 128, I_DN = 64 * 32;
            constexpr int NITEMS = I_IN + I_QU + I_KVU + 3 * I_BR + I_O + I_UP + I_DN;
            for (int it = gw; it < NITEMS; it += NGW) {
                int r = it;
                if (r < I_IN) { tr_item(ap->in[2] + (size_t)l * 1024 * 6560, 1024, 6560, (bf16_t*)(ws + W_IN), ap->in[1] + l * 1024, 1, scr, r, lane); continue; } r -= I_IN;
                if (r < I_QU) { tr_item(ap->in[5] + (size_t)l * 256 * 768, 256, 768, (bf16_t*)(ws + W_QU), ap->in[3] + l * 256, 2, scr, r, lane); continue; } r -= I_QU;
                if (r < I_KVU) { tr_item(ap->in[6] + (size_t)l * 128 * 1024, 128, 1024, (bf16_t*)(ws + W_KVU), ap->in[4] + l * 128, 0, scr, r, lane); continue; } r -= I_KVU;
                if (r < 3 * I_BR) { const int br = r / I_BR; tr_item(ap->in[9 + br] + (size_t)l * 512 * 1024, 512, 1024, (bf16_t*)(ws + W_BR) + (size_t)br * 1024 * 512, nullptr, 0, scr, r - br * I_BR, lane); continue; } r -= 3 * I_BR;
                if (r < I_O) { tr_item(ap->in[12] + (size_t)l * 1024 * 1024, 1024, 1024, (bf16_t*)(ws + W_OUT), nullptr, 0, scr, r, lane); continue; } r -= I_O;
                if (r < I_UP) { tr_item(ap->in[14] + (size_t)l * 1024 * 4096, 1024, 4096, (bf16_t*)(ws + W_UP), ap->in[13] + l * 1024, 0, scr, r, lane); continue; } r -= I_UP;
                tr_item(ap->in[15] + (size_t)l * 4096 * 1024, 4096, 1024, (bf16_t*)(ws + W_DN), nullptr, 0, scr, r, lane);
            }
        }
        grid_bar(ap_ws(), lds);
        STAMP(1 + l * 12 + 0);
        if (PH(1)) { PHASE_VARS pg8::Gemm g{1024, 1024, 1024}; pg8::SchedStd S; S.init(ws + WS_XB, ws + W_IN, 1024, 1024, 64, 12, G, bx);
          EpiP1 E{ws}; pg8::gemm_phase(lds, g, S, E); }
        grid_bar(ap_ws(), lds);
        STAMP(1 + l * 12 + 1);
        if (PH(2)) { PHASE_VARS pg8::Gemm g{256, 256, 256}; pg8::SchedStd S; S.init(ws + WS_CQ, ws + W_QU, 256, 256, 64, 3, G, bx); EpiQU E{ws}; pg8::gemm_phase(lds, g, S, E); }
        if (PH(3)) { PHASE_VARS pg8::Gemm g{128, 128, 128}; pg8::SchedStd S; S.init(ws + WS_CKV, ws + W_KVU, 128, 128, 64, 4, G, bx); EpiKVU E{ws}; pg8::gemm_phase(lds, g, S, E); }
        __syncthreads();
        STAMP(30 + l * 8 + 0);
        if (PH(4)) { PHASE_VARS
          for (int un = vcu; un < 256; un += G) {
            const int bq = un >> 2, qtr = un & 3, b = bq >> 4, blk = bq & 15; const bf16_t* p = WSP(bf16_t, WS_MK) + ((size_t)b * SS + blk * 256 + qtr * 64) * 512 + tid; float s = 0.f;
#pragma unroll 32
            for (int j = 0; j < 64; ++j) s += __uint_as_float((unsigned)p[(size_t)j * 512] << 16);
            WSP(float, WS_KMP)[(size_t)un * 512 + tid] = s; } }
        STAMP(30 + l * 8 + 1);
        if (PH(5)) { PHASE_VARS for (int un = vcu; un < 512; un += G) ret_kv_unit(un, WSP(bf16_t, WS_RK), WSP(bf16_t, WS_RV), WSP(float, WS_RKV), (const float*)ap->ret_lg2, lds); }
        grid_bar(ap_ws(), lds);
        STAMP(1 + l * 12 + 2);
        if (PH(6)) { PHASE_VARS
          for (int un = vcu; un < 512; un += G) {
            const int bh = (un & 255) >> 3, qb = un < 256 ? (un & 7) : 15 - (un & 7), b = bh >> 3, h = bh & 7;
            att::attn_unit<96, false>((long)b * SS, qb, WSP(bf16_t, WS_QM) + h * 96, 768, WSP(bf16_t, WS_KVM) + h * 128, 1024, WSP(bf16_t, WS_KPE), WSP(bf16_t, WS_KVM) + h * 128 + 64, 1024, WSP(bf16_t, WS_OM) + h * 64, 512, lds, (1u << qb) - 1u);
          } }
        STAMP(30 + l * 8 + 2);
        if (PH(7)) { PHASE_VARS
          for (int un = vcu; un < 512; un += G) {
            const int bh = (un & 255) >> 3, qb = un < 256 ? (un & 7) : 15 - (un & 7), b = bh >> 3, h = bh & 7;
            LAS float* km = (LAS float*)(lds + att::L_KM); LAS unsigned* selp = (LAS unsigned*)(lds + att::L_SEL); LAS unsigned* ump = (LAS unsigned*)(lds + att::L_UM);
            bf16_t* MQ = WSP(bf16_t, WS_MQ);
            if (tid == 0) *ump = 0u;
            for (int e = tid; e < 1024; e += 512) { const int n = e >> 6, d = e & 63; float s = 0.f;
                if (n < qb) { const float* p = WSP(float, WS_KMP) + ((size_t)(b * 16 + n) * 4) * 512 + h * 64 + d; s = (p[0] + p[512]) + (p[1024] + p[1536]); }
                km[e] = s * (1.f / 256.f); }
            __syncthreads();
            if (tid < 256) { const bf16_t* qp = MQ + ((size_t)b * SS + qb * 256 + tid) * 512 + h * 64;
                float v1 = -INFINITY, v2 = -INFINITY, v3 = -INFINITY; int i1 = 0, i2 = 0, i3 = 0;
#pragma unroll 1
                for (int n = 0; n < qb; ++n) { float gsum = 0.f;
#pragma unroll
                    for (int i = 0; i < 8; ++i) { f32x4 a, bq; unpack8(*(const u32x4*)(qp + 8 * i), a, bq); const f32x4 k0 = *(const LAS f32x4*)(km + n * 64 + 8 * i), k1 = *(const LAS f32x4*)(km + n * 64 + 8 * i + 4);
                        gsum += (a[0] * k0[0] + a[1] * k0[1]) + (a[2] * k0[2] + a[3] * k0[3]) + (bq[0] * k1[0] + bq[1] * k1[1]) + (bq[2] * k1[2] + bq[3] * k1[3]); }
                    if (gsum > v1) { v3 = v2; i3 = i2; v2 = v1; i2 = i1; v1 = gsum; i1 = n; } else if (gsum > v2) { v3 = v2; i3 = i2; v2 = gsum; i2 = n; } else if (gsum > v3) { v3 = gsum; i3 = n; } }
                unsigned sel = qb <= 3 ? ((1u << qb) - 1u) : ((1u << i1) | (1u << i2) | (1u << i3));
                selp[tid] = sel;
                unsigned um = sel;
#pragma unroll
                for (int o = 1; o < 64; o <<= 1) um |= (unsigned)__shfl_xor((int)um, o);
                if (lane == 0) atomicOr((unsigned*)ump, um); }
            __syncthreads();
            const unsigned umask = *ump;
            att::attn_unit<64, true>((long)b * SS, qb, MQ + h * 64, 512, WSP(bf16_t, WS_MK) + h * 64, 512, nullptr, WSP(bf16_t, WS_MV) + h * 64, 512, MQ + h * 64, 512, lds, umask);
          } }
        STAMP(30 + l * 8 + 3);
        if (PH(8)) { PHASE_VARS for (int un = vcu; un < 512; un += G) ret_out_unit(un, WSP(bf16_t, WS_RQ), WSP(bf16_t, WS_RK), WSP(bf16_t, WS_RV), WSP(float, WS_RKV), ap->in[7] + l * 512, ap->in[8] + l * 512, (const float*)ap->ret_lg2, lds); }
        grid_bar(ap_ws(), lds);
        STAMP(1 + l * 12 + 3);
        if (PH(9)) { PHASE_VARS pg8::Gemm g{1024, 1024, 1024}; pg8::SchedStd S; S.init(ws + WS_XB, ws + W_IN + (size_t)3072 * 1024 * 2, 1024, 1024, 64, 14, G, bx);
          EpiGate E{ws}; pg8::gemm_phase(lds, g, S, E); }
        grid_bar(ap_ws(), lds);
        STAMP(1 + l * 12 + 4);
        if (PH(10)) { PHASE_VARS pg8::Gemm g{512, 512, 512}; pg8::SchedMerge S{(const char*)(ws + WS_OM), (const char*)(ws + WS_MQ), (const char*)(ws + WS_RV), (const char*)(ws + W_BR), G, bx};
          EpiMerge E{ws}; pg8::gemm_phase(lds, g, S, E); }
        grid_bar(ap_ws(), lds);
        STAMP(1 + l * 12 + 5);
        if (PH(11)) { PHASE_VARS pg8::Gemm g{1024, 1024, 1024}; pg8::SchedStd S; S.init(ws + WS_MB, ws + W_OUT, 1024, 1024, 64, 4, G, bx);
          EpiRes E{l == 0 ? ap->in[0] : (const float*)out, out, ws, 1}; pg8::gemm_phase(lds, g, S, E); }
        grid_bar(ap_ws(), lds);
        STAMP(1 + l * 12 + 6);
        if (PH(12)) { PHASE_VARS pg8::Gemm g{1024, 1024, 1024}; pg8::SchedStd S; S.init(ws + WS_XB, ws + W_UP, 1024, 1024, 64, 16, G, bx); EpiUp E{ws}; pg8::gemm_phase(lds, g, S, E); }
        grid_bar(ap_ws(), lds);
        STAMP(1 + l * 12 + 7);
        if (PH(13)) { PHASE_VARS pg8::Gemm g{4096, 4096, 4096}; pg8::SchedStd S; S.init(ws + WS_HID, ws + W_DN, 4096, 4096, 64, 4, G, bx); EpiRes E{(const float*)out, out, ws, l == 0 ? 1 : 0}; pg8::gemm_phase(lds, g, S, E); }
        grid_bar(ap_ws(), lds);
        STAMP(1 + l * 12 + 8);
    }
    { PHASE_VARS const float* fn = ap->in[16];
      for (int m = gw; m < TT; m += NGW) { f32x4* xr = (f32x4*)(out + (size_t)m * DM) + lane; f32x4 v[4]; float s = 0.f;
#pragma unroll
          for (int j = 0; j < 4; ++j) { v[j] = xr[64 * j]; s += dot4(v[j]); }
          s = wave_sum(s); const float rs = rsqrtf(s * (1.f / 1024.f) + NEPS);
#pragma unroll
          for (int j = 0; j < 4; ++j) { const f32x4 gsc = *((const f32x4*)fn + lane + 64 * j); xr[64 * j] = v[j] * rs * gsc; } }
#ifdef PROBE_A
      { const unsigned long long* ts = (const unsigned long long*)(ws + WS_TS); const float dlt = (float)(ts[PROBE_B] - ts[PROBE_A]) * 4e-7f;
        for (int m = gw; m < 1024; m += NGW) { f32x4* xr = (f32x4*)(out + (size_t)m * DM) + lane;
#pragma unroll
          for (int j = 0; j < 4; ++j) xr[64 * j] = xr[64 * j] + dlt; } }
#endif
    }
}

extern "C" void kernel_launch(void* const* d_in, const int* in_sizes, int n_in, void* d_out, int out_size, void* d_ws, size_t ws_size, hipStream_t stream) {
    static int grid = 0;
    if (grid == 0) {
        if (n_in != 17 || out_size != TT * DM || ws_size < WS_END) { fprintf(stderr, "kernel_launch: unexpected shapes (n_in %d out %d ws %zu)\n", n_in, out_size, ws_size); grid = -1; return; }
        int dev = 0, cus = 0, per_cu = 0;
        hipGetDevice(&dev); hipDeviceGetAttribute(&cus, hipDeviceAttributeMultiprocessorCount, dev);
        hipFuncSetAttribute((const void*)mega_fwd, hipFuncAttributeMaxDynamicSharedMemorySize, LDS_BYTES);
        hipOccupancyMaxActiveBlocksPerMultiprocessor(&per_cu, (const void*)mega_fwd, 512, LDS_BYTES);
        if (per_cu < 1) per_cu = 1;
        grid = cus * per_cu;
        (void)hipGetLastError();
    }
    if (grid < 0) return;
    Args a{};
    for (int i = 0; i < 17; ++i) a.in[i] = (const float*)d_in[i];
    a.out = (float*)d_out; a.ws = (unsigned char*)d_ws;
    for (int i = 0; i < 16; ++i) a.inv_mla[i] = 1.0f / powf(500000.0f, (float)(2 * i) / 32.0f);
    for (int i = 0; i < 8; ++i) a.inv_moba[i] = 1.0f / powf(500000.0f, (float)(2 * i) / 16.0f);
    for (int i = 0; i < 32; ++i) a.inv_ret[i] = 1.0f / powf(10000.0f, (float)(2 * i) / 64.0f);
    for (int i = 0; i < 4; ++i) a.ret_lg2[i] = (float)log2(1.0 - pow(2.0, -5.0 - (double)i));
    a.use_cg_sync = 0; a.pad_ = 0;
    (void)hipMemsetAsync((unsigned char*)d_ws + WS_BAR, 0, XCD_BAR_WORDS * 4, stream);
    void* kargs[] = {&a};
    hipError_t e = hipLaunchCooperativeKernel((const void*)mega_fwd, dim3(grid), dim3(512), kargs, LDS_BYTES, stream);
    if (e != hipSuccess) fprintf(stderr, "cooperative launch failed: %s (grid %d)\n", hipGetErrorString(e), grid);
}
```

```cpp
#include <hip/hip_runtime.h>
#include <hip/hip_cooperative_groups.h>
#include <cstdio>
#include <cstdint>
#include <cmath>
namespace cg = cooperative_groups;

#define LAS __attribute__((address_space(3)))
typedef unsigned short bf16_t;
typedef short bf16x8 __attribute__((ext_vector_type(8)));
typedef float f32x4 __attribute__((ext_vector_type(4)));
typedef float f32x16 __attribute__((ext_vector_type(16)));
typedef unsigned u32x4 __attribute__((ext_vector_type(4)));
typedef short s16x4 __attribute__((ext_vector_type(4)));
typedef float f32x2_t __attribute__((ext_vector_type(2)));
typedef __bf16 bf16x2_t __attribute__((ext_vector_type(2)));

__device__ __forceinline__ unsigned pk2(float lo, float hi) { f32x2_t v = {lo, hi}; bf16x2_t b = __builtin_convertvector(v, bf16x2_t); return __builtin_bit_cast(unsigned, b); }
__device__ __forceinline__ u32x4 pack8(f32x4 a, f32x4 b) { return (u32x4){pk2(a[0], a[1]), pk2(a[2], a[3]), pk2(b[0], b[1]), pk2(b[2], b[3])}; }
__device__ __forceinline__ void unpack8(u32x4 w, f32x4& a, f32x4& b) {
    a[0] = __uint_as_float(w.x << 16); a[1] = __uint_as_float(w.x & 0xffff0000u); a[2] = __uint_as_float(w.y << 16); a[3] = __uint_as_float(w.y & 0xffff0000u);
    b[0] = __uint_as_float(w.z << 16); b[1] = __uint_as_float(w.z & 0xffff0000u); b[2] = __uint_as_float(w.w << 16); b[3] = __uint_as_float(w.w & 0xffff0000u);
}
__device__ __forceinline__ int opaque_tid() { int t = threadIdx.x; asm volatile("" : "+v"(t)); return t; }
__device__ __forceinline__ float dot4(f32x4 a) { return (a[0] * a[0] + a[1] * a[1]) + (a[2] * a[2] + a[3] * a[3]); }

constexpr int TT = 16384, SS = 4096, DM = 1024;
constexpr float NEPS = 1e-6f, GNEPS = 1e-5f;
constexpr float LOG2E = 1.4426950408889634f;
constexpr size_t MiB = 1u << 20;
constexpr size_t TAB_CM = 0, TAB_SM = 262144, TAB_CB = 524288, TAB_SB = 655360, TAB_CR = 786432, TAB_SR = 1310720;
constexpr size_t WS_SSQX = 2 * MiB, WS_SSQCQ = 3 * MiB, WS_SSQKV = 3 * MiB + 262144, WS_KMP = 3 * MiB + 524288;
constexpr size_t WS_W = 4 * MiB;
constexpr size_t W_IN = WS_W, W_QU = WS_W + 13 * MiB, W_KVU = WS_W + 13 * MiB + 524288, W_BR = WS_W + 14 * MiB, W_OUT = WS_W + 17 * MiB, W_UP = WS_W + 19 * MiB, W_DN = WS_W + 27 * MiB;
constexpr size_t WS_XB = 39 * MiB;
constexpr size_t A0 = 71 * MiB;
constexpr size_t WS_MQ = A0, WS_MK = A0 + 16 * MiB, WS_MV = A0 + 32 * MiB, WS_RQ = A0 + 48 * MiB, WS_RK = A0 + 56 * MiB, WS_RKV = A0 + 64 * MiB, WS_RV = A0 + 80 * MiB,
                 WS_OM = A0 + 96 * MiB, WS_QM = A0 + 112 * MiB, WS_CQ = A0 + 136 * MiB, WS_KVM = A0 + 144 * MiB, WS_CKV = A0 + 176 * MiB, WS_KPE = A0 + 180 * MiB, WS_END = A0 + 181 * MiB;
constexpr size_t WS_GMLA = WS_QM, WS_GMOBA = WS_MK, WS_GRET = WS_KVM, WS_MB = WS_RQ, WS_HID = A0;
constexpr int LDS_BYTES = 147456;
constexpr size_t WS_TS = 1835008 + 16384;
#ifndef PMASK
#define PMASK 0xffff
#endif
#define PH(k) ((PMASK >> (k)) & 1)

struct Args {
    const float* in[17];
    float* out;
    unsigned char* ws;
    float inv_mla[16], inv_moba[8], inv_ret[32], ret_lg2[4];
    int use_cg_sync, pad_;
};

namespace pg8 {
constexpr int BM = 256, BK = 64, HALF = 128, HTB = HALF * BK * 2, STAGE_BYTES = 8 * HTB, NXCD = 8, WGM = 8;
__host__ __device__ __forceinline__ int lds_byte(int r, int c) { const int st = (r >> 4) * 2 + (c >> 5), rr = r & 15, cc = c & 31, ob = rr * 64 + cc * 2; return st * 1024 + (ob ^ (((ob >> 9) & 1) << 5)); }
__host__ __device__ __forceinline__ void stage_rc(int b, int& R, int& C) { const int st = b / 1024, sb = b % 1024, swz = sb ^ (((sb >> 9) & 1) << 5); R = (st >> 1) * 16 + swz / 64; C = (st & 1) * 32 + (swz % 64) / 2; }
__host__ __device__ __forceinline__ int perm32(int rho) { const int n = rho >> 4, i = rho & 15; return 8 * (i >> 2) + 4 * n + (i & 3); }

struct Unit { int pm, pn, aux; const char* a; const char* b; };
struct Gemm { int lda, ldb, K; };

struct SchedStd {
    const char* A; const char* B; int lda, ldb; int nM, nN, nwg, G, c;
    __device__ void init(const void* A_, const void* B_, int lda_, int ldb_, int nM_, int nN_, int G_, int c_) { A = (const char*)A_; B = (const char*)B_; lda = lda_; ldb = ldb_; nM = nM_; nN = nN_; nwg = nM * nN; G = G_; c = c_; }
    __device__ __forceinline__ bool next(int i, Unit& u) const {
        const long L = (long)i * G + c; if (L >= nwg) return false;
        int wgid = (int)L; { const int q = nwg / NXCD, r = nwg % NXCD, xcd = wgid % NXCD, off = wgid / NXCD; wgid = (xcd < r ? xcd * (q + 1) : r * (q + 1) + (xcd - r) * q) + off; }
        const int nig = WGM * nN, gid = wgid / nig, fm = gid * WGM, gsz = (nM - fm) < WGM ? (nM - fm) : WGM;
        u.pm = fm + ((wgid % nig) % gsz); u.pn = (wgid % nig) / gsz; u.aux = 0;
        u.a = A + (size_t)u.pm * BM * lda * 2; u.b = B + (size_t)u.pn * BM * ldb * 2; return true;
    }
};
struct SchedMerge {
    const char* A0; const char* A1; const char* A2; const char* B; int G, c;
    __device__ __forceinline__ bool next(int i, Unit& u) const {
        const int br = i % 3; const long L = (long)(i / 3) * G + c; if (L >= 256) return false;
        int wgid = (int)L; { const int xcd = wgid % NXCD, off = wgid / NXCD; wgid = xcd * 32 + off; }
        const int nN = 4, nig = WGM * nN, gid = wgid / nig, fm = gid * WGM;
        u.pm = fm + ((wgid % nig) % WGM); u.pn = (wgid % nig) / WGM; u.aux = br;
        const char* Ab = br == 0 ? A0 : (br == 1 ? A1 : A2);
        u.a = Ab + (size_t)u.pm * BM * 512 * 2; u.b = B + ((size_t)br * 1024 + (size_t)u.pn * BM) * 512 * 2; return true;
    }
};

template <class Epi, class Sched>
__device__ __forceinline__ void gemm_phase(LAS unsigned char* lds, const Gemm g, const Sched& S, const Epi& E) {
    const int tid = opaque_tid(), wid = __builtin_amdgcn_readfirstlane(tid >> 6), lane = tid & 63, wr = wid >> 2, wc = wid & 3, fr = lane & 15, fq = lane >> 4;
    int K = g.K; asm volatile("" : "+s"(K)); const int nt = K / BK;
    unsigned voffA[2], voffB[2];
#pragma unroll
    for (int i = 0; i < 2; ++i) { int R, C; stage_rc(tid * 16 + i * 8192, R, C); const int Rb = Epi::PERM ? ((R & ~31) + perm32(R & 31)) : R;
        voffA[i] = (unsigned)(R * g.lda + C) * 2u; voffB[i] = (unsigned)(Rb * g.ldb + C) * 2u; }
    const size_t kstep = (size_t)(BK * 2);
    const size_t hstepA = (size_t)HALF * g.lda * 2, hstepB = (size_t)HALF * g.ldb * 2;
    const unsigned ldsw = (unsigned)wid * 1024u;
    const int aoff = lds_byte(wr * 64 + fr, fq * 8), boff = lds_byte(wc * 32 + fr, fq * 8);
#define PG8_SA(b, h) (((b) * 2 + (h)) * HTB)
#define PG8_SB(b, h) ((4 + (b) * 2 + (h)) * HTB)
#define PG8_STAGE(bufoff, gbase, voff) do { _Pragma("unroll") for (int _i = 0; _i < 2; ++_i) \
        __builtin_amdgcn_global_load_lds((const unsigned*)((const char*)(gbase) + (voff)[_i]), (LAS unsigned*)(lds + (bufoff) + ldsw + _i * 8192), 16, 0, 0); } while (0)
#define PG8_LDA(dst, b, h) do { _Pragma("unroll") for (int m = 0; m < 4; ++m) _Pragma("unroll") for (int k = 0; k < 2; ++k) dst[m][k] = *(const LAS bf16x8*)(lds + PG8_SA(b, h) + aoff + m * 2048 + k * 1024); } while (0)
#define PG8_LDB(dst, b, h) do { _Pragma("unroll") for (int n = 0; n < 2; ++n) _Pragma("unroll") for (int k = 0; k < 2; ++k) dst[n][k] = *(const LAS bf16x8*)(lds + PG8_SB(b, h) + boff + n * 2048 + k * 1024); } while (0)
#define PG8_MMA(ai, bj, At, Bt) do { __builtin_amdgcn_s_setprio(1); _Pragma("unroll") for (int m = 0; m < 4; ++m) _Pragma("unroll") for (int n = 0; n < 2; ++n) _Pragma("unroll") for (int k = 0; k < 2; ++k) \
        acc[ai][bj][m][n] = __builtin_amdgcn_mfma_f32_16x16x32_bf16(Bt[n][k], At[m][k], acc[ai][bj][m][n], 0, 0, 0); __builtin_amdgcn_s_setprio(0); } while (0)
#define PG8_WAIT_V(n) asm volatile("s_waitcnt vmcnt(" #n ")" ::: "memory")
#define PG8_WAIT_L(n) asm volatile("s_waitcnt lgkmcnt(" #n ")" ::: "memory")
#define PG8_BAR __builtin_amdgcn_s_barrier()
#define PG8_SCHED __builtin_amdgcn_sched_barrier(0)
    Unit cur, nxt; int ui = 0;
    if (!S.next(0, cur)) return;
    f32x4 acc[2][2][4][2];
#pragma unroll
    for (int a = 0; a < 2; ++a)
#pragma unroll
        for (int b = 0; b < 2; ++b)
#pragma unroll
            for (int m = 0; m < 4; ++m)
#pragma unroll
                for (int n = 0; n < 2; ++n) acc[a][b][m][n] = (f32x4){0.f, 0.f, 0.f, 0.f};
    bf16x8 At[4][2], B0[2][2], B1[2][2];
    const char* cA = cur.a; const char* cB = cur.b;
    PG8_STAGE(PG8_SB(0, 0), cB, voffB); PG8_STAGE(PG8_SB(0, 1), cB + hstepB, voffB); PG8_STAGE(PG8_SA(0, 0), cA, voffA); PG8_STAGE(PG8_SA(0, 1), cA + hstepA, voffA);
    if (wr == 1) PG8_BAR;
    PG8_WAIT_V(2); PG8_BAR;
    PG8_STAGE(PG8_SB(1, 0), cB + kstep, voffB); PG8_STAGE(PG8_SA(1, 0), cA + kstep, voffA); PG8_STAGE(PG8_SB(1, 1), cB + hstepB + kstep, voffB);
    PG8_WAIT_V(6); PG8_BAR;
    for (;;) {
        const bool has_next = S.next(ui + 1, nxt);
        const char* nA = has_next ? nxt.a : cA; const char* nB = has_next ? nxt.b : cB;
        for (int t = 0; t < nt; t += 2) {
            const bool last = (t == nt - 2);
            const char* a1 = cA + (size_t)(t + 1) * kstep;
            const char* a2 = last ? nA : cA + (size_t)(t + 2) * kstep; const char* b2 = last ? nB : cB + (size_t)(t + 2) * kstep;
            const char* a3 = a2 + kstep; const char* b3 = b2 + kstep;
            PG8_LDB(B0, 0, 0); PG8_LDB(B1, 0, 1); PG8_SCHED; PG8_LDA(At, 0, 0); PG8_STAGE(PG8_SA(1, 1), a1 + hstepA, voffA);
            PG8_WAIT_V(8); PG8_WAIT_L(0); PG8_BAR; PG8_MMA(0, 0, At, B0); PG8_MMA(0, 1, At, B1); PG8_BAR; PG8_SCHED;
            PG8_LDA(At, 0, 1); PG8_STAGE(PG8_SB(0, 0), b2, voffB); PG8_STAGE(PG8_SB(0, 1), b2 + hstepB, voffB); PG8_STAGE(PG8_SA(0, 0), a2, voffA);
            PG8_WAIT_V(8); PG8_WAIT_L(0); PG8_BAR; PG8_MMA(1, 0, At, B0); PG8_MMA(1, 1, At, B1); PG8_BAR; PG8_SCHED;
            PG8_LDB(B0, 1, 0); PG8_LDB(B1, 1, 1); PG8_SCHED; PG8_LDA(At, 1, 0); PG8_STAGE(PG8_SA(0, 1), a2 + hstepA, voffA);
            PG8_WAIT_V(8); PG8_WAIT_L(0); PG8_BAR; PG8_MMA(0, 0, At, B0); PG8_MMA(0, 1, At, B1); PG8_BAR; PG8_SCHED;
            PG8_LDA(At, 1, 1); PG8_STAGE(PG8_SB(1, 0), b3, voffB); PG8_STAGE(PG8_SB(1, 1), b3 + hstepB, voffB); PG8_STAGE(PG8_SA(1, 0), a3, voffA);
            PG8_WAIT_V(8); PG8_WAIT_L(0); PG8_BAR; PG8_MMA(1, 0, At, B0); PG8_MMA(1, 1, At, B1); PG8_BAR; PG8_SCHED;
        }
        if (wr == 0) PG8_BAR;
        const bool keep = E(acc, cur, wr, wc, fr, fq);
        if (!has_next) break;
        if (!keep) {
#pragma unroll
        for (int a = 0; a < 2; ++a)
#pragma unroll
            for (int b = 0; b < 2; ++b)
#pragma unroll
                for (int m = 0; m < 4; ++m)
#pragma unroll
                    for (int n = 0; n < 2; ++n) acc[a][b][m][n] = (f32x4){0.f, 0.f, 0.f, 0.f};
        }
        cur = nxt; cA = nA; cB = nB; ++ui;
        if (wr == 1) PG8_BAR;
    }
    PG8_WAIT_V(0);
    PG8_BAR;
#undef PG8_SA
#undef PG8_SB
#undef PG8_STAGE
#undef PG8_LDA
#undef PG8_LDB
#undef PG8_MMA
#undef PG8_WAIT_V
#undef PG8_WAIT_L
#undef PG8_BAR
#undef PG8_SCHED
}
}
using pg8::Unit;

__device__ __forceinline__ float ssq16(const float* p) { const f32x4 a = *(const f32x4*)p, b = *(const f32x4*)(p + 4), c = *(const f32x4*)(p + 8), d = *(const f32x4*)(p + 12);
    return ((a[0] + a[1]) + (a[2] + a[3])) + ((b[0] + b[1]) + (b[2] + b[3])) + ((c[0] + c[1]) + (c[2] + c[3])) + ((d[0] + d[1]) + (d[2] + d[3])); }
__device__ __forceinline__ float ssq4(const float* p) { const f32x4 a = *(const f32x4*)p; return (a[0] + a[1]) + (a[2] + a[3]); }
__device__ __forceinline__ void rope8(f32x4& v0, f32x4& v1, const float* ct, const float* st, int pos, int NF, int fb) {
    const f32x4 c = *(const f32x4*)(ct + (size_t)pos * NF + fb), s = *(const f32x4*)(st + (size_t)pos * NF + fb);
    const f32x4 a = v0 * c - v1 * s, b = v0 * s + v1 * c; v0 = a; v1 = b;
}
#define EPI_ROWLOOP _Pragma("unroll") for (int ai = 0; ai < 2; ++ai) _Pragma("unroll") for (int m = 0; m < 4; ++m)
#define EPI_FENCE asm volatile("" ::: "memory")

#define WSP(T, off) ((T*)(ws + (off)))
constexpr unsigned LDS_RSTAB = 132096;
__device__ __forceinline__ void rstd_table(const unsigned char* ws, int pm) {
    LAS float* rsl = (LAS float*)(size_t)LDS_RSTAB; const int t = threadIdx.x;
    if (t < 256) rsl[t] = rsqrtf(ssq16((const float*)(ws + WS_SSQX) + (size_t)(pm * 256 + t) * 16) * (1.f / 1024.f) + NEPS);
    asm volatile("s_waitcnt lgkmcnt(0)" ::: "memory"); __builtin_amdgcn_s_barrier(); asm volatile("" ::: "memory");
}
#define RSTAB(lrow) (((const LAS float*)(size_t)LDS_RSTAB)[(lrow)])
__device__ __forceinline__ float rstd_x(const unsigned char* ws, int row) { return rsqrtf(ssq16((const float*)(ws + WS_SSQX) + (size_t)row * 16) * (1.f / 1024.f) + NEPS); }
struct EpiP1 {
    static constexpr bool PERM = true;
    unsigned char* ws;
    __device__ __forceinline__ bool operator()(f32x4 (&acc)[2][2][4][2], const Unit& u, int wr, int wc, int fr, int fq) const {
        const int pn = u.pn, row0 = u.pm * 256 + wr * 64 + fr, cl0 = wc * 32 + 8 * fq;
        size_t d0, d1; int l0, l1, c0, c1, md0 = 0, md1 = 0; bool st1 = true; size_t ssqo = 0;
        if (pn == 0) { d0 = d1 = WS_CQ; l0 = l1 = 256; c0 = cl0; c1 = 128 + cl0; ssqo = WS_SSQCQ; }
        else if (pn == 1) { d0 = WS_CKV; l0 = 128; c0 = cl0; d1 = WS_KPE; l1 = 32; c1 = 8 * fq; md1 = 1; st1 = (wc == 0); ssqo = WS_SSQKV; }
        else if (pn < 8) { const int sec = (pn - 2) >> 1; d0 = d1 = WS_MQ + (size_t)sec * (16 * MiB); l0 = l1 = 512; c0 = ((pn - 2) & 1) * 256 + cl0; c1 = c0 + 128; md0 = md1 = (sec < 2) ? 2 : 0; }
        else if (pn < 10) { d0 = d1 = (pn == 8 ? WS_RQ : WS_RK); l0 = l1 = 256; c0 = cl0; c1 = 128 + cl0; md0 = md1 = 3; }
        else { d0 = d1 = WS_RV; l0 = l1 = 512; c0 = (pn - 10) * 256 + cl0; c1 = c0 + 128; }
        const int md = md0 | md1; const int NF = md == 1 ? 16 : (md == 2 ? 8 : 32);
        const float* ct = (const float*)(ws + (md == 1 ? TAB_CM : (md == 2 ? TAB_CB : TAB_CR))); const float* st = (const float*)(ws + (md == 1 ? TAB_SM : (md == 2 ? TAB_SB : TAB_SR)));
        const bool rp0 = md0 == 2 ? ((c0 & 63) < 16) : (md0 != 0), rp1 = md1 == 2 ? ((c1 & 63) < 16) : (md1 != 0);
        const int fb0 = 4 * ((c0 & 63) >> 3), fb1 = 4 * ((c1 & 63) >> 3);
        bf16_t* p0 = (bf16_t*)(ws + d0) + c0; bf16_t* p1 = (bf16_t*)(ws + d1) + c1;
        rstd_table(ws, u.pm); const int lrow0 = wr * 64 + fr;
#pragma unroll
        for (int ai = 0; ai < 2; ++ai)
#pragma unroll
          for (int mp = 0; mp < 4; mp += 2) { f32x4 tc0[2], ts0[2], tc1[2], ts1[2];
#pragma unroll
            for (int q = 0; q < 2; ++q) { const int pos = (row0 + ai * 128 + (mp + q) * 16) & (SS - 1); tc0[q] = ts0[q] = tc1[q] = ts1[q] = (f32x4){0.f, 0.f, 0.f, 0.f};
                if (rp0) { tc0[q] = *(const f32x4*)(ct + (size_t)pos * NF + fb0); ts0[q] = *(const f32x4*)(st + (size_t)pos * NF + fb0); }
                if (rp1) { tc1[q] = *(const f32x4*)(ct + (size_t)pos * NF + fb1); ts1[q] = *(const f32x4*)(st + (size_t)pos * NF + fb1); } }
#pragma unroll
            for (int q = 0; q < 2; ++q) { const int m = mp + q; const int row = row0 + ai * 128 + m * 16; const float rs = RSTAB(lrow0 + ai * 128 + m * 16);
                f32x4 v0 = acc[ai][0][m][0] * rs, v1 = acc[ai][0][m][1] * rs; float ss = 0.f; if (ssqo) ss = dot4(v0) + dot4(v1);
                if (rp0) { const f32x4 a = v0 * tc0[q] - v1 * ts0[q], b = v0 * ts0[q] + v1 * tc0[q]; v0 = a; v1 = b; }
                *(u32x4*)(p0 + (size_t)row * l0) = pack8(v0, v1);
                v0 = acc[ai][1][m][0] * rs; v1 = acc[ai][1][m][1] * rs; if (pn == 0) ss += dot4(v0) + dot4(v1);
                if (rp1) { const f32x4 a = v0 * tc1[q] - v1 * ts1[q], b = v0 * ts1[q] + v1 * tc1[q]; v0 = a; v1 = b; }
                if (st1) *(u32x4*)(p1 + (size_t)row * l1) = pack8(v0, v1);
                if (ssqo) { ss += __shfl_xor(ss, 16); ss += __shfl_xor(ss, 32); if (fq == 0) ((float*)(ws + ssqo))[(size_t)row * 4 + wc] = ss; } }
            EPI_FENCE; }
        return false;
    }
};
struct EpiQU {
    static constexpr bool PERM = true;
    unsigned char* ws;
    __device__ __forceinline__ bool operator()(f32x4 (&acc)[2][2][4][2], const Unit& u, int wr, int wc, int fr, int fq) const {
        const int row0 = u.pm * 256 + wr * 64 + fr, c0 = u.pn * 256 + wc * 32 + 8 * fq;
        const int d0 = c0 % 96, d1 = (c0 + 128) % 96; const bool rp0 = d0 >= 64, rp1 = d1 >= 64; const int fb0 = rp0 ? 4 * ((d0 - 64) >> 3) : 0, fb1 = rp1 ? 4 * ((d1 - 64) >> 3) : 0;
        const float* ct = WSP(const float, TAB_CM); const float* st = WSP(const float, TAB_SM);
        float rsv[2][4];
        EPI_ROWLOOP rsv[ai][m] = rsqrtf(ssq4(WSP(const float, WS_SSQCQ) + (size_t)(row0 + ai * 128 + m * 16) * 4) * (1.f / 256.f) + NEPS);
#pragma unroll
        for (int ai = 0; ai < 2; ++ai)
#pragma unroll
          for (int mp = 0; mp < 4; mp += 2) { f32x4 tc0[2], ts0[2], tc1[2], ts1[2];
#pragma unroll
            for (int q = 0; q < 2; ++q) { const int pos = (row0 + ai * 128 + (mp + q) * 16) & (SS - 1); tc0[q] = ts0[q] = tc1[q] = ts1[q] = (f32x4){0.f, 0.f, 0.f, 0.f};
                if (rp0) { tc0[q] = *(const f32x4*)(ct + (size_t)pos * 16 + fb0); ts0[q] = *(const f32x4*)(st + (size_t)pos * 16 + fb0); }
                if (rp1) { tc1[q] = *(const f32x4*)(ct + (size_t)pos * 16 + fb1); ts1[q] = *(const f32x4*)(st + (size_t)pos * 16 + fb1); } }
#pragma unroll
            for (int q = 0; q < 2; ++q) { const int m = mp + q; const int row = row0 + ai * 128 + m * 16; const float rs = rsv[ai][m];
                f32x4 v0 = acc[ai][0][m][0] * rs, v1 = acc[ai][0][m][1] * rs;
                if (rp0) { const f32x4 a = v0 * tc0[q] - v1 * ts0[q], b = v0 * ts0[q] + v1 * tc0[q]; v0 = a; v1 = b; }
                *(u32x4*)(WSP(bf16_t, WS_QM) + (size_t)row * 768 + c0) = pack8(v0, v1);
                v0 = acc[ai][1][m][0] * rs; v1 = acc[ai][1][m][1] * rs;
                if (rp1) { const f32x4 a = v0 * tc1[q] - v1 * ts1[q], b = v0 * ts1[q] + v1 * tc1[q]; v0 = a; v1 = b; }
                *(u32x4*)(WSP(bf16_t, WS_QM) + (size_t)row * 768 + c0 + 128) = pack8(v0, v1); }
            EPI_FENCE; }
        return false;
    }
};
struct EpiKVU {
    static constexpr bool PERM = true;
    unsigned char* ws;
    __device__ __forceinline__ bool operator()(f32x4 (&acc)[2][2][4][2], const Unit& u, int wr, int wc, int fr, int fq) const {
        const int row0 = u.pm * 256 + wr * 64 + fr, c0 = u.pn * 256 + wc * 32 + 8 * fq;
        float rsv[2][4];
        EPI_ROWLOOP rsv[ai][m] = rsqrtf(ssq4(WSP(const float, WS_SSQKV) + (size_t)(row0 + ai * 128 + m * 16) * 4) * (1.f / 128.f) + NEPS);
        EPI_ROWLOOP { const int row = row0 + ai * 128 + m * 16; const float rs = rsv[ai][m];
#pragma unroll
            for (int bj = 0; bj < 2; ++bj) { const int c = c0 + bj * 128; const f32x4 v0 = acc[ai][bj][m][0] * rs, v1 = acc[ai][bj][m][1] * rs;
                *(u32x4*)(WSP(bf16_t, WS_KVM) + (size_t)row * 1024 + c) = pack8(v0, v1); }
            EPI_FENCE; }
        return false;
    }
};
__device__ __forceinline__ float sigm(float v) { return __builtin_amdgcn_rcpf(1.f + __builtin_amdgcn_exp2f(-LOG2E * v)); }
struct EpiGate {
    static constexpr bool PERM = true;
    unsigned char* ws;
    __device__ __forceinline__ bool operator()(f32x4 (&acc)[2][2][4][2], const Unit& u, int wr, int wc, int fr, int fq) const {
        const int pn = u.pn, row0 = u.pm * 256 + wr * 64 + fr, cl0 = wc * 32 + 8 * fq;
        rstd_table(ws, u.pm); const int lrow0 = wr * 64 + fr;
        if (pn < 12) {
            bf16_t* dst = (pn < 4 ? WSP(bf16_t, WS_GMLA) : (pn < 8 ? WSP(bf16_t, WS_GMOBA) : WSP(bf16_t, WS_GRET))); const int cb0 = (pn & 3) * 256;
            EPI_ROWLOOP { const int row = row0 + ai * 128 + m * 16; const float rs = RSTAB(lrow0 + ai * 128 + m * 16);
#pragma unroll
                for (int bj = 0; bj < 2; ++bj) { const float nrs = -LOG2E * rs; f32x4 v0 = acc[ai][bj][m][0] * nrs, v1 = acc[ai][bj][m][1] * nrs;
#pragma unroll
                    for (int j = 0; j < 4; ++j) { v0[j] = fminf(1.f + __builtin_amdgcn_exp2f(v0[j]), 1e30f); v1[j] = fminf(1.f + __builtin_amdgcn_exp2f(v1[j]), 1e30f); }
                    *(u32x4*)(dst + (size_t)row * 1024 + cb0 + bj * 128 + cl0) = pack8(v0, v1); }
                EPI_FENCE; }
        } else {
            const int cb0 = (pn - 12) * 256;
#pragma unroll
            for (int ai = 0; ai < 2; ++ai) { u32x4 ov[4][2];
#pragma unroll
                for (int m = 0; m < 4; ++m)
#pragma unroll
                    for (int bj = 0; bj < 2; ++bj) ov[m][bj] = *(const u32x4*)(WSP(bf16_t, WS_RV) + (size_t)(row0 + ai * 128 + m * 16) * 512 + cb0 + bj * 128 + cl0);
#pragma unroll
                for (int m = 0; m < 4; ++m) { const int row = row0 + ai * 128 + m * 16; const float rs = RSTAB(lrow0 + ai * 128 + m * 16);
#pragma unroll
                    for (int bj = 0; bj < 2; ++bj) { f32x4 v0 = acc[ai][bj][m][0] * rs, v1 = acc[ai][bj][m][1] * rs; bf16_t* p = WSP(bf16_t, WS_RV) + (size_t)row * 512 + cb0 + bj * 128 + cl0;
                        f32x4 o0, o1; unpack8(ov[m][bj], o0, o1);
#pragma unroll
                        for (int j = 0; j < 4; ++j) { v0[j] = v0[j] * sigm(v0[j]) * o0[j]; v1[j] = v1[j] * sigm(v1[j]) * o1[j]; }
                        *(u32x4*)p = pack8(v0, v1); } }
                EPI_FENCE; }
        }
        return false;
    }
};
struct EpiMerge {
    static constexpr bool PERM = true;
    unsigned char* ws;
    __device__ __forceinline__ bool operator()(f32x4 (&acc)[2][2][4][2], const Unit& u, int wr, int wc, int fr, int fq) const {
        const int br = u.aux, row0 = u.pm * 256 + wr * 64 + fr, c0 = u.pn * 256 + wc * 32 + 8 * fq;
        const bf16_t* Ga = br == 0 ? WSP(bf16_t, WS_GMLA) : (br == 1 ? WSP(bf16_t, WS_GMOBA) : WSP(bf16_t, WS_GRET)); const bf16_t* Gb = br == 0 ? WSP(bf16_t, WS_GMOBA) : WSP(bf16_t, WS_GRET);
#pragma unroll
        for (int ai = 0; ai < 2; ++ai) { u32x4 ga[4][2], gb[4][2];
#pragma unroll
            for (int m = 0; m < 4; ++m)
#pragma unroll
                for (int bj = 0; bj < 2; ++bj) { const size_t off = (size_t)(row0 + ai * 128 + m * 16) * 1024 + c0 + bj * 128; ga[m][bj] = *(const u32x4*)(Ga + off); if (br < 2) gb[m][bj] = *(const u32x4*)(Gb + off); else gb[m][bj] = ga[m][bj]; }
#pragma unroll
            for (int m = 0; m < 4; ++m)
#pragma unroll
                for (int bj = 0; bj < 2; ++bj) { const size_t off = (size_t)(row0 + ai * 128 + m * 16) * 1024 + c0 + bj * 128; f32x4 a0, a1; unpack8(ga[m][bj], a0, a1);
                    if (br < 2) { f32x4 b0, b1; unpack8(gb[m][bj], b0, b1);
#pragma unroll
                        for (int j = 0; j < 4; ++j) { acc[ai][bj][m][0][j] *= b0[j] * __builtin_amdgcn_rcpf(a0[j]); acc[ai][bj][m][1][j] *= b1[j] * __builtin_amdgcn_rcpf(a1[j]); } }
                    else { f32x4 v0 = acc[ai][bj][m][0], v1 = acc[ai][bj][m][1];
#pragma unroll
                        for (int j = 0; j < 4; ++j) { v0[j] *= __builtin_amdgcn_rcpf(a0[j]); v1[j] *= __builtin_amdgcn_rcpf(a1[j]); }
                        *(u32x4*)(WSP(bf16_t, WS_MB) + off) = pack8(v0, v1); } }
            EPI_FENCE; }
        return br < 2;
    }
};
struct EpiRes {
    static constexpr bool PERM = false;
    const float* res; float* out; unsigned char* ws; int wxb;
    __device__ __forceinline__ bool operator()(f32x4 (&acc)[2][2][4][2], const Unit& u, int wr, int wc, int fr, int fq) const {
        const int row0 = u.pm * 256 + wr * 64 + fr, c0 = u.pn * 256 + wc * 32 + 4 * fq;
#pragma unroll
        for (int ai = 0; ai < 2; ++ai) { f32x4 rv[4][2][2];
#pragma unroll
            for (int m = 0; m < 4; ++m)
#pragma unroll
                for (int bj = 0; bj < 2; ++bj)
#pragma unroll
                    for (int n = 0; n < 2; ++n) rv[m][bj][n] = *(const f32x4*)(res + (size_t)(row0 + ai * 128 + m * 16) * 1024 + c0 + bj * 128 + n * 16);
#pragma unroll
            for (int m = 0; m < 4; ++m) { const int row = row0 + ai * 128 + m * 16; float ss = 0.f;
#pragma unroll
                for (int bj = 0; bj < 2; ++bj)
#pragma unroll
                    for (int n = 0; n < 2; ++n) { const size_t off = (size_t)row * 1024 + c0 + bj * 128 + n * 16;
                        const f32x4 v = acc[ai][bj][m][n] + rv[m][bj][n];
                        *(f32x4*)(out + off) = v; ss += dot4(v);
                        if (wxb) { const unsigned lo = pk2(v[0], v[1]), hi2 = pk2(v[2], v[3]); *(unsigned long long*)(WSP(bf16_t, WS_XB) + off) = (unsigned long long)lo | ((unsigned long long)hi2 << 32); } }
                ss += __shfl_xor(ss, 16); ss += __shfl_xor(ss, 32); if (fq == 0) WSP(float, WS_SSQX)[(size_t)row * 16 + u.pn * 4 + wc] = ss; }
            EPI_FENCE; }
        return false;
    }
};
struct EpiUp {
    static constexpr bool PERM = true;
    unsigned char* ws;
    __device__ __forceinline__ bool operator()(f32x4 (&acc)[2][2][4][2], const Unit& u, int wr, int wc, int fr, int fq) const {
        const int row0 = u.pm * 256 + wr * 64 + fr, c0 = u.pn * 256 + wc * 32 + 8 * fq;
        rstd_table(ws, u.pm); const int lrow0 = wr * 64 + fr;
        EPI_ROWLOOP { const int row = row0 + ai * 128 + m * 16; const float rs = RSTAB(lrow0 + ai * 128 + m * 16);
#pragma unroll
            for (int bj = 0; bj < 2; ++bj) { f32x4 v0 = acc[ai][bj][m][0] * rs, v1 = acc[ai][bj][m][1] * rs;
#pragma unroll
                for (int j = 0; j < 4; ++j) { const float a = fmaxf(v0[j], 0.f), b = fmaxf(v1[j], 0.f); v0[j] = a * a; v1[j] = b * b; }
                *(u32x4*)(WSP(bf16_t, WS_HID) + (size_t)row * 4096 + c0 + bj * 128) = pack8(v0, v1); }
            EPI_FENCE; }
        return false;
    }
};

namespace att {
constexpr int KSL = 12288, VSL = 8192;
constexpr int NSL = 4;
constexpr int L_K = 0, L_V = NSL * KSL, L_WS = L_V + NSL * VSL, L_OST = L_WS + 2048, L_SEL = L_OST + 32768, L_UM = L_SEL + 1024, L_KM = L_UM + 64, L_END = L_KM + 4096;
constexpr float NEG = -1e30f;
__device__ __forceinline__ int crow(int r, int hi) { return (r & 3) + 8 * (r >> 2) + 4 * hi; }
__device__ __forceinline__ void glds16(const void* gsrc, unsigned lds_dst) { unsigned keep;
    asm volatile("s_mov_b32 %0, m0\n\ts_mov_b32 m0, %2\n\ts_nop 0\n\tglobal_load_lds_dwordx4 %1, off\n\ts_mov_b32 m0, %0" : "=&s"(keep) : "v"(gsrc), "s"(lds_dst) : "memory"); }
__device__ __forceinline__ unsigned long long blk_list(unsigned um, int qb, bool own_first) { unsigned long long l = 0ull; int i = 0; if (own_first) { l = (unsigned long long)qb; i = 1; }
    for (; um; um &= um - 1u, ++i) l |= (unsigned long long)__builtin_ctz(um) << (4 * i); for (; i < 16; ++i) l |= (unsigned long long)qb << (4 * i); return l; }
#define nth_block(um, bi, qb) ((int)((blist >> (4 * (bi))) & 15ull))
__device__ __forceinline__ void pv(f32x16* o, int vb, bf16x8 pa0, bf16x8 pa1, bf16x8 pa2, bf16x8 pa3) {
#pragma unroll
    for (int d0 = 0; d0 < 2; ++d0) { s16x4 lo[4], hi[4];
#pragma unroll
        for (int ks = 0; ks < 4; ++ks) {
            asm volatile("ds_read_b64_tr_b16 %0,%1 offset:%c2" : "=&v"(lo[ks]) : "v"(vb), "i"(d0 * 4096 + ks * 1024) : "memory");
            asm volatile("ds_read_b64_tr_b16 %0,%1 offset:%c2" : "=&v"(hi[ks]) : "v"(vb), "i"(d0 * 4096 + ks * 1024 + 512) : "memory"); }
        asm volatile("s_waitcnt lgkmcnt(0)" ::: "memory"); __builtin_amdgcn_sched_barrier(0);
#define PK(k) (bf16x8){lo[k][0], lo[k][1], lo[k][2], lo[k][3], hi[k][0], hi[k][1], hi[k][2], hi[k][3]}
        o[d0] = __builtin_amdgcn_mfma_f32_32x32x16_bf16(pa0, PK(0), o[d0], 0, 0, 0);
        o[d0] = __builtin_amdgcn_mfma_f32_32x32x16_bf16(pa1, PK(1), o[d0], 0, 0, 0);
        o[d0] = __builtin_amdgcn_mfma_f32_32x32x16_bf16(pa2, PK(2), o[d0], 0, 0, 0);
        o[d0] = __builtin_amdgcn_mfma_f32_32x32x16_bf16(pa3, PK(3), o[d0], 0, 0, 0);
#undef PK
    }
}
#define ATT_WAITBAR() asm volatile("s_waitcnt vmcnt(0) lgkmcnt(0)\n\ts_barrier" ::: "memory")
__device__ __forceinline__ float max3a(float a, float b, float c) { float r; asm("v_max3_f32 %0, %1, %2, %3" : "=v"(r) : "v"(a), "v"(b), "v"(c)); return r; }
__device__ __forceinline__ float max2a(float a, float b) { float r; asm("v_max_f32_e32 %0, %1, %2" : "=v"(r) : "v"(a), "v"(b)); return r; }

template <int DQ, bool ROWSEL>
__device__ __forceinline__ void attn_unit(long rowbase, int qb, const bf16_t* Qh, int ldq, const bf16_t* Kh, int ldk, const bf16_t* Kpe, const bf16_t* Vh, int ldv, bf16_t* Oh, int ldo,
                                          LAS unsigned char* lds, unsigned umask) {
    const int tid = opaque_tid(), lane = tid & 63, r32 = lane & 31, hi = lane >> 5; const int wid = __builtin_amdgcn_readfirstlane(tid >> 6);
    const int q0 = qb * 256;
    const unsigned lds0 = (unsigned)(uintptr_t)lds;
    LAS float* wsf = (LAS float*)(lds + L_WS) + wid * 64;
    umask = (unsigned)__builtin_amdgcn_readfirstlane((int)umask);
    const int npast = __builtin_popcount(umask), NT = 4 * (npast + 1);
    const unsigned long long blist = blk_list(umask, qb, ROWSEL);
    const bf16_t* kl_ = Kh + (rowbase + lane) * ldk + wid * 8;
    const bf16_t* pl_ = (DQ == 96) ? Kpe + (rowbase + lane) * 32 + wid * 8 : Kh;
    const bf16_t* vl_ = Vh + (rowbase + 16 * (wid & 3) + (lane >> 2)) * ldv + (wid >> 2) * 32 + (lane & 3) * 8;
#define ATT_ISSUE(key0, slot) do { const long ko_ = (long)(key0); \
        glds16(kl_ + ko_ * ldk, (unsigned)__builtin_amdgcn_readfirstlane((int)(lds0 + L_K + (slot) * KSL + wid * 1024))); \
        if (DQ == 96 && wid < 4) glds16(pl_ + ko_ * 32, (unsigned)__builtin_amdgcn_readfirstlane((int)(lds0 + L_K + (slot) * KSL + (8 + wid) * 1024))); \
        glds16(vl_ + ko_ * ldv, (unsigned)__builtin_amdgcn_readfirstlane((int)(lds0 + L_V + (slot) * VSL + wid * 1024))); } while (0)
    bf16x8 qr[DQ / 16];
    { const bf16_t* Qw = Qh + (rowbase + q0 + wid * 32 + r32) * ldq + hi * 8;
#pragma unroll
      for (int d0 = 0; d0 < DQ / 16; ++d0) qr[d0] = *(const bf16x8*)(Qw + d0 * 16); }
#define ATT_WAITK(k) do { if (DQ == 96 && wid < 4) { if ((k) == 2) asm volatile("s_waitcnt vmcnt(6)" ::: "memory"); else if ((k) == 1) asm volatile("s_waitcnt vmcnt(3)" ::: "memory"); else asm volatile("s_waitcnt vmcnt(0)" ::: "memory"); } \
        else { if ((k) == 2) asm volatile("s_waitcnt vmcnt(4)" ::: "memory"); else if ((k) == 1) asm volatile("s_waitcnt vmcnt(2)" ::: "memory"); else asm volatile("s_waitcnt vmcnt(0)" ::: "memory"); } } while (0)
    ATT_ISSUE(nth_block(umask, 0, qb) * 256, 0); ATT_ISSUE(nth_block(umask, 0, qb) * 256 + 64, 1); ATT_ISSUE(nth_block(umask, 0, qb) * 256 + 128, 2);
    unsigned rowsel = 0xffffffffu; if (ROWSEL) rowsel = *(const LAS unsigned*)(lds + L_SEL + (wid * 32 + r32) * 4);
    float m_run = NEG, l_run = 0.f; f32x16 o[2]; o[0] = f32x16{}; o[1] = f32x16{};
    const int qrel = wid * 32 + r32;
    const int vb0 = (int)(lds0 + L_V) + ((lane >> 4) & 1) * 32 + (lane & 3) * 8 + (4 * hi + ((lane & 15) >> 2)) * 64;
    ATT_WAITK(2); asm volatile("s_waitcnt lgkmcnt(0)\n\ts_barrier" ::: "memory");
    constexpr int NP = DQ / 16;
#define SBAR() __builtin_amdgcn_sched_barrier(0)
#define EX2(x) __builtin_amdgcn_exp2f(x)
#define VTR(dst, off) asm volatile("ds_read_b64_tr_b16 %0,%1 offset:%c2" : "=&v"(dst) : "v"(vb_), "i"(off) : "memory")
#define MASK_TILE(P0, P1, tt) do { const int blk_ = nth_block(umask, (tt) >> 2, qb); \
        if (blk_ == qb) { const int kb = 64 * ((tt) & 3) + 4 * hi; \
            _Pragma("unroll") for (int r = 0; r < 16; ++r) { const int kv = kb + (r & 3) + 8 * (r >> 2); if (kv > qrel) P0[r] = NEG; if (kv + 32 > qrel) P1[r] = NEG; } \
        } } while (0)
#define ROWMAX_FIN(a_, b_, X0, X1) do { float rm_ = max2a(a_, b_); auto rr_ = __builtin_amdgcn_permlane32_swap(__float_as_uint(rm_), __float_as_uint(rm_), false, false); \
        rm_ = max2a(__uint_as_float(rr_[0]), __uint_as_float(rr_[1])); \
        if (NEGM) {   \
            if (__any(rm_ > 8.0f)) { const float dl_ = fmaxf(rm_, 0.f); m_run += dl_; fsc = EX2(-dl_); cupd = true; \
                _Pragma("unroll") for (int r = 0; r < 16; ++r) { X0[r] -= dl_; X1[r] -= dl_; } } else fsc = 1.f; } \
        else if (__any(rm_ - m_run > 8.0f)) { mn = fmaxf(m_run, rm_); fsc = EX2(m_run - mn); m_run = mn; } else { fsc = 1.f; mn = m_run; } } while (0)
#define ATT_STEP(MORE, P0, P1, N0, N1) do { \
        const int s = t & 3; \
        if (t + 3 < NT) { const int nb = nth_block(umask, (t + 3) >> 2, qb); ATT_ISSUE(nb * 256 + ((t + 3) & 3) * 64, (t + 3) & 3); } \
        const int vb_ = vb0 + s * VSL; const LAS unsigned char* kp_ = lds + L_K + ((t + 1) & 3) * KSL + hi * 1024 + r32 * 16; \
        const float mnc = mn, fc = fsc; s16x4 vlo[8], vhi[8]; bf16x8 ka = bf16x8{}, kb2 = bf16x8{}; \
        if (MORE) { ka = *(const LAS bf16x8*)(kp_); kb2 = *(const LAS bf16x8*)(kp_ + 512); } \
        SBAR(); \
        _Pragma("unroll") for (int i = 0; i < NP; ++i) { \
            if (MORE) { if (i == 0) { N0 = __builtin_amdgcn_mfma_f32_32x32x16_bf16(ka, qr[0], NEGM ? negm : f32x16{}, 0, 0, 0); N1 = __builtin_amdgcn_mfma_f32_32x32x16_bf16(kb2, qr[0], NEGM ? negm : f32x16{}, 0, 0, 0); } \
                        else { N0 = __builtin_amdgcn_mfma_f32_32x32x16_bf16(ka, qr[i], N0, 0, 0, 0); N1 = __builtin_amdgcn_mfma_f32_32x32x16_bf16(kb2, qr[i], N1, 0, 0, 0); } } \
            if (MORE && i + 1 < NP) { ka = *(const LAS bf16x8*)(kp_ + (i + 1) * 2048); kb2 = *(const LAS bf16x8*)(kp_ + (i + 1) * 2048 + 512); } \
            _Pragma("unroll") for (int v = (i * 8) / NP; v < ((i + 1) * 8) / NP; ++v) { const int q_ = v >> 1, idx = (q_ & 1) + 4 * (q_ >> 1), off = (idx >> 2) * 4096 + (idx & 3) * 1024 + (v & 1) * 512; if (v & 1) VTR(vhi[idx], off); else VTR(vlo[idx], off); }     \
            _Pragma("unroll") for (int e = (i * 32) / NP; e < ((i + 1) * 32) / NP; ++e) { if (e < 16) P0[e] = NEGM ? EX2(P0[e]) : EX2(P0[e] - mnc); else P1[e - 16] = NEGM ? EX2(P1[e - 16]) : EX2(P1[e - 16] - mnc); } \
            asm volatile("" : "+v"(P0), "+v"(P1)); SBAR(); } \
        const u32x4 pw0 = (u32x4){pk2(P0[0], P0[1]), pk2(P0[2], P0[3]), pk2(P0[4], P0[5]), pk2(P0[6], P0[7])}, pw1 = (u32x4){pk2(P0[8], P0[9]), pk2(P0[10], P0[11]), pk2(P0[12], P0[13]), pk2(P0[14], P0[15])}; \
        const u32x4 pw2 = (u32x4){pk2(P1[0], P1[1]), pk2(P1[2], P1[3]), pk2(P1[4], P1[5]), pk2(P1[6], P1[7])}, pw3 = (u32x4){pk2(P1[8], P1[9]), pk2(P1[10], P1[11]), pk2(P1[12], P1[13]), pk2(P1[14], P1[15])}; \
        asm volatile("s_waitcnt lgkmcnt(0)" ::: "memory"); \
        if (__any(fc != 1.f)) { if (hi == 0) wsf[r32] = fc; asm volatile("s_waitcnt lgkmcnt(0)" ::: "memory"); \
            _Pragma("unroll") for (int r = 0; r < 16; ++r) { const float fr_ = wsf[crow(r, hi)]; o[0][r] *= fr_; o[1][r] *= fr_; } \
            asm volatile("s_waitcnt lgkmcnt(0)" ::: "memory"); } \
        if (MORE) MASK_TILE(N0, N1, t + 1); \
        SBAR(); \
        float ma = NEG, mb = NEG, sa = 0.f, sb2 = 0.f; \
        _Pragma("unroll") for (int j = 0; j < 8; ++j) { const int d = j & 1, k = j >> 1; \
            if (j == 4) asm volatile("s_waitcnt lgkmcnt(0)" ::: "memory"); \
            const bf16x8 vf = (bf16x8){vlo[d * 4 + k][0], vlo[d * 4 + k][1], vlo[d * 4 + k][2], vlo[d * 4 + k][3], vhi[d * 4 + k][0], vhi[d * 4 + k][1], vhi[d * 4 + k][2], vhi[d * 4 + k][3]}; \
            const bf16x8 pa = __builtin_bit_cast(bf16x8, k == 0 ? pw0 : (k == 1 ? pw1 : (k == 2 ? pw2 : pw3))); \
            o[d] = __builtin_amdgcn_mfma_f32_32x32x16_bf16(pa, vf, o[d], 0, 0, 0); \
            if (MORE) { ma = max3a(ma, N0[2 * j], N0[2 * j + 1]); mb = max3a(mb, N1[2 * j], N1[2 * j + 1]); } \
            sa += P0[2 * j] + P0[2 * j + 1]; sb2 += P1[2 * j] + P1[2 * j + 1]; \
            if (j < 4) { const int idx2 = (j & 1) * 4 + 2 + (j >> 1), off2 = (idx2 >> 2) * 4096 + (idx2 & 3) * 1024; VTR(vlo[idx2], off2); VTR(vhi[idx2], off2 + 512); } \
            asm volatile("" : "+v"(sa), "+v"(sb2), "+v"(ma), "+v"(mb)); SBAR(); } \
        l_run = l_run * fc + (sa + sb2); \
        if (MORE) { bool cupd = false; ROWMAX_FIN(ma, mb, N0, N1); \
            if (cupd || (ROWSEL && ((t + 2) & 3) == 0)) { const int nb_ = nth_block(umask, (t + 2) >> 2, qb); \
                const float cv_ = (!ROWSEL || nb_ == qb || ((rowsel >> nb_) & 1u)) ? -m_run : NEG; \
                _Pragma("unroll") for (int r = 0; r < 16; ++r) negm[r] = cv_; } } \
        { const int k_ = (t + 3 < NT) ? 1 : 0; ATT_WAITK(k_); asm volatile("s_waitcnt lgkmcnt(0)\n\ts_barrier" ::: "memory"); } \
    } while (0)
    constexpr bool NEGM = true;
    f32x16 pa0, pa1, pb0, pb1, negm = f32x16{}; float mn = NEG, fsc = 1.f;
    { const LAS unsigned char* kp_ = lds + L_K + hi * 1024 + r32 * 16; pa0 = f32x16{}; pa1 = f32x16{};
#pragma unroll
      for (int d0 = 0; d0 < NP; ++d0) { const bf16x8 b0_ = *(const LAS bf16x8*)(kp_ + d0 * 2048), b1_ = *(const LAS bf16x8*)(kp_ + d0 * 2048 + 512);
          pa0 = __builtin_amdgcn_mfma_f32_32x32x16_bf16(b0_, qr[d0], pa0, 0, 0, 0); pa1 = __builtin_amdgcn_mfma_f32_32x32x16_bf16(b1_, qr[d0], pa1, 0, 0, 0); } }
    MASK_TILE(pa0, pa1, 0);
    { float ma = NEG, mb = NEG; bool cupd = false; (void)cupd;
#pragma unroll
      for (int j = 0; j < 8; ++j) { ma = fmaxf(ma, fmaxf(pa0[2 * j], pa0[2 * j + 1])); mb = fmaxf(mb, fmaxf(pa1[2 * j], pa1[2 * j + 1])); }
      if (NEGM) { float rm_ = fmaxf(ma, mb); auto rr_ = __builtin_amdgcn_permlane32_swap(__float_as_uint(rm_), __float_as_uint(rm_), false, false); rm_ = fmaxf(__uint_as_float(rr_[0]), __uint_as_float(rr_[1]));
          m_run = rm_; fsc = 1.f;
#pragma unroll
          for (int r = 0; r < 16; ++r) { pa0[r] -= rm_; pa1[r] -= rm_; negm[r] = -rm_; } }
      else ROWMAX_FIN(ma, mb, pa0, pa1); }
    ATT_WAITK(1); asm volatile("s_waitcnt lgkmcnt(0)\n\ts_barrier" ::: "memory");
    int t = 0;
    for (; t < NT - 2; t += 2) { ATT_STEP(true, pa0, pa1, pb0, pb1); ++t; ATT_STEP(true, pb0, pb1, pa0, pa1); --t; }
    ATT_STEP(true, pa0, pa1, pb0, pb1); ++t;
    ATT_STEP(false, pb0, pb1, pa0, pa1);
#undef ATT_STEP
#undef ROWMAX_FIN
#undef MASK_TILE
#undef VTR
#undef EX2
#undef SBAR
#undef ATT_ISSUE
#undef ATT_WAITK
    { auto rr = __builtin_amdgcn_permlane32_swap(__float_as_uint(l_run), __float_as_uint(l_run), false, false); l_run = __uint_as_float(rr[0]) + __uint_as_float(rr[1]); }
    if (hi == 0) wsf[32 + r32] = l_run; asm volatile("s_waitcnt lgkmcnt(0)" ::: "memory");
    float rli[16];
#pragma unroll
    for (int r = 0; r < 16; ++r) rli[r] = __builtin_amdgcn_rcpf(wsf[32 + crow(r, hi)]);
    bf16_t* Ow = Oh + (rowbase + q0 + wid * 32) * ldo;
    { LAS bf16_t* stg = (LAS bf16_t*)(lds + L_OST) + wid * 2048;
#pragma unroll
      for (int r = 0; r < 16; ++r) { const int orow = crow(r, hi);
#pragma unroll
          for (int d0 = 0; d0 < 2; ++d0) stg[orow * 64 + d0 * 32 + r32] = (bf16_t)(pk2(o[d0][r] * rli[r], 0.f) & 0xffffu); }
      asm volatile("s_waitcnt lgkmcnt(0)" ::: "memory");
#pragma unroll
      for (int i = 0; i < 4; ++i) { const int row = i * 8 + (lane >> 3), ch = lane & 7; const u32x4 v = *(const LAS u32x4*)(stg + row * 64 + ch * 8); *(u32x4*)(Ow + (long)row * ldo + ch * 8) = v; } }
    ATT_WAITBAR();
}
}

__device__ __forceinline__ f32x16 mfma32f(float a, float b, f32x16 c) { return __builtin_amdgcn_mfma_f32_32x32x2f32(a, b, c, 0, 0, 0); }
__device__ __forceinline__ bf16x8 ldpack(const LAS float* p, int stride) {
    const u32x4 w = (u32x4){pk2(p[0], p[stride]), pk2(p[2 * stride], p[3 * stride]), pk2(p[4 * stride], p[5 * stride]), pk2(p[6 * stride], p[7 * stride])};
    return __builtin_bit_cast(bf16x8, w);
}
__device__ __forceinline__ f32x16 mfma16b(bf16x8 a, bf16x8 b, f32x16 c) { return __builtin_amdgcn_mfma_f32_32x32x16_bf16(a, b, c, 0, 0, 0); }
__device__ __forceinline__ float ex2(float x) { return __builtin_amdgcn_exp2f(x); }

__device__ __forceinline__ void ret_kv_unit(int un, const bf16_t* RK, const bf16_t* RV, float* RKV, const float* lg2p, LAS unsigned char* lds) {
    const int tid = opaque_tid(), lane = tid & 63, r32 = lane & 31, hi = lane >> 5, wid = tid >> 6;
    const int bh = un >> 5, n = un & 31, b = bh >> 2, h = bh & 3; const long r0 = (long)b * SS + n * 128; const float lg = lg2p[h];
    LAS float* Kz = (LAS float*)lds; LAS float* Vs = (LAS float*)(lds + 32768);
    { const int row = tid >> 2, cs = (tid & 3) * 16; const float z = ex2(lg * (float)(127 - row)); const bf16_t* p = RK + (r0 + row) * 256 + h * 64 + cs;
      f32x4 a, bq; unpack8(*(const u32x4*)p, a, bq); *(LAS f32x4*)(Kz + row * 64 + cs) = a * z; *(LAS f32x4*)(Kz + row * 64 + cs + 4) = bq * z;
      unpack8(*(const u32x4*)(p + 8), a, bq); *(LAS f32x4*)(Kz + row * 64 + cs + 8) = a * z; *(LAS f32x4*)(Kz + row * 64 + cs + 12) = bq * z;
      const int vs = (tid & 3) * 32; const bf16_t* pv_ = RV + (r0 + row) * 512 + h * 128 + vs;
#pragma unroll
      for (int i = 0; i < 4; ++i) { unpack8(*(const u32x4*)(pv_ + 8 * i), a, bq); *(LAS f32x4*)(Vs + row * 128 + vs + 8 * i) = a; *(LAS f32x4*)(Vs + row * 128 + vs + 8 * i + 4) = bq; } }
    __syncthreads();
    const int dt = wid >> 2, et = wid & 3; f32x16 acc = f32x16{};
#pragma unroll 2
    for (int j0 = 0; j0 < 128; j0 += 16) acc = mfma16b(ldpack(Kz + (j0 + 8 * hi) * 64 + dt * 32 + r32, 64), ldpack(Vs + (j0 + 8 * hi) * 128 + et * 32 + r32, 128), acc);
    float* dst = RKV + (size_t)un * 8192;
#pragma unroll
    for (int r = 0; r < 16; ++r) dst[(dt * 32 + att::crow(r, hi)) * 128 + et * 32 + r32] = acc[r];
    __syncthreads();
}
__device__ __forceinline__ void ret_out_unit(int un, const bf16_t* RQ, const bf16_t* RK, bf16_t* RV, const float* RKV, const float* gnw, const float* gnb, const float* lg2p, LAS unsigned char* lds) {
    const int tid = opaque_tid(), lane = tid & 63, r32 = lane & 31, hi = lane >> 5, wid = tid >> 6;
    const int bh = un >> 5, n = un < 256 ? (un & 31) : 31 - (un & 31), b = bh >> 2, h = bh & 3; const long r0 = (long)b * SS + n * 128; const float lg = lg2p[h];
    LAS float* Qs = (LAS float*)lds; LAS float* Ks = (LAS float*)(lds + 33280); LAS float* Rs = (LAS float*)(lds + 66560); LAS float* Sm = (LAS float*)(lds + 66560); LAS float* Vs = (LAS float*)lds;
    { const int row = tid >> 2, cs = (tid & 3) * 16; const bf16_t* pq = RQ + (r0 + row) * 256 + h * 64 + cs; const bf16_t* pk = RK + (r0 + row) * 256 + h * 64 + cs;
      f32x4 a, bq;
#pragma unroll
      for (int i = 0; i < 2; ++i) { unpack8(*(const u32x4*)(pq + 8 * i), a, bq);
#pragma unroll
          for (int j = 0; j < 4; ++j) { Qs[row * 65 + cs + 8 * i + j] = a[j]; Qs[row * 65 + cs + 8 * i + 4 + j] = bq[j]; }
          unpack8(*(const u32x4*)(pk + 8 * i), a, bq);
#pragma unroll
          for (int j = 0; j < 4; ++j) { Ks[row * 65 + cs + 8 * i + j] = a[j]; Ks[row * 65 + cs + 8 * i + 4 + j] = bq[j]; } }
      { f32x4 r0 = (f32x4){0.f, 0.f, 0.f, 0.f}, r1 = r0, r2 = r0, r3 = r0; const float* base = RKV + (size_t)(bh * 32) * 8192 + tid * 4; int j = 0;
#pragma unroll 1
        for (; j + 1 < n; j += 2) { const float* p = base + (size_t)j * 8192; f32x4 a[2][4];
#pragma unroll
            for (int u = 0; u < 2; ++u)
#pragma unroll
                for (int q = 0; q < 4; ++q) a[u][q] = *(const f32x4*)(p + u * 8192 + q * 2048);
#pragma unroll
            for (int u = 0; u < 2; ++u) { const float w = ex2(lg * 128.0f * (float)(n - 1 - j - u)); r0 += a[u][0] * w; r1 += a[u][1] * w; r2 += a[u][2] * w; r3 += a[u][3] * w; } }
#pragma unroll 1
        for (; j < n; ++j) { const float w0 = ex2(lg * 128.0f * (float)(n - 1 - j)); const float* p = base + (size_t)j * 8192;
            r0 += *(const f32x4*)(p) * w0; r1 += *(const f32x4*)(p + 2048) * w0; r2 += *(const f32x4*)(p + 4096) * w0; r3 += *(const f32x4*)(p + 6144) * w0; }
        *(LAS f32x4*)(Rs + tid * 4) = r0; *(LAS f32x4*)(Rs + tid * 4 + 2048) = r1; *(LAS f32x4*)(Rs + tid * 4 + 4096) = r2; *(LAS f32x4*)(Rs + tid * 4 + 6144) = r3; } }
    __syncthreads();
    const int it = wid >> 1, eh = wid & 1; f32x16 acc0 = f32x16{}, acc1 = f32x16{};
    bf16x8 qa[4];
#pragma unroll
    for (int ks = 0; ks < 4; ++ks) { qa[ks] = ldpack(Qs + (32 * it + r32) * 65 + 16 * ks + 8 * hi, 1);
        acc0 = mfma16b(qa[ks], ldpack(Rs + (16 * ks + 8 * hi) * 128 + 64 * eh + r32, 128), acc0); acc1 = mfma16b(qa[ks], ldpack(Rs + (16 * ks + 8 * hi) * 128 + 64 * eh + 32 + r32, 128), acc1); }
#pragma unroll
    for (int r = 0; r < 16; ++r) { const float xi = ex2(lg * (float)(32 * it + att::crow(r, hi) + 1)); acc0[r] *= xi; acc1[r] *= xi; }
    __syncthreads();
#pragma unroll
    for (int jj = 0; jj < 2; ++jj) { const int jt = 2 * eh + jj; if (jt <= it) { f32x16 s = f32x16{};
#pragma unroll
        for (int ks = 0; ks < 4; ++ks) s = mfma16b(qa[ks], ldpack(Ks + (32 * jt + r32) * 65 + 16 * ks + 8 * hi, 1), s);
#pragma unroll
        for (int r = 0; r < 16; ++r) { const int i = 32 * it + att::crow(r, hi), j = 32 * jt + r32; Sm[i * 129 + j] = (i >= j) ? s[r] * ex2(lg * (float)(i - j)) : 0.f; } } }
    __syncthreads();
    { const int row = tid >> 2, vs = (tid & 3) * 32; const bf16_t* pv_ = RV + (r0 + row) * 512 + h * 128 + vs; f32x4 a, bq;
#pragma unroll
      for (int i = 0; i < 4; ++i) { unpack8(*(const u32x4*)(pv_ + 8 * i), a, bq); *(LAS f32x4*)(Vs + row * 128 + vs + 8 * i) = a; *(LAS f32x4*)(Vs + row * 128 + vs + 8 * i + 4) = bq; } }
    __syncthreads();
    { const int jend = 32 * (it + 1);
#pragma unroll 2
      for (int j0 = 0; j0 < jend; j0 += 16) { const bf16x8 a = ldpack(Sm + (32 * it + r32) * 129 + j0 + 8 * hi, 1);
          acc0 = mfma16b(a, ldpack(Vs + (j0 + 8 * hi) * 128 + 64 * eh + r32, 128), acc0); acc1 = mfma16b(a, ldpack(Vs + (j0 + 8 * hi) * 128 + 64 * eh + 32 + r32, 128), acc1); } }
    __syncthreads();
#pragma unroll
    for (int r = 0; r < 16; ++r) { const int i = 32 * it + att::crow(r, hi); Sm[i * 129 + 64 * eh + r32] = acc0[r]; Sm[i * 129 + 64 * eh + 32 + r32] = acc1[r]; }
    __syncthreads();
    { const int row = tid >> 2, q4 = tid & 3; float v[32]; float s = 0.f;
#pragma unroll
      for (int k = 0; k < 32; ++k) { v[k] = Sm[row * 129 + q4 * 32 + k]; s += v[k]; }
      s += __shfl_xor(s, 1); s += __shfl_xor(s, 2); const float mu = s * (1.f / 128.f); float q = 0.f;
#pragma unroll
      for (int k = 0; k < 32; ++k) { v[k] -= mu; q += v[k] * v[k]; }
      q += __shfl_xor(q, 1); q += __shfl_xor(q, 2); const float rstd = rsqrtf(q * (1.f / 128.f) + GNEPS);
      const float* gw = gnw + h * 128 + q4 * 32; const float* gb = gnb + h * 128 + q4 * 32; bf16_t* po = RV + (r0 + row) * 512 + h * 128 + q4 * 32;
#pragma unroll
      for (int i = 0; i < 4; ++i) { f32x4 a, bq; const f32x4 w0 = *(const f32x4*)(gw + 8 * i), w1 = *(const f32x4*)(gw + 8 * i + 4), b0 = *(const f32x4*)(gb + 8 * i), b1 = *(const f32x4*)(gb + 8 * i + 4);
#pragma unroll
          for (int j = 0; j < 4; ++j) { a[j] = v[8 * i + j] * rstd * w0[j] + b0[j]; bq[j] = v[8 * i + 4 + j] * rstd * w1[j] + b1[j]; }
          *(u32x4*)(po + 8 * i) = pack8(a, bq); } }
    __syncthreads();
}

__device__ __forceinline__ float wave_sum(float v) {
#pragma unroll
    for (int o = 1; o < 64; o <<= 1) v += __shfl_xor(v, o);
    return v;
}
__device__ __forceinline__ void sincos_acc(float ang, float& s, float& c) {
    const double a = (double)ang; const double k = rint(a * 0.63661977236758134308); const double r = a - k * 1.57079632679489661923; const double r2 = r * r;
    const double sr = r * (1.0 + r2 * (-1.0 / 6 + r2 * (1.0 / 120 + r2 * (-1.0 / 5040 + r2 * (1.0 / 362880 + r2 * (-1.0 / 39916800 + r2 * (1.0 / 6227020800.0)))))));
    const double cr = 1.0 + r2 * (-0.5 + r2 * (1.0 / 24 + r2 * (-1.0 / 720 + r2 * (1.0 / 40320 + r2 * (-1.0 / 3628800 + r2 * (1.0 / 479001600.0 - r2 * (1.0 / 87178291200.0)))))));
    const int q = ((int)k) & 3;
    const double sv = (q == 0) ? sr : (q == 1) ? cr : (q == 2) ? -sr : -cr, cv = (q == 0) ? cr : (q == 1) ? -sr : (q == 2) ? -cr : sr;
    s = (float)sv; c = (float)cv;
}
__device__ __forceinline__ int perm_pair(int d, int half) { const int i = d < half ? d : d - half; return 8 * (i >> 2) + (i & 3) + (d < half ? 0 : 4); }

__device__ __forceinline__ void map_row(int kind, int n, int& row, float& sc) {
    const float c2m = 0.125f * LOG2E, c2q = 0.10206207261596575f * LOG2E;
    sc = 1.f; row = n;
    if (kind == 1) {
        if (n < 384) row = n;
        else if (n < 416) row = 384 + perm_pair(n - 384, 16);
        else if (n < 1952) { const int s = n - 416, sec = s >> 9, w = s & 511, hd = w >> 6, d = w & 63; row = 512 + sec * 512 + hd * 64 + ((sec < 2 && d < 16) ? perm_pair(d, 8) : d); if (sec == 0) sc = c2m; }
        else if (n < 2464) { const int s = n - 1952, sec = s >> 8, hd = (s & 255) >> 6, d = s & 63; row = 2048 + sec * 256 + hd * 64 + perm_pair(d, 32); if (sec == 1) sc = 0.125f; }
        else if (n < 2976) row = 2560 + (n - 2464);
        else if (n < 3488) row = 6144 + (n - 2976);
        else row = 3072 + (n - 3488);
    } else if (kind == 2) { const int hd = n / 96, d = n % 96; row = hd * 96 + (d < 64 ? d : 64 + perm_pair(d - 64, 16)); sc = c2q; }
}
__device__ __forceinline__ void tr_item(const float* __restrict__ W, int K, int N, bf16_t* WT, const float* gain, int kind, LAS float* scr, int item, int lane) {
    const int nblk = N / 32, kb = item / nblk, nb = item % nblk, k0 = 64 * kb, n0 = 32 * nb;
#pragma unroll
    for (int i = 0; i < 32; ++i) { const int kk = 2 * i + (lane >> 5); scr[kk * 33 + (lane & 31)] = W[(size_t)(k0 + kk) * N + n0 + (lane & 31)]; }
    asm volatile("s_waitcnt lgkmcnt(0)" ::: "memory");
    const int c = lane & 7; f32x4 g0 = (f32x4){1.f, 1.f, 1.f, 1.f}, g1 = g0;
    if (gain) { g0 = *(const f32x4*)(gain + k0 + 8 * c); g1 = *(const f32x4*)(gain + k0 + 8 * c + 4); }
#pragma unroll
    for (int j = 0; j < 4; ++j) { const int n = (lane >> 3) + 8 * j; int row; float sc; map_row(kind, n0 + n, row, sc); const LAS float* s = scr + (8 * c) * 33 + n;
        u32x4 o; o.x = pk2(s[0 * 33] * g0[0] * sc, s[1 * 33] * g0[1] * sc); o.y = pk2(s[2 * 33] * g0[2] * sc, s[3 * 33] * g0[3] * sc); o.z = pk2(s[4 * 33] * g1[0] * sc, s[5 * 33] * g1[1] * sc); o.w = pk2(s[6 * 33] * g1[2] * sc, s[7 * 33] * g1[3] * sc);
        *(u32x4*)(WT + (size_t)row * K + k0 + 8 * c) = o; }
    asm volatile("s_waitcnt lgkmcnt(0)" ::: "memory");
}


constexpr size_t WS_BAR = 1835008;
constexpr int LDS_MISC = 140000;
#define XB_TMO      128
#define XB_XCNT(j)  (256  + 64 * (j))
#define XB_XSUB(j)  (1280 + 64 * (j))
#define XB_XGEN(j)  (2304 + 64 * (j))
#define XB_TOP      3328
#define XB_TOPGEN   3392
#define XCD_BAR_WORDS 3456
#define XB_SPIN_CAP (1u << 22)
__device__ __forceinline__ unsigned xb_ld(unsigned* p)              { return __hip_atomic_load(p, __ATOMIC_RELAXED, __HIP_MEMORY_SCOPE_AGENT); }
__device__ __forceinline__ unsigned xb_add(unsigned* p, unsigned v) { return __hip_atomic_fetch_add(p, v, __ATOMIC_RELAXED, __HIP_MEMORY_SCOPE_AGENT); }
__device__ __forceinline__ unsigned xb_xcc_id() { return (unsigned)__builtin_amdgcn_s_getreg((3 << 11) | 20) & 0xFu; }
#define XB_SPIN(cond, bar) do { unsigned _sp = 0; while (cond) { __builtin_amdgcn_s_sleep(1); \
    if ((++_sp & 255u) == 0u) { if (xb_ld(&(bar)[XB_TMO])) break; if (_sp > XB_SPIN_CAP) { atomicAdd(&(bar)[XB_TMO], 1u); break; } } } } while (0)
__device__ __forceinline__ void xcd_barrier_complete(unsigned* bar, unsigned x, unsigned& nloc, unsigned& nx) {
    const unsigned G = gridDim.x;
    unsigned sum, cnt, mine, sp = 0u;
    for (;;) {
        sum = 0u; cnt = 0u; mine = 0u;
#pragma unroll
        for (unsigned j = 0; j < 16; ++j) { const unsigned c = xb_ld(&bar[XB_XCNT(j)]); sum += c; cnt += (c > 0u) ? 1u : 0u; mine = (j == x) ? c : mine; }
        if (sum == G) break;
        __builtin_amdgcn_s_sleep(1);
        if ((++sp & 255u) == 0u) { if (xb_ld(&bar[XB_TMO])) break; if (sp > XB_SPIN_CAP) { atomicAdd(&bar[XB_TMO], 1u); break; } }
    }
    nloc = mine > 0u ? mine : 1u; nx = cnt > 0u ? cnt : 1u;
}
__device__ __forceinline__ void grid_bar(unsigned char* wsb, LAS unsigned char* ldsb) {
    asm volatile("s_waitcnt vmcnt(0)" ::: "memory");
    __syncthreads();
    if (threadIdx.x == 0) {
        unsigned* bar = (unsigned*)(wsb + WS_BAR); volatile LAS unsigned* st = (volatile LAS unsigned*)(ldsb + LDS_MISC); const unsigned x = xb_xcc_id();
        __builtin_amdgcn_s_waitcnt(0);
        unsigned nloc = st[0], nx = st[1];
        if (nloc == 0u) { xcd_barrier_complete(bar, x, nloc, nx); st[0] = nloc; st[1] = nx; }
        const unsigned old = xb_add(&bar[XB_XSUB(x)], 1u);
        const unsigned gen = old / nloc;
        if (old + 1u == (gen + 1u) * nloc) {
            __builtin_amdgcn_fence(__ATOMIC_RELEASE, "agent");
            asm volatile("s_waitcnt vmcnt(0)" ::: "memory");
            const unsigned og = xb_add(&bar[XB_TOP], 1u);
            const unsigned tg = og / nx;
            if (og + 1u == (tg + 1u) * nx) xb_add(&bar[XB_TOPGEN], 1u);
            else XB_SPIN(xb_ld(&bar[XB_TOPGEN]) == tg, bar);
            __builtin_amdgcn_fence(__ATOMIC_ACQUIRE, "agent");
            xb_add(&bar[XB_XGEN(x)], 1u);
            asm volatile("s_waitcnt vmcnt(0)" ::: "memory");
        } else {
            XB_SPIN(xb_ld(&bar[XB_XGEN(x)]) == gen, bar);
            __builtin_amdgcn_fence(__ATOMIC_ACQUIRE, "agent");
            asm volatile("s_waitcnt vmcnt(0)" ::: "memory");
        }
    }
    __syncthreads();
}

__device__ __forceinline__ unsigned char* ap_ws() { const __attribute__((address_space(4))) Args* ap = (const __attribute__((address_space(4))) Args*)__builtin_amdgcn_kernarg_segment_ptr(); asm volatile("" : "+s"(ap)); return ap->ws; }
#ifdef PROBE_A
#define STAMP(k) do { unsigned long long* tsp_ = (unsigned long long*)(ap_ws() + WS_TS); if (blockIdx.x == 0 && threadIdx.x == 0) tsp_[(k)] = __builtin_amdgcn_s_memrealtime(); } while (0)
#else
#define STAMP(k) do {} while (0)
#endif
__global__ void __launch_bounds__(512) mega_fwd(Args args) {
    extern __shared__ __attribute__((aligned(16))) unsigned char lds_raw[];
    LAS unsigned char* lds = (LAS unsigned char*)lds_raw;
    {
      unsigned* bar = (unsigned*)(args.ws + WS_BAR);
      if (threadIdx.x < 2) ((volatile LAS unsigned*)(lds + LDS_MISC))[threadIdx.x] = 0u;
      if (args.use_cg_sync) cg::this_grid().sync();
      if (threadIdx.x == 0) (void)xb_add(&bar[XB_XCNT(xb_xcc_id())], 1u);
      __syncthreads();
    }
    STAMP(0);
#define PHASE_VARS \
    const __attribute__((address_space(4))) Args* ap = (const __attribute__((address_space(4))) Args*)__builtin_amdgcn_kernarg_segment_ptr(); asm volatile("" : "+s"(ap)); \
    unsigned char* ws = ap->ws; float* out = ap->out; (void)out; (void)ws; \
    int G = (int)gridDim.x, bx = (int)blockIdx.x; asm volatile("" : "+s"(G), "+s"(bx)); \
    const int tid = opaque_tid(), lane = tid & 63, wave = __builtin_amdgcn_readfirstlane(tid >> 6); (void)lane; (void)wave; \
    const int vcu = (G % 8 == 0) ? (bx % 8) * (G / 8) + bx / 8 : bx; const int gw = vcu * 8 + wave, NGW = G * 8; (void)gw; (void)NGW; (void)vcu;
    if (PH(0)) { PHASE_VARS
            {
                for (int idx = (vcu * 512 + tid); idx < SS * 56; idx += G * 512) { const int pos = idx / 56, f = idx % 56; float s, c;
                    if (f < 16) { sincos_acc((float)pos * ap->inv_mla[f], s, c); ((float*)(ws + TAB_CM))[pos * 16 + f] = c; ((float*)(ws + TAB_SM))[pos * 16 + f] = s; }
                    else if (f < 24) { sincos_acc((float)pos * ap->inv_moba[f - 16], s, c); ((float*)(ws + TAB_CB))[pos * 8 + f - 16] = c; ((float*)(ws + TAB_SB))[pos * 8 + f - 16] = s; }
                    else { sincos_acc((float)pos * ap->inv_ret[f - 24], s, c); ((float*)(ws + TAB_CR))[pos * 32 + f - 24] = c; ((float*)(ws + TAB_SR))[pos * 32 + f - 24] = s; } }
                const float* x = ap->in[0]; bf16_t* XB = WSP(bf16_t, WS_XB); float* SSQ_X = WSP(float, WS_SSQX);
                for (int m = gw; m < TT; m += NGW) { const f32x4* xr = (const f32x4*)(x + (size_t)m * DM) + lane; f32x4 v[4]; float s = 0.f;
#pragma unroll
                    for (int j = 0; j < 4; ++j) { v[j] = xr[64 * j]; s += dot4(v[j]); }
                    s = wave_sum(s);
                    unsigned long long* o8 = (unsigned long long*)(XB + (size_t)m * DM) + lane;
#pragma unroll
                    for (int j = 0; j < 4; ++j) o8[64 * j] = (unsigned long long)pk2(v[j][0], v[j][1]) | ((unsigned long long)pk2(v[j][2], v[j][3]) << 32);
                    if (lane < 16) SSQ_X[(size_t)m * 16 + lane] = lane == 0 ? s : 0.f; }
            }
    }
#pragma unroll 1
    for (int l = 0; l < 2; ++l) {
        if (PH(0)) {
            PHASE_VARS
            LAS float* scr = (LAS float*)(lds + wave * 16384);
            constexpr int I_IN = 16 * 205, I_QU = 4 * 24, I_KVU = 2 * 32, I_BR = 8 * 32, I_O = 16 * 32, I_UP = 16 * 128, I_DN = 64 * 32;
            constexpr int NITEMS = I_IN + I_QU + I_KVU + 3 * I_BR + I_O + I_UP + I_DN;
            for (int it = gw; it < NITEMS; it += NGW) {
                int r = it;
                if (r < I_IN) { tr_item(ap->in[2] + (size_t)l * 1024 * 6560, 1024, 6560, (bf16_t*)(ws + W_IN), ap->in[1] + l * 1024, 1, scr, r, lane); continue; } r -= I_IN;
                if (r < I_QU) { tr_item(ap->in[5] + (size_t)l * 256 * 768, 256, 768, (bf16_t*)(ws + W_QU), ap->in[3] + l * 256, 2, scr, r, lane); continue; } r -= I_QU;
                if (r < I_KVU) { tr_item(ap->in[6] + (size_t)l * 128 * 1024, 128, 1024, (bf16_t*)(ws + W_KVU), ap->in[4] + l * 128, 0, scr, r, lane); continue; } r -= I_KVU;
                if (r < 3 * I_BR) { const int br = r / I_BR; tr_item(ap->in[9 + br] + (size_t)l * 512 * 1024, 512, 1024, (bf16_t*)(ws + W_BR) + (size_t)br * 1024 * 512, nullptr, 0, scr, r - br * I_BR, lane); continue; } r -= 3 * I_BR;
                if (r < I_O) { tr_item(ap->in[12] + (size_t)l * 1024 * 1024, 1024, 1024, (bf16_t*)(ws + W_OUT), nullptr, 0, scr, r, lane); continue; } r -= I_O;
                if (r < I_UP) { tr_item(ap->in[14] + (size_t)l * 1024 * 4096, 1024, 4096, (bf16_t*)(ws + W_UP), ap->in[13] + l * 1024, 0, scr, r, lane); continue; } r -= I_UP;
                tr_item(ap->in[15] + (size_t)l * 4096 * 1024, 4096, 1024, (bf16_t*)(ws + W_DN), nullptr, 0, scr, r, lane);
            }
        }
        grid_bar(ap_ws(), lds);
        STAMP(1 + l * 12 + 0);
        if (PH(1)) { PHASE_VARS pg8::Gemm g{1024, 1024, 1024}; pg8::SchedStd S; S.init(ws + WS_XB, ws + W_IN, 1024, 1024, 64, 12, G, bx);
          EpiP1 E{ws}; pg8::gemm_phase(lds, g, S, E); }
        grid_bar(ap_ws(), lds);
        STAMP(1 + l * 12 + 1);
        if (PH(2)) { PHASE_VARS pg8::Gemm g{256, 256, 256}; pg8::SchedStd S; S.init(ws + WS_CQ, ws + W_QU, 256, 256, 64, 3, G, bx); EpiQU E{ws}; pg8::gemm_phase(lds, g, S, E); }
        if (PH(3)) { PHASE_VARS pg8::Gemm g{128, 128, 128}; pg8::SchedStd S; S.init(ws + WS_CKV, ws + W_KVU, 128, 128, 64, 4, G, bx); EpiKVU E{ws}; pg8::gemm_phase(lds, g, S, E); }
        __syncthreads();
        STAMP(30 + l * 8 + 0);
        if (PH(4)) { PHASE_VARS
          for (int un = vcu; un < 256; un += G) {
            const int bq = un >> 2, qtr = un & 3, b = bq >> 4, blk = bq & 15; const bf16_t* p = WSP(bf16_t, WS_MK) + ((size_t)b * SS + blk * 256 + qtr * 64) * 512 + tid; float s = 0.f;
#pragma unroll 32
            for (int j = 0; j < 64; ++j) s += __uint_as_float((unsigned)p[(size_t)j * 512] << 16);
            WSP(float, WS_KMP)[(size_t)un * 512 + tid] = s; } }
        STAMP(30 + l * 8 + 1);
        if (PH(5)) { PHASE_VARS for (int un = vcu; un < 512; un += G) ret_kv_unit(un, WSP(bf16_t, WS_RK), WSP(bf16_t, WS_RV), WSP(float, WS_RKV), (const float*)ap->ret_lg2, lds); }
        grid_bar(ap_ws(), lds);
        STAMP(1 + l * 12 + 2);
        if (PH(6)) { PHASE_VARS
          for (int un = vcu; un < 512; un += G) {
            const int bh = (un & 255) >> 3, qb = un < 256 ? (un & 7) : 15 - (un & 7), b = bh >> 3, h = bh & 7;
            att::attn_unit<96, false>((long)b * SS, qb, WSP(bf16_t, WS_QM) + h * 96, 768, WSP(bf16_t, WS_KVM) + h * 128, 1024, WSP(bf16_t, WS_KPE), WSP(bf16_t, WS_KVM) + h * 128 + 64, 1024, WSP(bf16_t, WS_OM) + h * 64, 512, lds, (1u << qb) - 1u);
          } }
        STAMP(30 + l * 8 + 2);
        if (PH(7)) { PHASE_VARS
          for (int un = vcu; un < 512; un += G) {
            const int bh = (un & 255) >> 3, qb = un < 256 ? (un & 7) : 15 - (un & 7), b = bh >> 3, h = bh & 7;
            LAS float* km = (LAS float*)(lds + att::L_KM); LAS unsigned* selp = (LAS unsigned*)(lds + att::L_SEL); LAS unsigned* ump = (LAS unsigned*)(lds + att::L_UM);
            bf16_t* MQ = WSP(bf16_t, WS_MQ);
            if (tid == 0) *ump = 0u;
            for (int e = tid; e < 1024; e += 512) { const int n = e >> 6, d = e & 63; float s = 0.f;
                if (n < qb) { const float* p = WSP(float, WS_KMP) + ((size_t)(b * 16 + n) * 4) * 512 + h * 64 + d; s = (p[0] + p[512]) + (p[1024] + p[1536]); }
                km[e] = s * (1.f / 256.f); }
            __syncthreads();
            if (tid < 256) { const bf16_t* qp = MQ + ((size_t)b * SS + qb * 256 + tid) * 512 + h * 64;
                float v1 = -INFINITY, v2 = -INFINITY, v3 = -INFINITY; int i1 = 0, i2 = 0, i3 = 0;
#pragma unroll 1
                for (int n = 0; n < qb; ++n) { float gsum = 0.f;
#pragma unroll
                    for (int i = 0; i < 8; ++i) { f32x4 a, bq; unpack8(*(const u32x4*)(qp + 8 * i), a, bq); const f32x4 k0 = *(const LAS f32x4*)(km + n * 64 + 8 * i), k1 = *(const LAS f32x4*)(km + n * 64 + 8 * i + 4);
                        gsum += (a[0] * k0[0] + a[1] * k0[1]) + (a[2] * k0[2] + a[3] * k0[3]) + (bq[0] * k1[0] + bq[1] * k1[1]) + (bq[2] * k1[2] + bq[3] * k1[3]); }
                    if (gsum > v1) { v3 = v2; i3 = i2; v2 = v1; i2 = i1; v1 = gsum; i1 = n; } else if (gsum > v2) { v3 = v2; i3 = i2; v2 = gsum; i2 = n; } else if (gsum > v3) { v3 = gsum; i3 = n; } }
                unsigned sel = qb <= 3 ? ((1u << qb) - 1u) : ((1u << i1) | (1u << i2) | (1u << i3));
                selp[tid] = sel;
                unsigned um = sel;
#pragma unroll
                for (int o = 1; o < 64; o <<= 1) um |= (unsigned)__shfl_xor((int)um, o);
                if (lane == 0) atomicOr((unsigned*)ump, um); }
            __syncthreads();
            const unsigned umask = *ump;
            att::attn_unit<64, true>((long)b * SS, qb, MQ + h * 64, 512, WSP(bf16_t, WS_MK) + h * 64, 512, nullptr, WSP(bf16_t, WS_MV) + h * 64, 512, MQ + h * 64, 512, lds, umask);
          } }
        STAMP(30 + l * 8 + 3);
        if (PH(8)) { PHASE_VARS for (int un = vcu; un < 512; un += G) ret_out_unit(un, WSP(bf16_t, WS_RQ), WSP(bf16_t, WS_RK), WSP(bf16_t, WS_RV), WSP(float, WS_RKV), ap->in[7] + l * 512, ap->in[8] + l * 512, (const float*)ap->ret_lg2, lds); }
        grid_bar(ap_ws(), lds);
        STAMP(1 + l * 12 + 3);
        if (PH(9)) { PHASE_VARS pg8::Gemm g{1024, 1024, 1024}; pg8::SchedStd S; S.init(ws + WS_XB, ws + W_IN + (size_t)3072 * 1024 * 2, 1024, 1024, 64, 14, G, bx);
          EpiGate E{ws}; pg8::gemm_phase(lds, g, S, E); }
        grid_bar(ap_ws(), lds);
        STAMP(1 + l * 12 + 4);
        if (PH(10)) { PHASE_VARS pg8::Gemm g{512, 512, 512}; pg8::SchedMerge S{(const char*)(ws + WS_OM), (const char*)(ws + WS_MQ), (const char*)(ws + WS_RV), (const char*)(ws + W_BR), G, bx};
          EpiMerge E{ws}; pg8::gemm_phase(lds, g, S, E); }
        grid_bar(ap_ws(), lds);
        STAMP(1 + l * 12 + 5);
        if (PH(11)) { PHASE_VARS pg8::Gemm g{1024, 1024, 1024}; pg8::SchedStd S; S.init(ws + WS_MB, ws + W_OUT, 1024, 1024, 64, 4, G, bx);
          EpiRes E{l == 0 ? ap->in[0] : (const float*)out, out, ws, 1}; pg8::gemm_phase(lds, g, S, E); }
        grid_bar(ap_ws(), lds);
        STAMP(1 + l * 12 + 6);
        if (PH(12)) { PHASE_VARS pg8::Gemm g{1024, 1024, 1024}; pg8::SchedStd S; S.init(ws + WS_XB, ws + W_UP, 1024, 1024, 64, 16, G, bx); EpiUp E{ws}; pg8::gemm_phase(lds, g, S, E); }
        grid_bar(ap_ws(), lds);
        STAMP(1 + l * 12 + 7);
        if (PH(13)) { PHASE_VARS pg8::Gemm g{4096, 4096, 4096}; pg8::SchedStd S; S.init(ws + WS_HID, ws + W_DN, 4096, 4096, 64, 4, G, bx); EpiRes E{(const float*)out, out, ws, l == 0 ? 1 : 0}; pg8::gemm_phase(lds, g, S, E); }
        grid_bar(ap_ws(), lds);
        STAMP(1 + l * 12 + 8);
    }
    { PHASE_VARS const float* fn = ap->in[16];
      for (int m = gw; m < TT; m += NGW) { f32x4* xr = (f32x4*)(out + (size_t)m * DM) + lane; f32x4 v[4]; float s = 0.f;
#pragma unroll
          for (int j = 0; j < 4; ++j) { v[j] = xr[64 * j]; s += dot4(v[j]); }
          s = wave_sum(s); const float rs = rsqrtf(s * (1.f / 1024.f) + NEPS);
#pragma unroll
          for (int j = 0; j < 4; ++j) { const f32x4 gsc = *((const f32x4*)fn + lane + 64 * j); xr[64 * j] = v[j] * rs * gsc; } }
#ifdef PROBE_A
      { const unsigned long long* ts = (const unsigned long long*)(ws + WS_TS); const float dlt = (float)(ts[PROBE_B] - ts[PROBE_A]) * 4e-7f;
        for (int m = gw; m < 1024; m += NGW) { f32x4* xr = (f32x4*)(out + (size_t)m * DM) + lane;
#pragma unroll
          for (int j = 0; j < 4; ++j) xr[64 * j] = xr[64 * j] + dlt; } }
#endif
    }
}

extern "C" void kernel_launch(void* const* d_in, const int* in_sizes, int n_in, void* d_out, int out_size, void* d_ws, size_t ws_size, hipStream_t stream) {
    static int grid = 0;
    if (grid == 0) {
        if (n_in != 17 || out_size != TT * DM || ws_size < WS_END) { fprintf(stderr, "kernel_launch: unexpected shapes (n_in %d out %d ws %zu)\n", n_in, out_size, ws_size); grid = -1; return; }
        int dev = 0, cus = 0, per_cu = 0;
        hipGetDevice(&dev); hipDeviceGetAttribute(&cus, hipDeviceAttributeMultiprocessorCount, dev);
        hipFuncSetAttribute((const void*)mega_fwd, hipFuncAttributeMaxDynamicSharedMemorySize, LDS_BYTES);
        hipOccupancyMaxActiveBlocksPerMultiprocessor(&per_cu, (const void*)mega_fwd, 512, LDS_BYTES);
        if (per_cu < 1) per_cu = 1;
        grid = cus * per_cu;
        (void)hipGetLastError();
    }
    if (grid < 0) return;
    Args a{};
    for (int i = 0; i < 17; ++i) a.in[i] = (const float*)d_in[i];
    a.out = (float*)d_out; a.ws = (unsigned char*)d_ws;
    for (int i = 0; i < 16; ++i) a.inv_mla[i] = 1.0f / powf(500000.0f, (float)(2 * i) / 32.0f);
    for (int i = 0; i < 8; ++i) a.inv_moba[i] = 1.0f / powf(500000.0f, (float)(2 * i) / 16.0f);
    for (int i = 0; i < 32; ++i) a.inv_ret[i] = 1.0f / powf(10000.0f, (float)(2 * i) / 64.0f);
    for (int i = 0; i < 4; ++i) a.ret_lg2[i] = (float)log2(1.0 - pow(2.0, -5.0 - (double)i));
    a.use_cg_sync = 0; a.pad_ = 0;
    (void)hipMemsetAsync((unsigned char*)d_ws + WS_BAR, 0, XCD_BAR_WORDS * 4, stream);
    void* kargs[] = {&a};
    hipError_t e = hipLaunchCooperativeKernel((const void*)mega_fwd, dim3(grid), dim3(512), kargs, LDS_BYTES, stream);
    if (e != hipSuccess) fprintf(stderr, "cooperative launch failed: %s (grid %d)\n", hipGetErrorString(e), grid);
}
```

```cpp
#include <hip/hip_runtime.h>
#include <hip/hip_cooperative_groups.h>
#include <cstdio>
#include <cstdint>
#include <cmath>
namespace cg = cooperative_groups;

#define LAS __attribute__((address_space(3)))
typedef unsigned short bf16_t;
typedef short bf16x8 __attribute__((ext_vector_type(8)));
typedef float f32x4 __attribute__((ext_vector_type(4)));
typedef float f32x16 __attribute__((ext_vector_type(16)));
typedef unsigned u32x4 __attribute__((ext_vector_type(4)));
typedef short s16x4 __attribute__((ext_vector_type(4)));
typedef float f32x2_t __attribute__((ext_vector_type(2)));
typedef __bf16 bf16x2_t __attribute__((ext_vector_type(2)));

__device__ __forceinline__ unsigned pk2(float lo, float hi) { f32x2_t v = {lo, hi}; bf16x2_t b = __builtin_convertvector(v, bf16x2_t); return __builtin_bit_cast(unsigned, b); }
__device__ __forceinline__ u32x4 pack8(f32x4 a, f32x4 b) { return (u32x4){pk2(a[0], a[1]), pk2(a[2], a[3]), pk2(b[0], b[1]), pk2(b[2], b[3])}; }
__device__ __forceinline__ void unpack8(u32x4 w, f32x4& a, f32x4& b) {
    a[0] = __uint_as_float(w.x << 16); a[1] = __uint_as_float(w.x & 0xffff0000u); a[2] = __uint_as_float(w.y << 16); a[3] = __uint_as_float(w.y & 0xffff0000u);
    b[0] = __uint_as_float(w.z << 16); b[1] = __uint_as_float(w.z & 0xffff0000u); b[2] = __uint_as_float(w.w << 16); b[3] = __uint_as_float(w.w & 0xffff0000u);
}
__device__ __forceinline__ int opaque_tid() { int t = threadIdx.x; asm volatile("" : "+v"(t)); return t; }
__device__ __forceinline__ float dot4(f32x4 a) { return (a[0] * a[0] + a[1] * a[1]) + (a[2] * a[2] + a[3] * a[3]); }

constexpr int TT = 16384, SS = 4096, DM = 1024;
constexpr float NEPS = 1e-6f, GNEPS = 1e-5f;
constexpr float LOG2E = 1.4426950408889634f;
constexpr size_t MiB = 1u << 20;
constexpr size_t TAB_CM = 0, TAB_SM = 262144, TAB_CB = 524288, TAB_SB = 655360, TAB_CR = 786432, TAB_SR = 1310720;
constexpr size_t WS_SSQX = 2 * MiB, WS_SSQCQ = 3 * MiB, WS_SSQKV = 3 * MiB + 262144, WS_KMP = 3 * MiB + 524288;
constexpr size_t WS_W = 4 * MiB;
constexpr size_t W_IN = WS_W, W_QU = WS_W + 13 * MiB, W_KVU = WS_W + 13 * MiB + 524288, W_BR = WS_W + 14 * MiB, W_OUT = WS_W + 17 * MiB, W_UP = WS_W + 19 * MiB, W_DN = WS_W + 27 * MiB;
constexpr size_t WS_XB = 39 * MiB;
constexpr size_t A0 = 71 * MiB;
constexpr size_t WS_MQ = A0, WS_MK = A0 + 16 * MiB, WS_MV = A0 + 32 * MiB, WS_RQ = A0 + 48 * MiB, WS_RK = A0 + 56 * MiB, WS_RKV = A0 + 64 * MiB, WS_RV = A0 + 80 * MiB,
                 WS_OM = A0 + 96 * MiB, WS_QM = A0 + 112 * MiB, WS_CQ = A0 + 136 * MiB, WS_KVM = A0 + 144 * MiB, WS_CKV = A0 + 176 * MiB, WS_KPE = A0 + 180 * MiB, WS_END = A0 + 181 * MiB;
constexpr size_t WS_GMLA = WS_QM, WS_GMOBA = WS_MK, WS_GRET = WS_KVM, WS_MB = WS_RQ, WS_HID = A0;
constexpr int LDS_BYTES = 147456;
constexpr size_t WS_TS = 1835008 + 16384;
#ifndef PMASK
#define PMASK 0xffff
#endif
#define PH(k) ((PMASK >> (k)) & 1)

struct Args {
    const float* in[17];
    float* out;
    unsigned char* ws;
    float inv_mla[16], inv_moba[8], inv_ret[32], ret_lg2[4];
    int use_cg_sync, pad_;
};

namespace pg8 {
constexpr int BM = 256, BK = 64, HALF = 128, HTB = HALF * BK * 2, STAGE_BYTES = 8 * HTB, NXCD = 8, WGM = 8;
__host__ __device__ __forceinline__ int lds_byte(int r, int c) { const int st = (r >> 4) * 2 + (c >> 5), rr = r & 15, cc = c & 31, ob = rr * 64 + cc * 2; return st * 1024 + (ob ^ (((ob >> 9) & 1) << 5)); }
__host__ __device__ __forceinline__ void stage_rc(int b, int& R, int& C) { const int st = b / 1024, sb = b % 1024, swz = sb ^ (((sb >> 9) & 1) << 5); R = (st >> 1) * 16 + swz / 64; C = (st & 1) * 32 + (swz % 64) / 2; }
__host__ __device__ __forceinline__ int perm32(int rho) { const int n = rho >> 4, i = rho & 15; return 8 * (i >> 2) + 4 * n + (i & 3); }

struct Unit { int pm, pn, aux; const char* a; const char* b; };
struct Gemm { int lda, ldb, K; };

struct SchedStd {
    const char* A; const char* B; int lda, ldb; int nM, nN, nwg, G, c;
    __device__ void init(const void* A_, const void* B_, int lda_, int ldb_, int nM_, int nN_, int G_, int c_) { A = (const char*)A_; B = (const char*)B_; lda = lda_; ldb = ldb_; nM = nM_; nN = nN_; nwg = nM * nN; G = G_; c = c_; }
    __device__ __forceinline__ bool next(int i, Unit& u) const {
        const long L = (long)i * G + c; if (L >= nwg) return false;
        int wgid = (int)L; { const int q = nwg / NXCD, r = nwg % NXCD, xcd = wgid % NXCD, off = wgid / NXCD; wgid = (xcd < r ? xcd * (q + 1) : r * (q + 1) + (xcd - r) * q) + off; }
        const int nig = WGM * nN, gid = wgid / nig, fm = gid * WGM, gsz = (nM - fm) < WGM ? (nM - fm) : WGM;
        u.pm = fm + ((wgid % nig) % gsz); u.pn = (wgid % nig) / gsz; u.aux = 0;
        u.a = A + (size_t)u.pm * BM * lda * 2; u.b = B + (size_t)u.pn * BM * ldb * 2; return true;
    }
};
struct SchedMerge {
    const char* A0; const char* A1; const char* A2; const char* B; int G, c;
    __device__ __forceinline__ bool next(int i, Unit& u) const {
        const int br = i % 3; const long L = (long)(i / 3) * G + c; if (L >= 256) return false;
        int wgid = (int)L; { const int xcd = wgid % NXCD, off = wgid / NXCD; wgid = xcd * 32 + off; }
        const int nN = 4, nig = WGM * nN, gid = wgid / nig, fm = gid * WGM;
        u.pm = fm + ((wgid % nig) % WGM); u.pn = (wgid % nig) / WGM; u.aux = br;
        const char* Ab = br == 0 ? A0 : (br == 1 ? A1 : A2);
        u.a = Ab + (size_t)u.pm * BM * 512 * 2; u.b = B + ((size_t)br * 1024 + (size_t)u.pn * BM) * 512 * 2; return true;
    }
};

template <class Epi, class Sched>
__device__ __forceinline__ void gemm_phase(LAS unsigned char* lds, const Gemm g, const Sched& S, const Epi& E) {
    const int tid = opaque_tid(), wid = __builtin_amdgcn_readfirstlane(tid >> 6), lane = tid & 63, wr = wid >> 2, wc = wid & 3, fr = lane & 15, fq = lane >> 4;
    int K = g.K; asm volatile("" : "+s"(K)); const int nt = K / BK;
    unsigned voffA[2], voffB[2];
#pragma unroll
    for (int i = 0; i < 2; ++i) { int R, C; stage_rc(tid * 16 + i * 8192, R, C); const int Rb = Epi::PERM ? ((R & ~31) + perm32(R & 31)) : R;
        voffA[i] = (unsigned)(R * g.lda + C) * 2u; voffB[i] = (unsigned)(Rb * g.ldb + C) * 2u; }
    const size_t kstep = (size_t)(BK * 2);
    const size_t hstepA = (size_t)HALF * g.lda * 2, hstepB = (size_t)HALF * g.ldb * 2;
    const unsigned ldsw = (unsigned)wid * 1024u;
    const int aoff = lds_byte(wr * 64 + fr, fq * 8), boff = lds_byte(wc * 32 + fr, fq * 8);
#define PG8_SA(b, h) (((b) * 2 + (h)) * HTB)
#define PG8_SB(b, h) ((4 + (b) * 2 + (h)) * HTB)
#define PG8_STAGE(bufoff, gbase, voff) do { _Pragma("unroll") for (int _i = 0; _i < 2; ++_i) \
        __builtin_amdgcn_global_load_lds((const unsigned*)((const char*)(gbase) + (voff)[_i]), (LAS unsigned*)(lds + (bufoff) + ldsw + _i * 8192), 16, 0, 0); } while (0)
#define PG8_LDA(dst, b, h) do { _Pragma("unroll") for (int m = 0; m < 4; ++m) _Pragma("unroll") for (int k = 0; k < 2; ++k) dst[m][k] = *(const LAS bf16x8*)(lds + PG8_SA(b, h) + aoff + m * 2048 + k * 1024); } while (0)
#define PG8_LDB(dst, b, h) do { _Pragma("unroll") for (int n = 0; n < 2; ++n) _Pragma("unroll") for (int k = 0; k < 2; ++k) dst[n][k] = *(const LAS bf16x8*)(lds + PG8_SB(b, h) + boff + n * 2048 + k * 1024); } while (0)
#define PG8_MMA(ai, bj, At, Bt) do { __builtin_amdgcn_s_setprio(1); _Pragma("unroll") for (int m = 0; m < 4; ++m) _Pragma("unroll") for (int n = 0; n < 2; ++n) _Pragma("unroll") for (int k = 0; k < 2; ++k) \
        acc[ai][bj][m][n] = __builtin_amdgcn_mfma_f32_16x16x32_bf16(Bt[n][k], At[m][k], acc[ai][bj][m][n], 0, 0, 0); __builtin_amdgcn_s_setprio(0); } while (0)
#define PG8_WAIT_V(n) asm volatile("s_waitcnt vmcnt(" #n ")" ::: "memory")
#define PG8_WAIT_L(n) asm volatile("s_waitcnt lgkmcnt(" #n ")" ::: "memory")
#define PG8_BAR __builtin_amdgcn_s_barrier()
#define PG8_SCHED __builtin_amdgcn_sched_barrier(0)
    Unit cur, nxt; int ui = 0;
    if (!S.next(0, cur)) return;
    f32x4 acc[2][2][4][2];
#pragma unroll
    for (int a = 0; a < 2; ++a)
#pragma unroll
        for (int b = 0; b < 2; ++b)
#pragma unroll
            for (int m = 0; m < 4; ++m)
#pragma unroll
                for (int n = 0; n < 2; ++n) acc[a][b][m][n] = (f32x4){0.f, 0.f, 0.f, 0.f};
    bf16x8 At[4][2], B0[2][2], B1[2][2];
    const char* cA = cur.a; const char* cB = cur.b;
    PG8_STAGE(PG8_SB(0, 0), cB, voffB); PG8_STAGE(PG8_SB(0, 1), cB + hstepB, voffB); PG8_STAGE(PG8_SA(0, 0), cA, voffA); PG8_STAGE(PG8_SA(0, 1), cA + hstepA, voffA);
    if (wr == 1) PG8_BAR;
    PG8_WAIT_V(2); PG8_BAR;
    PG8_STAGE(PG8_SB(1, 0), cB + kstep, voffB); PG8_STAGE(PG8_SA(1, 0), cA + kstep, voffA); PG8_STAGE(PG8_SB(1, 1), cB + hstepB + kstep, voffB);
    PG8_WAIT_V(6); PG8_BAR;
    for (;;) {
        const bool has_next = S.next(ui + 1, nxt);
        const char* nA = has_next ? nxt.a : cA; const char* nB = has_next ? nxt.b : cB;
        for (int t = 0; t < nt; t += 2) {
            const bool last = (t == nt - 2);
            const char* a1 = cA + (size_t)(t + 1) * kstep;
            const char* a2 = last ? nA : cA + (size_t)(t + 2) * kstep; const char* b2 = last ? nB : cB + (size_t)(t + 2) * kstep;
            const char* a3 = a2 + kstep; const char* b3 = b2 + kstep;
            PG8_LDB(B0, 0, 0); PG8_LDB(B1, 0, 1); PG8_SCHED; PG8_LDA(At, 0, 0); PG8_STAGE(PG8_SA(1, 1), a1 + hstepA, voffA);
            PG8_WAIT_V(8); PG8_WAIT_L(0); PG8_BAR; PG8_MMA(0, 0, At, B0); PG8_MMA(0, 1, At, B1); PG8_BAR; PG8_SCHED;
            PG8_LDA(At, 0, 1); PG8_STAGE(PG8_SB(0, 0), b2, voffB); PG8_STAGE(PG8_SB(0, 1), b2 + hstepB, voffB); PG8_STAGE(PG8_SA(0, 0), a2, voffA);
            PG8_WAIT_V(8); PG8_WAIT_L(0); PG8_BAR; PG8_MMA(1, 0, At, B0); PG8_MMA(1, 1, At, B1); PG8_BAR; PG8_SCHED;
            PG8_LDB(B0, 1, 0); PG8_LDB(B1, 1, 1); PG8_SCHED; PG8_LDA(At, 1, 0); PG8_STAGE(PG8_SA(0, 1), a2 + hstepA, voffA);
            PG8_WAIT_V(8); PG8_WAIT_L(0); PG8_BAR; PG8_MMA(0, 0, At, B0); PG8_MMA(0, 1, At, B1); PG8_BAR; PG8_SCHED;
            PG8_LDA(At, 1, 1); PG8_STAGE(PG8_SB(1, 0), b3, voffB); PG8_STAGE(PG8_SB(1, 1), b3 + hstepB, voffB); PG8_STAGE(PG8_SA(1, 0), a3, voffA);
            PG8_WAIT_V(8); PG8_WAIT_L(0); PG8_BAR; PG8_MMA(1, 0, At, B0); PG8_MMA(1, 1, At, B1); PG8_BAR; PG8_SCHED;
        }
        if (wr == 0) PG8_BAR;
        const bool keep = E(acc, cur, wr, wc, fr, fq);
        if (!has_next) break;
        if (!keep) {
#pragma unroll
        for (int a = 0; a < 2; ++a)
#pragma unroll
            for (int b = 0; b < 2; ++b)
#pragma unroll
                for (int m = 0; m < 4; ++m)
#pragma unroll
                    for (int n = 0; n < 2; ++n) acc[a][b][m][n] = (f32x4){0.f, 0.f, 0.f, 0.f};
        }
        cur = nxt; cA = nA; cB = nB; ++ui;
        if (wr == 1) PG8_BAR;
    }
    PG8_WAIT_V(0);
    PG8_BAR;
#undef PG8_SA
#undef PG8_SB
#undef PG8_STAGE
#undef PG8_LDA
#undef PG8_LDB
#undef PG8_MMA
#undef PG8_WAIT_V
#undef PG8_WAIT_L
#undef PG8_BAR
#undef PG8_SCHED
}
}
using pg8::Unit;

__device__ __forceinline__ float ssq16(const float* p) { const f32x4 a = *(const f32x4*)p, b = *(const f32x4*)(p + 4), c = *(const f32x4*)(p + 8), d = *(const f32x4*)(p + 12);
    return ((a[0] + a[1]) + (a[2] + a[3])) + ((b[0] + b[1]) + (b[2] + b[3])) + ((c[0] + c[1]) + (c[2] + c[3])) + ((d[0] + d[1]) + (d[2] + d[3])); }
__device__ __forceinline__ float ssq4(const float* p) { const f32x4 a = *(const f32x4*)p; return (a[0] + a[1]) + (a[2] + a[3]); }
__device__ __forceinline__ void rope8(f32x4& v0, f32x4& v1, const float* ct, const float* st, int pos, int NF, int fb) {
    const f32x4 c = *(const f32x4*)(ct + (size_t)pos * NF + fb), s = *(const f32x4*)(st + (size_t)pos * NF + fb);
    const f32x4 a = v0 * c - v1 * s, b = v0 * s + v1 * c; v0 = a; v1 = b;
}
#define EPI_ROWLOOP _Pragma("unroll") for (int ai = 0; ai < 2; ++ai) _Pragma("unroll") for (int m = 0; m < 4; ++m)
#define EPI_FENCE asm volatile("" ::: "memory")

#define WSP(T, off) ((T*)(ws + (off)))
constexpr unsigned LDS_RSTAB = 132096;
__device__ __forceinline__ void rstd_table(const unsigned char* ws, int pm) {
    LAS float* rsl = (LAS float*)(size_t)LDS_RSTAB; const int t = threadIdx.x;
    if (t < 256) rsl[t] = rsqrtf(ssq16((const float*)(ws + WS_SSQX) + (size_t)(pm * 256 + t) * 16) * (1.f / 1024.f) + NEPS);
    asm volatile("s_waitcnt lgkmcnt(0)" ::: "memory"); __builtin_amdgcn_s_barrier(); asm volatile("" ::: "memory");
}
#define RSTAB(lrow) (((const LAS float*)(size_t)LDS_RSTAB)[(lrow)])
__device__ __forceinline__ float rstd_x(const unsigned char* ws, int row) { return rsqrtf(ssq16((const float*)(ws + WS_SSQX) + (size_t)row * 16) * (1.f / 1024.f) + NEPS); }
struct EpiP1 {
    static constexpr bool PERM = true;
    unsigned char* ws;
    __device__ __forceinline__ bool operator()(f32x4 (&acc)[2][2][4][2], const Unit& u, int wr, int wc, int fr, int fq) const {
        const int pn = u.pn, row0 = u.pm * 256 + wr * 64 + fr, cl0 = wc * 32 + 8 * fq;
        size_t d0, d1; int l0, l1, c0, c1, md0 = 0, md1 = 0; bool st1 = true; size_t ssqo = 0;
        if (pn == 0) { d0 = d1 = WS_CQ; l0 = l1 = 256; c0 = cl0; c1 = 128 + cl0; ssqo = WS_SSQCQ; }
        else if (pn == 1) { d0 = WS_CKV; l0 = 128; c0 = cl0; d1 = WS_KPE; l1 = 32; c1 = 8 * fq; md1 = 1; st1 = (wc == 0); ssqo = WS_SSQKV; }
        else if (pn < 8) { const int sec = (pn - 2) >> 1; d0 = d1 = WS_MQ + (size_t)sec * (16 * MiB); l0 = l1 = 512; c0 = ((pn - 2) & 1) * 256 + cl0; c1 = c0 + 128; md0 = md1 = (sec < 2) ? 2 : 0; }
        else if (pn < 10) { d0 = d1 = (pn == 8 ? WS_RQ : WS_RK); l0 = l1 = 256; c0 = cl0; c1 = 128 + cl0; md0 = md1 = 3; }
        else { d0 = d1 = WS_RV; l0 = l1 = 512; c0 = (pn - 10) * 256 + cl0; c1 = c0 + 128; }
        const int md = md0 | md1; const int NF = md == 1 ? 16 : (md == 2 ? 8 : 32);
        const float* ct = (const float*)(ws + (md == 1 ? TAB_CM : (md == 2 ? TAB_CB : TAB_CR))); const float* st = (const float*)(ws + (md == 1 ? TAB_SM : (md == 2 ? TAB_SB : TAB_SR)));
        const bool rp0 = md0 == 2 ? ((c0 & 63) < 16) : (md0 != 0), rp1 = md1 == 2 ? ((c1 & 63) < 16) : (md1 != 0);
        const int fb0 = 4 * ((c0 & 63) >> 3), fb1 = 4 * ((c1 & 63) >> 3);
        bf16_t* p0 = (bf16_t*)(ws + d0) + c0; bf16_t* p1 = (bf16_t*)(ws + d1) + c1;
        rstd_table(ws, u.pm); const int lrow0 = wr * 64 + fr;
#pragma unroll
        for (int ai = 0; ai < 2; ++ai)
#pragma unroll
          for (int mp = 0; mp < 4; mp += 2) { f32x4 tc0[2], ts0[2], tc1[2], ts1[2];
#pragma unroll
            for (int q = 0; q < 2; ++q) { const int pos = (row0 + ai * 128 + (mp + q) * 16) & (SS - 1); tc0[q] = ts0[q] = tc1[q] = ts1[q] = (f32x4){0.f, 0.f, 0.f, 0.f};
                if (rp0) { tc0[q] = *(const f32x4*)(ct + (size_t)pos * NF + fb0); ts0[q] = *(const f32x4*)(st + (size_t)pos * NF + fb0); }
                if (rp1) { tc1[q] = *(const f32x4*)(ct + (size_t)pos * NF + fb1); ts1[q] = *(const f32x4*)(st + (size_t)pos * NF + fb1); } }
#pragma unroll
            for (int q = 0; q < 2; ++q) { const int m = mp + q; const int row = row0 + ai * 128 + m * 16; const float rs = RSTAB(lrow0 + ai * 128 + m * 16);
                f32x4 v0 = acc[ai][0][m][0] * rs, v1 = acc[ai][0][m][1] * rs; float ss = 0.f; if (ssqo) ss = dot4(v0) + dot4(v1);
                if (rp0) { const f32x4 a = v0 * tc0[q] - v1 * ts0[q], b = v0 * ts0[q] + v1 * tc0[q]; v0 = a; v1 = b; }
                *(u32x4*)(p0 + (size_t)row * l0) = pack8(v0, v1);
                v0 = acc[ai][1][m][0] * rs; v1 = acc[ai][1][m][1] * rs; if (pn == 0) ss += dot4(v0) + dot4(v1);
                if (rp1) { const f32x4 a = v0 * tc1[q] - v1 * ts1[q], b = v0 * ts1[q] + v1 * tc1[q]; v0 = a; v1 = b; }
                if (st1) *(u32x4*)(p1 + (size_t)row * l1) = pack8(v0, v1);
                if (ssqo) { ss += __shfl_xor(ss, 16); ss += __shfl_xor(ss, 32); if (fq == 0) ((float*)(ws + ssqo))[(size_t)row * 4 + wc] = ss; } }
            EPI_FENCE; }
        return false;
    }
};
struct EpiQU {
    static constexpr bool PERM = true;
    unsigned char* ws;
    __device__ __forceinline__ bool operator()(f32x4 (&acc)[2][2][4][2], const Unit& u, int wr, int wc, int fr, int fq) const {
        const int row0 = u.pm * 256 + wr * 64 + fr, c0 = u.pn * 256 + wc * 32 + 8 * fq;
        const int d0 = c0 % 96, d1 = (c0 + 128) % 96; const bool rp0 = d0 >= 64, rp1 = d1 >= 64; const int fb0 = rp0 ? 4 * ((d0 - 64) >> 3) : 0, fb1 = rp1 ? 4 * ((d1 - 64) >> 3) : 0;
        const float* ct = WSP(const float, TAB_CM); const float* st = WSP(const float, TAB_SM);
        float rsv[2][4];
        EPI_ROWLOOP rsv[ai][m] = rsqrtf(ssq4(WSP(const float, WS_SSQCQ) + (size_t)(row0 + ai * 128 + m * 16) * 4) * (1.f / 256.f) + NEPS);
#pragma unroll
        for (int ai = 0; ai < 2; ++ai)
#pragma unroll
          for (int mp = 0; mp < 4; mp += 2) { f32x4 tc0[2], ts0[2], tc1[2], ts1[2];
#pragma unroll
            for (int q = 0; q < 2; ++q) { const int pos = (row0 + ai * 128 + (mp + q) * 16) & (SS - 1); tc0[q] = ts0[q] = tc1[q] = ts1[q] = (f32x4){0.f, 0.f, 0.f, 0.f};
                if (rp0) { tc0[q] = *(const f32x4*)(ct + (size_t)pos * 16 + fb0); ts0[q] = *(const f32x4*)(st + (size_t)pos * 16 + fb0); }
                if (rp1) { tc1[q] = *(const f32x4*)(ct + (size_t)pos * 16 + fb1); ts1[q] = *(const f32x4*)(st + (size_t)pos * 16 + fb1); } }
#pragma unroll
            for (int q = 0; q < 2; ++q) { const int m = mp + q; const int row = row0 + ai * 128 + m * 16; const float rs = rsv[ai][m];
                f32x4 v0 = acc[ai][0][m][0] * rs, v1 = acc[ai][0][m][1] * rs;
                if (rp0) { const f32x4 a = v0 * tc0[q] - v1 * ts0[q], b = v0 * ts0[q] + v1 * tc0[q]; v0 = a; v1 = b; }
                *(u32x4*)(WSP(bf16_t, WS_QM) + (size_t)row * 768 + c0) = pack8(v0, v1);
                v0 = acc[ai][1][m][0] * rs; v1 = acc[ai][1][m][1] * rs;
                if (rp1) { const f32x4 a = v0 * tc1[q] - v1 * ts1[q], b = v0 * ts1[q] + v1 * tc1[q]; v0 = a; v1 = b; }
                *(u32x4*)(WSP(bf16_t, WS_QM) + (size_t)row * 768 + c0 + 128) = pack8(v0, v1); }
            EPI_FENCE; }
        return false;
    }
};
struct EpiKVU {
    static constexpr bool PERM = true;
    unsigned char* ws;
    __device__ __forceinline__ bool operator()(f32x4 (&acc)[2][2][4][2], const Unit& u, int wr, int wc, int fr, int fq) const {
        const int row0 = u.pm * 256 + wr * 64 + fr, c0 = u.pn * 256 + wc * 32 + 8 * fq;
        float rsv[2][4];
        EPI_ROWLOOP rsv[ai][m] = rsqrtf(ssq4(WSP(const float, WS_SSQKV) + (size_t)(row0 + ai * 128 + m * 16) * 4) * (1.f / 128.f) + NEPS);
        EPI_ROWLOOP { const int row = row0 + ai * 128 + m * 16; const float rs = rsv[ai][m];
#pragma unroll
            for (int bj = 0; bj < 2; ++bj) { const int c = c0 + bj * 128; const f32x4 v0 = acc[ai][bj][m][0] * rs, v1 = acc[ai][bj][m][1] * rs;
                *(u32x4*)(WSP(bf16_t, WS_KVM) + (size_t)row * 1024 + c) = pack8(v0, v1); }
            EPI_FENCE; }
        return false;
    }
};
__device__ __forceinline__ float sigm(float v) { return __builtin_amdgcn_rcpf(1.f + __builtin_amdgcn_exp2f(-LOG2E * v)); }
struct EpiGate {
    static constexpr bool PERM = true;
    unsigned char* ws;
    __device__ __forceinline__ bool operator()(f32x4 (&acc)[2][2][4][2], const Unit& u, int wr, int wc, int fr, int fq) const {
        const int pn = u.pn, row0 = u.pm * 256 + wr * 64 + fr, cl0 = wc * 32 + 8 * fq;
        rstd_table(ws, u.pm); const int lrow0 = wr * 64 + fr;
        if (pn < 12) {
            bf16_t* dst = (pn < 4 ? WSP(bf16_t, WS_GMLA) : (pn < 8 ? WSP(bf16_t, WS_GMOBA) : WSP(bf16_t, WS_GRET))); const int cb0 = (pn & 3) * 256;
            EPI_ROWLOOP { const int row = row0 + ai * 128 + m * 16; const float rs = RSTAB(lrow0 + ai * 128 + m * 16);
#pragma unroll
                for (int bj = 0; bj < 2; ++bj) { const float nrs = -LOG2E * rs; f32x4 v0 = acc[ai][bj][m][0] * nrs, v1 = acc[ai][bj][m][1] * nrs;
#pragma unroll
                    for (int j = 0; j < 4; ++j) { v0[j] = fminf(1.f + __builtin_amdgcn_exp2f(v0[j]), 1e30f); v1[j] = fminf(1.f + __builtin_amdgcn_exp2f(v1[j]), 1e30f); }
                    *(u32x4*)(dst + (size_t)row * 1024 + cb0 + bj * 128 + cl0) = pack8(v0, v1); }
                EPI_FENCE; }
        } else {
            const int cb0 = (pn - 12) * 256;
#pragma unroll
            for (int ai = 0; ai < 2; ++ai) { u32x4 ov[4][2];
#pragma unroll
                for (int m = 0; m < 4; ++m)
#pragma unroll
                    for (int bj = 0; bj < 2; ++bj) ov[m][bj] = *(const u32x4*)(WSP(bf16_t, WS_RV) + (size_t)(row0 + ai * 128 + m * 16) * 512 + cb0 + bj * 128 + cl0);
#pragma unroll
                for (int m = 0; m < 4; ++m) { const int row = row0 + ai * 128 + m * 16; const float rs = RSTAB(lrow0 + ai * 128 + m * 16);
#pragma unroll
                    for (int bj = 0; bj < 2; ++bj) { f32x4 v0 = acc[ai][bj][m][0] * rs, v1 = acc[ai][bj][m][1] * rs; bf16_t* p = WSP(bf16_t, WS_RV) + (size_t)row * 512 + cb0 + bj * 128 + cl0;
                        f32x4 o0, o1; unpack8(ov[m][bj], o0, o1);
#pragma unroll
                        for (int j = 0; j < 4; ++j) { v0[j] = v0[j] * sigm(v0[j]) * o0[j]; v1[j] = v1[j] * sigm(v1[j]) * o1[j]; }
                        *(u32x4*)p = pack8(v0, v1); } }
                EPI_FENCE; }
        }
        return false;
    }
};
struct EpiMerge {
    static constexpr bool PERM = true;
    unsigned char* ws;
    __device__ __forceinline__ bool operator()(f32x4 (&acc)[2][2][4][2], const Unit& u, int wr, int wc, int fr, int fq) const {
        const int br = u.aux, row0 = u.pm * 256 + wr * 64 + fr, c0 = u.pn * 256 + wc * 32 + 8 * fq;
        const bf16_t* Ga = br == 0 ? WSP(bf16_t, WS_GMLA) : (br == 1 ? WSP(bf16_t, WS_GMOBA) : WSP(bf16_t, WS_GRET)); const bf16_t* Gb = br == 0 ? WSP(bf16_t, WS_GMOBA) : WSP(bf16_t, WS_GRET);
#pragma unroll
        for (int ai = 0; ai < 2; ++ai) { u32x4 ga[4][2], gb[4][2];
#pragma unroll
            for (int m = 0; m < 4; ++m)
#pragma unroll
                for (int bj = 0; bj < 2; ++bj) { const size_t off = (size_t)(row0 + ai * 128 + m * 16) * 1024 + c0 + bj * 128; ga[m][bj] = *(const u32x4*)(Ga + off); if (br < 2) gb[m][bj] = *(const u32x4*)(Gb + off); else gb[m][bj] = ga[m][bj]; }
#pragma unroll
            for (int m = 0; m < 4; ++m)
#pragma unroll
                for (int bj = 0; bj < 2; ++bj) { const size_t off = (size_t)(row0 + ai * 128 + m * 16) * 1024 + c0 + bj * 128; f32x4 a0, a1; unpack8(ga[m][bj], a0, a1);
                    if (br < 2) { f32x4 b0, b1; unpack8(gb[m][bj], b0, b1);
#pragma unroll
                        for (int j = 0; j < 4; ++j) { acc[ai][bj][m][0][j] *= b0[j] * __builtin_amdgcn_rcpf(a0[j]); acc[ai][bj][m][1][j] *= b1[j] * __builtin_amdgcn_rcpf(a1[j]); } }
                    else { f32x4 v0 = acc[ai][bj][m][0], v1 = acc[ai][bj][m][1];
#pragma unroll
                        for (int j = 0; j < 4; ++j) { v0[j] *= __builtin_amdgcn_rcpf(a0[j]); v1[j] *= __builtin_amdgcn_rcpf(a1[j]); }
                        *(u32x4*)(WSP(bf16_t, WS_MB) + off) = pack8(v0, v1); } }
            EPI_FENCE; }
        return br < 2;
    }
};
struct EpiRes {
    static constexpr bool PERM = false;
    const float* res; float* out; unsigned char* ws; int wxb;
    __device__ __forceinline__ bool operator()(f32x4 (&acc)[2][2][4][2], const Unit& u, int wr, int wc, int fr, int fq) const {
        const int row0 = u.pm * 256 + wr * 64 + fr, c0 = u.pn * 256 + wc * 32 + 4 * fq;
#pragma unroll
        for (int ai = 0; ai < 2; ++ai) { f32x4 rv[4][2][2];
#pragma unroll
            for (int m = 0; m < 4; ++m)
#pragma unroll
                for (int bj = 0; bj < 2; ++bj)
#pragma unroll
                    for (int n = 0; n < 2; ++n) rv[m][bj][n] = *(const f32x4*)(res + (size_t)(row0 + ai * 128 + m * 16) * 1024 + c0 + bj * 128 + n * 16);
#pragma unroll
            for (int m = 0; m < 4; ++m) { const int row = row0 + ai * 128 + m * 16; float ss = 0.f;
#pragma unroll
                for (int bj = 0; bj < 2; ++bj)
#pragma unroll
                    for (int n = 0; n < 2; ++n) { const size_t off = (size_t)row * 1024 + c0 + bj * 128 + n * 16;
                        const f32x4 v = acc[ai][bj][m][n] + rv[m][bj][n];
                        *(f32x4*)(out + off) = v; ss += dot4(v);
                        if (wxb) { const unsigned lo = pk2(v[0], v[1]), hi2 = pk2(v[2], v[3]); *(unsigned long long*)(WSP(bf16_t, WS_XB) + off) = (unsigned long long)lo | ((unsigned long long)hi2 << 32); } }
                ss += __shfl_xor(ss, 16); ss += __shfl_xor(ss, 32); if (fq == 0) WSP(float, WS_SSQX)[(size_t)row * 16 + u.pn * 4 + wc] = ss; }
            EPI_FENCE; }
        return false;
    }
};
struct EpiUp {
    static constexpr bool PERM = true;
    unsigned char* ws;
    __device__ __forceinline__ bool operator()(f32x4 (&acc)[2][2][4][2], const Unit& u, int wr, int wc, int fr, int fq) const {
        const int row0 = u.pm * 256 + wr * 64 + fr, c0 = u.pn * 256 + wc * 32 + 8 * fq;
        rstd_table(ws, u.pm); const int lrow0 = wr * 64 + fr;
        EPI_ROWLOOP { const int row = row0 + ai * 128 + m * 16; const float rs = RSTAB(lrow0 + ai * 128 + m * 16);
#pragma unroll
            for (int bj = 0; bj < 2; ++bj) { f32x4 v0 = acc[ai][bj][m][0] * rs, v1 = acc[ai][bj][m][1] * rs;
#pragma unroll
                for (int j = 0; j < 4; ++j) { const float a = fmaxf(v0[j], 0.f), b = fmaxf(v1[j], 0.f); v0[j] = a * a; v1[j] = b * b; }
                *(u32x4*)(WSP(bf16_t, WS_HID) + (size_t)row * 4096 + c0 + bj * 128) = pack8(v0, v1); }
            EPI_FENCE; }
        return false;
    }
};

namespace att {
constexpr int KSL = 12288, VSL = 8192;
constexpr int NSL = 4;
constexpr int L_K = 0, L_V = NSL * KSL, L_WS = L_V + NSL * VSL, L_OST = L_WS + 2048, L_SEL = L_OST + 32768, L_UM = L_SEL + 1024, L_KM = L_UM + 64, L_END = L_KM + 4096;
constexpr float NEG = -1e30f;
__device__ __forceinline__ int crow(int r, int hi) { return (r & 3) + 8 * (r >> 2) + 4 * hi; }
__device__ __forceinline__ void glds16(const void* gsrc, unsigned lds_dst) { unsigned keep;
    asm volatile("s_mov_b32 %0, m0\n\ts_mov_b32 m0, %2\n\ts_nop 0\n\tglobal_load_lds_dwordx4 %1, off\n\ts_mov_b32 m0, %0" : "=&s"(keep) : "v"(gsrc), "s"(lds_dst) : "memory"); }
__device__ __forceinline__ unsigned long long blk_list(unsigned um, int qb, bool own_first) { unsigned long long l = 0ull; int i = 0; if (own_first) { l = (unsigned long long)qb; i = 1; }
    for (; um; um &= um - 1u, ++i) l |= (unsigned long long)__builtin_ctz(um) << (4 * i); for (; i < 16; ++i) l |= (unsigned long long)qb << (4 * i); return l; }
#define nth_block(um, bi, qb) ((int)((blist >> (4 * (bi))) & 15ull))
__device__ __forceinline__ void pv(f32x16* o, int vb, bf16x8 pa0, bf16x8 pa1, bf16x8 pa2, bf16x8 pa3) {
#pragma unroll
    for (int d0 = 0; d0 < 2; ++d0) { s16x4 lo[4], hi[4];
#pragma unroll
        for (int ks = 0; ks < 4; ++ks) {
            asm volatile("ds_read_b64_tr_b16 %0,%1 offset:%c2" : "=&v"(lo[ks]) : "v"(vb), "i"(d0 * 4096 + ks * 1024) : "memory");
            asm volatile("ds_read_b64_tr_b16 %0,%1 offset:%c2" : "=&v"(hi[ks]) : "v"(vb), "i"(d0 * 4096 + ks * 1024 + 512) : "memory"); }
        asm volatile("s_waitcnt lgkmcnt(0)" ::: "memory"); __builtin_amdgcn_sched_barrier(0);
#define PK(k) (bf16x8){lo[k][0], lo[k][1], lo[k][2], lo[k][3], hi[k][0], hi[k][1], hi[k][2], hi[k][3]}
        o[d0] = __builtin_amdgcn_mfma_f32_32x32x16_bf16(pa0, PK(0), o[d0], 0, 0, 0);
        o[d0] = __builtin_amdgcn_mfma_f32_32x32x16_bf16(pa1, PK(1), o[d0], 0, 0, 0);
        o[d0] = __builtin_amdgcn_mfma_f32_32x32x16_bf16(pa2, PK(2), o[d0], 0, 0, 0);
        o[d0] = __builtin_amdgcn_mfma_f32_32x32x16_bf16(pa3, PK(3), o[d0], 0, 0, 0);
#undef PK
    }
}
#define ATT_WAITBAR() asm volatile("s_waitcnt vmcnt(0) lgkmcnt(0)\n\ts_barrier" ::: "memory")
__device__ __forceinline__ float max3a(float a, float b, float c) { float r; asm("v_max3_f32 %0, %1, %2, %3" : "=v"(r) : "v"(a), "v"(b), "v"(c)); return r; }
__device__ __forceinline__ float max2a(float a, float b) { float r; asm("v_max_f32_e32 %0, %1, %2" : "=v"(r) : "v"(a), "v"(b)); return r; }

template <int DQ, bool ROWSEL>
__device__ __forceinline__ void attn_unit(long rowbase, int qb, const bf16_t* Qh, int ldq, const bf16_t* Kh, int ldk, const bf16_t* Kpe, const bf16_t* Vh, int ldv, bf16_t* Oh, int ldo,
                                          LAS unsigned char* lds, unsigned umask) {
    const int tid = opaque_tid(), lane = tid & 63, r32 = lane & 31, hi = lane >> 5; const int wid = __builtin_amdgcn_readfirstlane(tid >> 6);
    const int q0 = qb * 256;
    const unsigned lds0 = (unsigned)(uintptr_t)lds;
    LAS float* wsf = (LAS float*)(lds + L_WS) + wid * 64;
    umask = (unsigned)__builtin_amdgcn_readfirstlane((int)umask);
    const int npast = __builtin_popcount(umask), NT = 4 * (npast + 1);
    const unsigned long long blist = blk_list(umask, qb, ROWSEL);
    const bf16_t* kl_ = Kh + (rowbase + lane) * ldk + wid * 8;
    const bf16_t* pl_ = (DQ == 96) ? Kpe + (rowbase + lane) * 32 + wid * 8 : Kh;
    const bf16_t* vl_ = Vh + (rowbase + 16 * (wid & 3) + (lane >> 2)) * ldv + (wid >> 2) * 32 + (lane & 3) * 8;
#define ATT_ISSUE(key0, slot) do { const long ko_ = (long)(key0); \
        glds16(kl_ + ko_ * ldk, (unsigned)__builtin_amdgcn_readfirstlane((int)(lds0 + L_K + (slot) * KSL + wid * 1024))); \
        if (DQ == 96 && wid < 4) glds16(pl_ + ko_ * 32, (unsigned)__builtin_amdgcn_readfirstlane((int)(lds0 + L_K + (slot) * KSL + (8 + wid) * 1024))); \
        glds16(vl_ + ko_ * ldv, (unsigned)__builtin_amdgcn_readfirstlane((int)(lds0 + L_V + (slot) * VSL + wid * 1024))); } while (0)
    bf16x8 qr[DQ / 16];
    { const bf16_t* Qw = Qh + (rowbase + q0 + wid * 32 + r32) * ldq + hi * 8;
#pragma unroll
      for (int d0 = 0; d0 < DQ / 16; ++d0) qr[d0] = *(const bf16x8*)(Qw + d0 * 16); }
#define ATT_WAITK(k) do { if (DQ == 96 && wid < 4) { if ((k) == 2) asm volatile("s_waitcnt vmcnt(6)" ::: "memory"); else if ((k) == 1) asm volatile("s_waitcnt vmcnt(3)" ::: "memory"); else asm volatile("s_waitcnt vmcnt(0)" ::: "memory"); } \
        else { if ((k) == 2) asm volatile("s_waitcnt vmcnt(4)" ::: "memory"); else if ((k) == 1) asm volatile("s_waitcnt vmcnt(2)" ::: "memory"); else asm volatile("s_waitcnt vmcnt(0)" ::: "memory"); } } while (0)
    ATT_ISSUE(nth_block(umask, 0, qb) * 256, 0); ATT_ISSUE(nth_block(umask, 0, qb) * 256 + 64, 1); ATT_ISSUE(nth_block(umask, 0, qb) * 256 + 128, 2);
    unsigned rowsel = 0xffffffffu; if (ROWSEL) rowsel = *(const LAS unsigned*)(lds + L_SEL + (wid * 32 + r32) * 4);
    float m_run = NEG, l_run = 0.f; f32x16 o[2]; o[0] = f32x16{}; o[1] = f32x16{};
    const int qrel = wid * 32 + r32;
    const int vb0 = (int)(lds0 + L_V) + ((lane >> 4) & 1) * 32 + (lane & 3) * 8 + (4 * hi + ((lane & 15) >> 2)) * 64;
    ATT_WAITK(2); asm volatile("s_waitcnt lgkmcnt(0)\n\ts_barrier" ::: "memory");
    constexpr int NP = DQ / 16;
#define SBAR() __builtin_amdgcn_sched_barrier(0)
#define EX2(x) __builtin_amdgcn_exp2f(x)
#define VTR(dst, off) asm volatile("ds_read_b64_tr_b16 %0,%1 offset:%c2" : "=&v"(dst) : "v"(vb_), "i"(off) : "memory")
#define MASK_TILE(P0, P1, tt) do { const int blk_ = nth_block(umask, (tt) >> 2, qb); \
        if (blk_ == qb && 32 * wid < 64 * ((tt) & 3) + 63) { const int kb = 64 * ((tt) & 3) + 4 * hi;     \
            _Pragma("unroll") for (int r = 0; r < 16; ++r) { const int kv = kb + (r & 3) + 8 * (r >> 2); if (kv > qrel) P0[r] = NEG; if (kv + 32 > qrel) P1[r] = NEG; } \
        } } while (0)
#define ROWMAX_FIN(a_, b_, X0, X1) do { float rm_ = max2a(a_, b_); auto rr_ = __builtin_amdgcn_permlane32_swap(__float_as_uint(rm_), __float_as_uint(rm_), false, false); \
        rm_ = max2a(__uint_as_float(rr_[0]), __uint_as_float(rr_[1])); \
        if (NEGM) {   \
            if (__any(rm_ > 8.0f)) { const float dl_ = fmaxf(rm_, 0.f); m_run += dl_; fsc = EX2(-dl_); cupd = true; \
                _Pragma("unroll") for (int r = 0; r < 16; ++r) { X0[r] -= dl_; X1[r] -= dl_; } } else fsc = 1.f; } \
        else if (__any(rm_ - m_run > 8.0f)) { mn = fmaxf(m_run, rm_); fsc = EX2(m_run - mn); m_run = mn; } else { fsc = 1.f; mn = m_run; } } while (0)
#define ATT_STEP(MORE, P0, P1, N0, N1) do { \
        const int s = t & 3; \
        if (t + 3 < NT) { const int nb = nth_block(umask, (t + 3) >> 2, qb); ATT_ISSUE(nb * 256 + ((t + 3) & 3) * 64, (t + 3) & 3); } \
        const int vb_ = vb0 + s * VSL; const LAS unsigned char* kp_ = lds + L_K + ((t + 1) & 3) * KSL + hi * 1024 + r32 * 16; \
        const float mnc = mn, fc = fsc; s16x4 vlo[8], vhi[8]; bf16x8 ka = bf16x8{}, kb2 = bf16x8{}; \
        if (MORE) { ka = *(const LAS bf16x8*)(kp_); kb2 = *(const LAS bf16x8*)(kp_ + 512); } \
        SBAR(); \
        _Pragma("unroll") for (int i = 0; i < NP; ++i) { \
            if (MORE) { if (i == 0) { N0 = __builtin_amdgcn_mfma_f32_32x32x16_bf16(ka, qr[0], NEGM ? negm : f32x16{}, 0, 0, 0); N1 = __builtin_amdgcn_mfma_f32_32x32x16_bf16(kb2, qr[0], NEGM ? negm : f32x16{}, 0, 0, 0); } \
                        else { N0 = __builtin_amdgcn_mfma_f32_32x32x16_bf16(ka, qr[i], N0, 0, 0, 0); N1 = __builtin_amdgcn_mfma_f32_32x32x16_bf16(kb2, qr[i], N1, 0, 0, 0); } } \
            if (MORE && i + 1 < NP) { ka = *(const LAS bf16x8*)(kp_ + (i + 1) * 2048); kb2 = *(const LAS bf16x8*)(kp_ + (i + 1) * 2048 + 512); } \
            _Pragma("unroll") for (int v = (i * 8) / NP; v < ((i + 1) * 8) / NP; ++v) { const int q_ = v >> 1, idx = (q_ & 1) + 4 * (q_ >> 1), off = (idx >> 2) * 4096 + (idx & 3) * 1024 + (v & 1) * 512; if (v & 1) VTR(vhi[idx], off); else VTR(vlo[idx], off); }     \
            _Pragma("unroll") for (int e = (i * 32) / NP; e < ((i + 1) * 32) / NP; ++e) { if (e < 16) P0[e] = NEGM ? EX2(P0[e]) : EX2(P0[e] - mnc); else P1[e - 16] = NEGM ? EX2(P1[e - 16]) : EX2(P1[e - 16] - mnc); } \
            asm volatile("" : "+v"(P0), "+v"(P1)); SBAR(); } \
        const u32x4 pw0 = (u32x4){pk2(P0[0], P0[1]), pk2(P0[2], P0[3]), pk2(P0[4], P0[5]), pk2(P0[6], P0[7])}, pw1 = (u32x4){pk2(P0[8], P0[9]), pk2(P0[10], P0[11]), pk2(P0[12], P0[13]), pk2(P0[14], P0[15])}; \
        const u32x4 pw2 = (u32x4){pk2(P1[0], P1[1]), pk2(P1[2], P1[3]), pk2(P1[4], P1[5]), pk2(P1[6], P1[7])}, pw3 = (u32x4){pk2(P1[8], P1[9]), pk2(P1[10], P1[11]), pk2(P1[12], P1[13]), pk2(P1[14], P1[15])}; \
        asm volatile("s_waitcnt lgkmcnt(0)" ::: "memory"); \
        if (__any(fc != 1.f)) { if (hi == 0) wsf[r32] = fc; asm volatile("s_waitcnt lgkmcnt(0)" ::: "memory"); \
            _Pragma("unroll") for (int r = 0; r < 16; ++r) { const float fr_ = wsf[crow(r, hi)]; o[0][r] *= fr_; o[1][r] *= fr_; } \
            asm volatile("s_waitcnt lgkmcnt(0)" ::: "memory"); } \
        if (MORE) MASK_TILE(N0, N1, t + 1); \
        SBAR(); \
        float ma = NEG, mb = NEG, sa = 0.f, sb2 = 0.f; \
        _Pragma("unroll") for (int j = 0; j < 8; ++j) { const int d = j & 1, k = j >> 1; \
            if (j == 4) asm volatile("s_waitcnt lgkmcnt(0)" ::: "memory"); \
            const bf16x8 vf = (bf16x8){vlo[d * 4 + k][0], vlo[d * 4 + k][1], vlo[d * 4 + k][2], vlo[d * 4 + k][3], vhi[d * 4 + k][0], vhi[d * 4 + k][1], vhi[d * 4 + k][2], vhi[d * 4 + k][3]}; \
            const bf16x8 pa = __builtin_bit_cast(bf16x8, k == 0 ? pw0 : (k == 1 ? pw1 : (k == 2 ? pw2 : pw3))); \
            o[d] = __builtin_amdgcn_mfma_f32_32x32x16_bf16(pa, vf, o[d], 0, 0, 0); \
            if (MORE) { ma = max3a(ma, N0[2 * j], N0[2 * j + 1]); mb = max3a(mb, N1[2 * j], N1[2 * j + 1]); } \
            sa += P0[2 * j] + P0[2 * j + 1]; sb2 += P1[2 * j] + P1[2 * j + 1]; \
            if (j < 4) { const int idx2 = (j & 1) * 4 + 2 + (j >> 1), off2 = (idx2 >> 2) * 4096 + (idx2 & 3) * 1024; VTR(vlo[idx2], off2); VTR(vhi[idx2], off2 + 512); } \
            asm volatile("" : "+v"(sa), "+v"(sb2), "+v"(ma), "+v"(mb)); SBAR(); } \
        l_run = l_run * fc + (sa + sb2); \
        if (MORE) { bool cupd = false; ROWMAX_FIN(ma, mb, N0, N1); \
            if (cupd || (ROWSEL && ((t + 2) & 3) == 0)) { const int nb_ = nth_block(umask, (t + 2) >> 2, qb); \
                const float cv_ = (!ROWSEL || nb_ == qb || ((rowsel >> nb_) & 1u)) ? -m_run : NEG; \
                _Pragma("unroll") for (int r = 0; r < 16; ++r) negm[r] = cv_; } } \
        { const int k_ = (t + 3 < NT) ? 1 : 0; ATT_WAITK(k_); asm volatile("s_waitcnt lgkmcnt(0)\n\ts_barrier" ::: "memory"); } \
    } while (0)
    constexpr bool NEGM = true;
    f32x16 pa0, pa1, pb0, pb1, negm = f32x16{}; float mn = NEG, fsc = 1.f;
    { const LAS unsigned char* kp_ = lds + L_K + hi * 1024 + r32 * 16; pa0 = f32x16{}; pa1 = f32x16{};
#pragma unroll
      for (int d0 = 0; d0 < NP; ++d0) { const bf16x8 b0_ = *(const LAS bf16x8*)(kp_ + d0 * 2048), b1_ = *(const LAS bf16x8*)(kp_ + d0 * 2048 + 512);
          pa0 = __builtin_amdgcn_mfma_f32_32x32x16_bf16(b0_, qr[d0], pa0, 0, 0, 0); pa1 = __builtin_amdgcn_mfma_f32_32x32x16_bf16(b1_, qr[d0], pa1, 0, 0, 0); } }
    MASK_TILE(pa0, pa1, 0);
    { float ma = NEG, mb = NEG; bool cupd = false; (void)cupd;
#pragma unroll
      for (int j = 0; j < 8; ++j) { ma = fmaxf(ma, fmaxf(pa0[2 * j], pa0[2 * j + 1])); mb = fmaxf(mb, fmaxf(pa1[2 * j], pa1[2 * j + 1])); }
      if (NEGM) { float rm_ = fmaxf(ma, mb); auto rr_ = __builtin_amdgcn_permlane32_swap(__float_as_uint(rm_), __float_as_uint(rm_), false, false); rm_ = fmaxf(__uint_as_float(rr_[0]), __uint_as_float(rr_[1]));
          m_run = rm_; fsc = 1.f;
#pragma unroll
          for (int r = 0; r < 16; ++r) { pa0[r] -= rm_; pa1[r] -= rm_; negm[r] = -rm_; } }
      else ROWMAX_FIN(ma, mb, pa0, pa1); }
    ATT_WAITK(1); asm volatile("s_waitcnt lgkmcnt(0)\n\ts_barrier" ::: "memory");
    int t = 0;
    for (; t < NT - 2; t += 2) { ATT_STEP(true, pa0, pa1, pb0, pb1); ++t; ATT_STEP(true, pb0, pb1, pa0, pa1); --t; }
    ATT_STEP(true, pa0, pa1, pb0, pb1); ++t;
    ATT_STEP(false, pb0, pb1, pa0, pa1);
#undef ATT_STEP
#undef ROWMAX_FIN
#undef MASK_TILE
#undef VTR
#undef EX2
#undef SBAR
#undef ATT_ISSUE
#undef ATT_WAITK
    { auto rr = __builtin_amdgcn_permlane32_swap(__float_as_uint(l_run), __float_as_uint(l_run), false, false); l_run = __uint_as_float(rr[0]) + __uint_as_float(rr[1]); }
    if (hi == 0) wsf[32 + r32] = l_run; asm volatile("s_waitcnt lgkmcnt(0)" ::: "memory");
    float rli[16];
#pragma unroll
    for (int r = 0; r < 16; ++r) rli[r] = __builtin_amdgcn_rcpf(wsf[32 + crow(r, hi)]);
    bf16_t* Ow = Oh + (rowbase + q0 + wid * 32) * ldo;
    { LAS bf16_t* stg = (LAS bf16_t*)(lds + L_OST) + wid * 2048;
#pragma unroll
      for (int r = 0; r < 16; ++r) { const int orow = crow(r, hi);
#pragma unroll
          for (int d0 = 0; d0 < 2; ++d0) stg[orow * 64 + d0 * 32 + r32] = (bf16_t)(pk2(o[d0][r] * rli[r], 0.f) & 0xffffu); }
      asm volatile("s_waitcnt lgkmcnt(0)" ::: "memory");
#pragma unroll
      for (int i = 0; i < 4; ++i) { const int row = i * 8 + (lane >> 3), ch = lane & 7; const u32x4 v = *(const LAS u32x4*)(stg + row * 64 + ch * 8); *(u32x4*)(Ow + (long)row * ldo + ch * 8) = v; } }
    ATT_WAITBAR();
}
}

__device__ __forceinline__ f32x16 mfma32f(float a, float b, f32x16 c) { return __builtin_amdgcn_mfma_f32_32x32x2f32(a, b, c, 0, 0, 0); }
__device__ __forceinline__ bf16x8 ldpack(const LAS float* p, int stride) {
    const u32x4 w = (u32x4){pk2(p[0], p[stride]), pk2(p[2 * stride], p[3 * stride]), pk2(p[4 * stride], p[5 * stride]), pk2(p[6 * stride], p[7 * stride])};
    return __builtin_bit_cast(bf16x8, w);
}
__device__ __forceinline__ f32x16 mfma16b(bf16x8 a, bf16x8 b, f32x16 c) { return __builtin_amdgcn_mfma_f32_32x32x16_bf16(a, b, c, 0, 0, 0); }
__device__ __forceinline__ float ex2(float x) { return __builtin_amdgcn_exp2f(x); }

__device__ __forceinline__ void ret_kv_unit(int un, const bf16_t* RK, const bf16_t* RV, float* RKV, const float* lg2p, LAS unsigned char* lds) {
    const int tid = opaque_tid(), lane = tid & 63, r32 = lane & 31, hi = lane >> 5, wid = tid >> 6;
    const int bh = un >> 5, n = un & 31, b = bh >> 2, h = bh & 3; const long r0 = (long)b * SS + n * 128; const float lg = lg2p[h];
    LAS float* Kz = (LAS float*)lds; LAS float* Vs = (LAS float*)(lds + 32768);
    { const int row = tid >> 2, cs = (tid & 3) * 16; const float z = ex2(lg * (float)(127 - row)); const bf16_t* p = RK + (r0 + row) * 256 + h * 64 + cs;
      f32x4 a, bq; unpack8(*(const u32x4*)p, a, bq); *(LAS f32x4*)(Kz + row * 64 + cs) = a * z; *(LAS f32x4*)(Kz + row * 64 + cs + 4) = bq * z;
      unpack8(*(const u32x4*)(p + 8), a, bq); *(LAS f32x4*)(Kz + row * 64 + cs + 8) = a * z; *(LAS f32x4*)(Kz + row * 64 + cs + 12) = bq * z;
      const int vs = (tid & 3) * 32; const bf16_t* pv_ = RV + (r0 + row) * 512 + h * 128 + vs;
#pragma unroll
      for (int i = 0; i < 4; ++i) { unpack8(*(const u32x4*)(pv_ + 8 * i), a, bq); *(LAS f32x4*)(Vs + row * 128 + vs + 8 * i) = a; *(LAS f32x4*)(Vs + row * 128 + vs + 8 * i + 4) = bq; } }
    __syncthreads();
    const int dt = wid >> 2, et = wid & 3; f32x16 acc = f32x16{};
#pragma unroll 2
    for (int j0 = 0; j0 < 128; j0 += 16) acc = mfma16b(ldpack(Kz + (j0 + 8 * hi) * 64 + dt * 32 + r32, 64), ldpack(Vs + (j0 + 8 * hi) * 128 + et * 32 + r32, 128), acc);
    float* dst = RKV + (size_t)un * 8192;
#pragma unroll
    for (int r = 0; r < 16; ++r) dst[(dt * 32 + att::crow(r, hi)) * 128 + et * 32 + r32] = acc[r];
    __syncthreads();
}
__device__ __forceinline__ void ret_out_unit(int un, const bf16_t* RQ, const bf16_t* RK, bf16_t* RV, const float* RKV, const float* gnw, const float* gnb, const float* lg2p, LAS unsigned char* lds) {
    const int tid = opaque_tid(), lane = tid & 63, r32 = lane & 31, hi = lane >> 5, wid = tid >> 6;
    const int bh = un >> 5, n = un < 256 ? (un & 31) : 31 - (un & 31), b = bh >> 2, h = bh & 3; const long r0 = (long)b * SS + n * 128; const float lg = lg2p[h];
    LAS float* Qs = (LAS float*)lds; LAS float* Ks = (LAS float*)(lds + 33280); LAS float* Rs = (LAS float*)(lds + 66560); LAS float* Sm = (LAS float*)(lds + 66560); LAS float* Vs = (LAS float*)lds;
    { const int row = tid >> 2, cs = (tid & 3) * 16; const bf16_t* pq = RQ + (r0 + row) * 256 + h * 64 + cs; const bf16_t* pk = RK + (r0 + row) * 256 + h * 64 + cs;
      f32x4 a, bq;
#pragma unroll
      for (int i = 0; i < 2; ++i) { unpack8(*(const u32x4*)(pq + 8 * i), a, bq);
#pragma unroll
          for (int j = 0; j < 4; ++j) { Qs[row * 65 + cs + 8 * i + j] = a[j]; Qs[row * 65 + cs + 8 * i + 4 + j] = bq[j]; }
          unpack8(*(const u32x4*)(pk + 8 * i), a, bq);
#pragma unroll
          for (int j = 0; j < 4; ++j) { Ks[row * 65 + cs + 8 * i + j] = a[j]; Ks[row * 65 + cs + 8 * i + 4 + j] = bq[j]; } }
      { f32x4 r0 = (f32x4){0.f, 0.f, 0.f, 0.f}, r1 = r0, r2 = r0, r3 = r0; const float* base = RKV + (size_t)(bh * 32) * 8192 + tid * 4; int j = 0;
#pragma unroll 1
        for (; j + 3 < n; j += 4) { const float* p = base + (size_t)j * 8192; f32x4 a[4][4];
#pragma unroll
            for (int u = 0; u < 4; ++u)
#pragma unroll
                for (int q = 0; q < 4; ++q) a[u][q] = *(const f32x4*)(p + u * 8192 + q * 2048);
#pragma unroll
            for (int u = 0; u < 4; ++u) { const float w = ex2(lg * 128.0f * (float)(n - 1 - j - u)); r0 += a[u][0] * w; r1 += a[u][1] * w; r2 += a[u][2] * w; r3 += a[u][3] * w; } }
#pragma unroll 1
        for (; j < n; ++j) { const float w0 = ex2(lg * 128.0f * (float)(n - 1 - j)); const float* p = base + (size_t)j * 8192;
            r0 += *(const f32x4*)(p) * w0; r1 += *(const f32x4*)(p + 2048) * w0; r2 += *(const f32x4*)(p + 4096) * w0; r3 += *(const f32x4*)(p + 6144) * w0; }
        *(LAS f32x4*)(Rs + tid * 4) = r0; *(LAS f32x4*)(Rs + tid * 4 + 2048) = r1; *(LAS f32x4*)(Rs + tid * 4 + 4096) = r2; *(LAS f32x4*)(Rs + tid * 4 + 6144) = r3; } }
    __syncthreads();
    const int it = wid >> 1, eh = wid & 1; f32x16 acc0 = f32x16{}, acc1 = f32x16{};
    bf16x8 qa[4];
#pragma unroll
    for (int ks = 0; ks < 4; ++ks) { qa[ks] = ldpack(Qs + (32 * it + r32) * 65 + 16 * ks + 8 * hi, 1);
        acc0 = mfma16b(qa[ks], ldpack(Rs + (16 * ks + 8 * hi) * 128 + 64 * eh + r32, 128), acc0); acc1 = mfma16b(qa[ks], ldpack(Rs + (16 * ks + 8 * hi) * 128 + 64 * eh + 32 + r32, 128), acc1); }
#pragma unroll
    for (int r = 0; r < 16; ++r) { const float xi = ex2(lg * (float)(32 * it + att::crow(r, hi) + 1)); acc0[r] *= xi; acc1[r] *= xi; }
    __syncthreads();
#pragma unroll
    for (int jj = 0; jj < 2; ++jj) { const int jt = 2 * eh + jj; if (jt <= it) { f32x16 s = f32x16{};
#pragma unroll
        for (int ks = 0; ks < 4; ++ks) s = mfma16b(qa[ks], ldpack(Ks + (32 * jt + r32) * 65 + 16 * ks + 8 * hi, 1), s);
#pragma unroll
        for (int r = 0; r < 16; ++r) { const int i = 32 * it + att::crow(r, hi), j = 32 * jt + r32; Sm[i * 129 + j] = (i >= j) ? s[r] * ex2(lg * (float)(i - j)) : 0.f; } } }
    __syncthreads();
    { const int row = tid >> 2, vs = (tid & 3) * 32; const bf16_t* pv_ = RV + (r0 + row) * 512 + h * 128 + vs; f32x4 a, bq;
#pragma unroll
      for (int i = 0; i < 4; ++i) { unpack8(*(const u32x4*)(pv_ + 8 * i), a, bq); *(LAS f32x4*)(Vs + row * 128 + vs + 8 * i) = a; *(LAS f32x4*)(Vs + row * 128 + vs + 8 * i + 4) = bq; } }
    __syncthreads();
    { const int jend = 32 * (it + 1);
#pragma unroll 2
      for (int j0 = 0; j0 < jend; j0 += 16) { const bf16x8 a = ldpack(Sm + (32 * it + r32) * 129 + j0 + 8 * hi, 1);
          acc0 = mfma16b(a, ldpack(Vs + (j0 + 8 * hi) * 128 + 64 * eh + r32, 128), acc0); acc1 = mfma16b(a, ldpack(Vs + (j0 + 8 * hi) * 128 + 64 * eh + 32 + r32, 128), acc1); } }
    __syncthreads();
#pragma unroll
    for (int r = 0; r < 16; ++r) { const int i = 32 * it + att::crow(r, hi); Sm[i * 129 + 64 * eh + r32] = acc0[r]; Sm[i * 129 + 64 * eh + 32 + r32] = acc1[r]; }
    __syncthreads();
    { const int row = tid >> 2, q4 = tid & 3; float v[32]; float s = 0.f;
#pragma unroll
      for (int k = 0; k < 32; ++k) { v[k] = Sm[row * 129 + q4 * 32 + k]; s += v[k]; }
      s += __shfl_xor(s, 1); s += __shfl_xor(s, 2); const float mu = s * (1.f / 128.f); float q = 0.f;
#pragma unroll
      for (int k = 0; k < 32; ++k) { v[k] -= mu; q += v[k] * v[k]; }
      q += __shfl_xor(q, 1); q += __shfl_xor(q, 2); const float rstd = rsqrtf(q * (1.f / 128.f) + GNEPS);
      const float* gw = gnw + h * 128 + q4 * 32; const float* gb = gnb + h * 128 + q4 * 32; bf16_t* po = RV + (r0 + row) * 512 + h * 128 + q4 * 32;
#pragma unroll
      for (int i = 0; i < 4; ++i) { f32x4 a, bq; const f32x4 w0 = *(const f32x4*)(gw + 8 * i), w1 = *(const f32x4*)(gw + 8 * i + 4), b0 = *(const f32x4*)(gb + 8 * i), b1 = *(const f32x4*)(gb + 8 * i + 4);
#pragma unroll
          for (int j = 0; j < 4; ++j) { a[j] = v[8 * i + j] * rstd * w0[j] + b0[j]; bq[j] = v[8 * i + 4 + j] * rstd * w1[j] + b1[j]; }
          *(u32x4*)(po + 8 * i) = pack8(a, bq); } }
    __syncthreads();
}

__device__ __forceinline__ float wave_sum(float v) {
#pragma unroll
    for (int o = 1; o < 64; o <<= 1) v += __shfl_xor(v, o);
    return v;
}
__device__ __forceinline__ void sincos_acc(float ang, float& s, float& c) {
    const double a = (double)ang; const double k = rint(a * 0.63661977236758134308); const double r = a - k * 1.57079632679489661923; const double r2 = r * r;
    const double sr = r * (1.0 + r2 * (-1.0 / 6 + r2 * (1.0 / 120 + r2 * (-1.0 / 5040 + r2 * (1.0 / 362880 + r2 * (-1.0 / 39916800 + r2 * (1.0 / 6227020800.0)))))));
    const double cr = 1.0 + r2 * (-0.5 + r2 * (1.0 / 24 + r2 * (-1.0 / 720 + r2 * (1.0 / 40320 + r2 * (-1.0 / 3628800 + r2 * (1.0 / 479001600.0 - r2 * (1.0 / 87178291200.0)))))));
    const int q = ((int)k) & 3;
    const double sv = (q == 0) ? sr : (q == 1) ? cr : (q == 2) ? -sr : -cr, cv = (q == 0) ? cr : (q == 1) ? -sr : (q == 2) ? -cr : sr;
    s = (float)sv; c = (float)cv;
}
__device__ __forceinline__ int perm_pair(int d, int half) { const int i = d < half ? d : d - half; return 8 * (i >> 2) + (i & 3) + (d < half ? 0 : 4); }

__device__ __forceinline__ void map_row(int kind, int n, int& row, float& sc) {
    const float c2m = 0.125f * LOG2E, c2q = 0.10206207261596575f * LOG2E;
    sc = 1.f; row = n;
    if (kind == 1) {
        if (n < 384) row = n;
        else if (n < 416) row = 384 + perm_pair(n - 384, 16);
        else if (n < 1952) { const int s = n - 416, sec = s >> 9, w = s & 511, hd = w >> 6, d = w & 63; row = 512 + sec * 512 + hd * 64 + ((sec < 2 && d < 16) ? perm_pair(d, 8) : d); if (sec == 0) sc = c2m; }
        else if (n < 2464) { const int s = n - 1952, sec = s >> 8, hd = (s & 255) >> 6, d = s & 63; row = 2048 + sec * 256 + hd * 64 + perm_pair(d, 32); if (sec == 1) sc = 0.125f; }
        else if (n < 2976) row = 2560 + (n - 2464);
        else if (n < 3488) row = 6144 + (n - 2976);
        else row = 3072 + (n - 3488);
    } else if (kind == 2) { const int hd = n / 96, d = n % 96; row = hd * 96 + (d < 64 ? d : 64 + perm_pair(d - 64, 16)); sc = c2q; }
}
__device__ __forceinline__ void tr_item(const float* __restrict__ W, int K, int N, bf16_t* WT, const float* gain, int kind, LAS float* scr, int item, int lane) {
    const int nblk = N / 32, kb = item / nblk, nb = item % nblk, k0 = 64 * kb, n0 = 32 * nb;
#pragma unroll
    for (int i = 0; i < 32; ++i) { const int kk = 2 * i + (lane >> 5); scr[kk * 33 + (lane & 31)] = W[(size_t)(k0 + kk) * N + n0 + (lane & 31)]; }
    asm volatile("s_waitcnt lgkmcnt(0)" ::: "memory");
    const int c = lane & 7; f32x4 g0 = (f32x4){1.f, 1.f, 1.f, 1.f}, g1 = g0;
    if (gain) { g0 = *(const f32x4*)(gain + k0 + 8 * c); g1 = *(const f32x4*)(gain + k0 + 8 * c + 4); }
#pragma unroll
    for (int j = 0; j < 4; ++j) { const int n = (lane >> 3) + 8 * j; int row; float sc; map_row(kind, n0 + n, row, sc); const LAS float* s = scr + (8 * c) * 33 + n;
        u32x4 o; o.x = pk2(s[0 * 33] * g0[0] * sc, s[1 * 33] * g0[1] * sc); o.y = pk2(s[2 * 33] * g0[2] * sc, s[3 * 33] * g0[3] * sc); o.z = pk2(s[4 * 33] * g1[0] * sc, s[5 * 33] * g1[1] * sc); o.w = pk2(s[6 * 33] * g1[2] * sc, s[7 * 33] * g1[3] * sc);
        *(u32x4*)(WT + (size_t)row * K + k0 + 8 * c) = o; }
    asm volatile("s_waitcnt lgkmcnt(0)" ::: "memory");
}


constexpr size_t WS_BAR = 1835008;
constexpr int LDS_MISC = 140000;
#define XB_TMO      128
#define XB_XCNT(j)  (256  + 64 * (j))
#define XB_XSUB(j)  (1280 + 64 * (j))
#define XB_XGEN(j)  (2304 + 64 * (j))
#define XB_TOP      3328
#define XB_TOPGEN   3392
#define XCD_BAR_WORDS 3456
#define XB_SPIN_CAP (1u << 22)
__device__ __forceinline__ unsigned xb_ld(unsigned* p)              { return __hip_atomic_load(p, __ATOMIC_RELAXED, __HIP_MEMORY_SCOPE_AGENT); }
__device__ __forceinline__ unsigned xb_add(unsigned* p, unsigned v) { return __hip_atomic_fetch_add(p, v, __ATOMIC_RELAXED, __HIP_MEMORY_SCOPE_AGENT); }
__device__ __forceinline__ unsigned xb_xcc_id() { return (unsigned)__builtin_amdgcn_s_getreg((3 << 11) | 20) & 0xFu; }
#define XB_SPIN(cond, bar) do { unsigned _sp = 0; while (cond) { __builtin_amdgcn_s_sleep(1); \
    if ((++_sp & 255u) == 0u) { if (xb_ld(&(bar)[XB_TMO])) break; if (_sp > XB_SPIN_CAP) { atomicAdd(&(bar)[XB_TMO], 1u); break; } } } } while (0)
__device__ __forceinline__ void xcd_barrier_complete(unsigned* bar, unsigned x, unsigned& nloc, unsigned& nx) {
    const unsigned G = gridDim.x;
    unsigned sum, cnt, mine, sp = 0u;
    for (;;) {
        sum = 0u; cnt = 0u; mine = 0u;
#pragma unroll
        for (unsigned j = 0; j < 16; ++j) { const unsigned c = xb_ld(&bar[XB_XCNT(j)]); sum += c; cnt += (c > 0u) ? 1u : 0u; mine = (j == x) ? c : mine; }
        if (sum == G) break;
        __builtin_amdgcn_s_sleep(1);
        if ((++sp & 255u) == 0u) { if (xb_ld(&bar[XB_TMO])) break; if (sp > XB_SPIN_CAP) { atomicAdd(&bar[XB_TMO], 1u); break; } }
    }
    nloc = mine > 0u ? mine : 1u; nx = cnt > 0u ? cnt : 1u;
}
__device__ __forceinline__ void grid_bar(unsigned char* wsb, LAS unsigned char* ldsb) {
    asm volatile("s_waitcnt vmcnt(0)" ::: "memory");
    __syncthreads();
    if (threadIdx.x == 0) {
        unsigned* bar = (unsigned*)(wsb + WS_BAR); volatile LAS unsigned* st = (volatile LAS unsigned*)(ldsb + LDS_MISC); const unsigned x = xb_xcc_id();
        __builtin_amdgcn_s_waitcnt(0);
        unsigned nloc = st[0], nx = st[1];
        if (nloc == 0u) { xcd_barrier_complete(bar, x, nloc, nx); st[0] = nloc; st[1] = nx; }
        const unsigned old = xb_add(&bar[XB_XSUB(x)], 1u);
        const unsigned gen = old / nloc;
        if (old + 1u == (gen + 1u) * nloc) {
            __builtin_amdgcn_fence(__ATOMIC_RELEASE, "agent");
            asm volatile("s_waitcnt vmcnt(0)" ::: "memory");
            const unsigned og = xb_add(&bar[XB_TOP], 1u);
            const unsigned tg = og / nx;
            if (og + 1u == (tg + 1u) * nx) xb_add(&bar[XB_TOPGEN], 1u);
            else XB_SPIN(xb_ld(&bar[XB_TOPGEN]) == tg, bar);
            __builtin_amdgcn_fence(__ATOMIC_ACQUIRE, "agent");
            xb_add(&bar[XB_XGEN(x)], 1u);
            asm volatile("s_waitcnt vmcnt(0)" ::: "memory");
        } else {
            XB_SPIN(xb_ld(&bar[XB_XGEN(x)]) == gen, bar);
            __builtin_amdgcn_fence(__ATOMIC_ACQUIRE, "agent");
            asm volatile("s_waitcnt vmcnt(0)" ::: "memory");
        }
    }
    __syncthreads();
}

__device__ __forceinline__ unsigned char* ap_ws() { const __attribute__((address_space(4))) Args* ap = (const __attribute__((address_space(4))) Args*)__builtin_amdgcn_kernarg_segment_ptr(); asm volatile("" : "+s"(ap)); return ap->ws; }
#ifdef PROBE_A
#define STAMP(k) do { unsigned long long* tsp_ = (unsigned long long*)(ap_ws() + WS_TS); if (blockIdx.x == 0 && threadIdx.x == 0) tsp_[(k)] = __builtin_amdgcn_s_memrealtime(); } while (0)
#else
#define STAMP(k) do {} while (0)
#endif
__global__ void __launch_bounds__(512) mega_fwd(Args args) {
    extern __shared__ __attribute__((aligned(16))) unsigned char lds_raw[];
    LAS unsigned char* lds = (LAS unsigned char*)lds_raw;
    {
      unsigned* bar = (unsigned*)(args.ws + WS_BAR);
      if (threadIdx.x < 2) ((volatile LAS unsigned*)(lds + LDS_MISC))[threadIdx.x] = 0u;
      if (args.use_cg_sync) cg::this_grid().sync();
      if (threadIdx.x == 0) (void)xb_add(&bar[XB_XCNT(xb_xcc_id())], 1u);
      __syncthreads();
    }
    STAMP(0);
#define PHASE_VARS \
    const __attribute__((address_space(4))) Args* ap = (const __attribute__((address_space(4))) Args*)__builtin_amdgcn_kernarg_segment_ptr(); asm volatile("" : "+s"(ap)); \
    unsigned char* ws = ap->ws; float* out = ap->out; (void)out; (void)ws; \
    int G = (int)gridDim.x, bx = (int)blockIdx.x; asm volatile("" : "+s"(G), "+s"(bx)); \
    const int tid = opaque_tid(), lane = tid & 63, wave = __builtin_amdgcn_readfirstlane(tid >> 6); (void)lane; (void)wave; \
    const int vcu = (G % 8 == 0) ? (bx % 8) * (G / 8) + bx / 8 : bx; const int gw = vcu * 8 + wave, NGW = G * 8; (void)gw; (void)NGW; (void)vcu;
    if (PH(0)) { PHASE_VARS
            {
                for (int idx = (vcu * 512 + tid); idx < SS * 56; idx += G * 512) { const int pos = idx / 56, f = idx % 56; float s, c;
                    if (f < 16) { sincos_acc((float)pos * ap->inv_mla[f], s, c); ((float*)(ws + TAB_CM))[pos * 16 + f] = c; ((float*)(ws + TAB_SM))[pos * 16 + f] = s; }
                    else if (f < 24) { sincos_acc((float)pos * ap->inv_moba[f - 16], s, c); ((float*)(ws + TAB_CB))[pos * 8 + f - 16] = c; ((float*)(ws + TAB_SB))[pos * 8 + f - 16] = s; }
                    else { sincos_acc((float)pos * ap->inv_ret[f - 24], s, c); ((float*)(ws + TAB_CR))[pos * 32 + f - 24] = c; ((float*)(ws + TAB_SR))[pos * 32 + f - 24] = s; } }
                const float* x = ap->in[0]; bf16_t* XB = WSP(bf16_t, WS_XB); float* SSQ_X = WSP(float, WS_SSQX);
                for (int m = gw; m < TT; m += NGW) { const f32x4* xr = (const f32x4*)(x + (size_t)m * DM) + lane; f32x4 v[4]; float s = 0.f;
#pragma unroll
                    for (int j = 0; j < 4; ++j) { v[j] = xr[64 * j]; s += dot4(v[j]); }
                    s = wave_sum(s);
                    unsigned long long* o8 = (unsigned long long*)(XB + (size_t)m * DM) + lane;
#pragma unroll
                    for (int j = 0; j < 4; ++j) o8[64 * j] = (unsigned long long)pk2(v[j][0], v[j][1]) | ((unsigned long long)pk2(v[j][2], v[j][3]) << 32);
                    if (lane < 16) SSQ_X[(size_t)m * 16 + lane] = lane == 0 ? s : 0.f; }
            }
    }
#pragma unroll 1
    for (int l = 0; l < 2; ++l) {
        if (PH(0)) {
            PHASE_VARS
            LAS float* scr = (LAS float*)(lds + wave * 16384);
            constexpr int I_IN = 16 * 205, I_QU = 4 * 24, I_KVU = 2 * 32, I_BR = 8 * 32, I_O = 16 * 32, I_UP = 16 * 128, I_DN = 64 * 32;
            constexpr int NITEMS = I_IN + I_QU + I_KVU + 3 * I_BR + I_O + I_UP + I_DN;
            for (int it = gw; it < NITEMS; it += NGW) {
                int r = it;
                if (r < I_IN) { tr_item(ap->in[2] + (size_t)l * 1024 * 6560, 1024, 6560, (bf16_t*)(ws + W_IN), ap->in[1] + l * 1024, 1, scr, r, lane); continue; } r -= I_IN;
                if (r < I_QU) { tr_item(ap->in[5] + (size_t)l * 256 * 768, 256, 768, (bf16_t*)(ws + W_QU), ap->in[3] + l * 256, 2, scr, r, lane); continue; } r -= I_QU;
                if (r < I_KVU) { tr_item(ap->in[6] + (size_t)l * 128 * 1024, 128, 1024, (bf16_t*)(ws + W_KVU), ap->in[4] + l * 128, 0, scr, r, lane); continue; } r -= I_KVU;
                if (r < 3 * I_BR) { const int br = r / I_BR; tr_item(ap->in[9 + br] + (size_t)l * 512 * 1024, 512, 1024, (bf16_t*)(ws + W_BR) + (size_t)br * 1024 * 512, nullptr, 0, scr, r - br * I_BR, lane); continue; } r -= 3 * I_BR;
                if (r < I_O) { tr_item(ap->in[12] + (size_t)l * 1024 * 1024, 1024, 1024, (bf16_t*)(ws + W_OUT), nullptr, 0, scr, r, lane); continue; } r -= I_O;
                if (r < I_UP) { tr_item(ap->in[14] + (size_t)l * 1024 * 4096, 1024, 4096, (bf16_t*)(ws + W_UP), ap->in[13] + l * 1024, 0, scr, r, lane); continue; } r -= I_UP;
                tr_item(ap->in[15] + (size_t)l * 4096 * 1024, 4096, 1024, (bf16_t*)(ws + W_DN), nullptr, 0, scr, r, lane);
            }
        }
        grid_bar(ap_ws(), lds);
        STAMP(1 + l * 12 + 0);
        if (PH(1)) { PHASE_VARS pg8::Gemm g{1024, 1024, 1024}; pg8::SchedStd S; S.init(ws + WS_XB, ws + W_IN, 1024, 1024, 64, 12, G, bx);
          EpiP1 E{ws}; pg8::gemm_phase(lds, g, S, E); }
        grid_bar(ap_ws(), lds);
        STAMP(1 + l * 12 + 1);
        if (PH(2)) { PHASE_VARS pg8::Gemm g{256, 256, 256}; pg8::SchedStd S; S.init(ws + WS_CQ, ws + W_QU, 256, 256, 64, 3, G, bx); EpiQU E{ws}; pg8::gemm_phase(lds, g, S, E); }
        if (PH(3)) { PHASE_VARS pg8::Gemm g{128, 128, 128}; pg8::SchedStd S; S.init(ws + WS_CKV, ws + W_KVU, 128, 128, 64, 4, G, bx); EpiKVU E{ws}; pg8::gemm_phase(lds, g, S, E); }
        __syncthreads();
        STAMP(30 + l * 8 + 0);
        if (PH(4)) { PHASE_VARS
          for (int un = vcu; un < 256; un += G) {
            const int bq = un >> 2, qtr = un & 3, b = bq >> 4, blk = bq & 15; const bf16_t* p = WSP(bf16_t, WS_MK) + ((size_t)b * SS + blk * 256 + qtr * 64) * 512 + tid; float s = 0.f;
#pragma unroll 32
            for (int j = 0; j < 64; ++j) s += __uint_as_float((unsigned)p[(size_t)j * 512] << 16);
            WSP(float, WS_KMP)[(size_t)un * 512 + tid] = s; } }
        STAMP(30 + l * 8 + 1);
        if (PH(5)) { PHASE_VARS for (int un = vcu; un < 512; un += G) ret_kv_unit(un, WSP(bf16_t, WS_RK), WSP(bf16_t, WS_RV), WSP(float, WS_RKV), (const float*)ap->ret_lg2, lds); }
        grid_bar(ap_ws(), lds);
        STAMP(1 + l * 12 + 2);
        if (PH(6)) { PHASE_VARS
          for (int un = vcu; un < 512; un += G) {
            const int bh = (un & 255) >> 3, qb = un < 256 ? (un & 7) : 15 - (un & 7), b = bh >> 3, h = bh & 7;
            att::attn_unit<96, false>((long)b * SS, qb, WSP(bf16_t, WS_QM) + h * 96, 768, WSP(bf16_t, WS_KVM) + h * 128, 1024, WSP(bf16_t, WS_KPE), WSP(bf16_t, WS_KVM) + h * 128 + 64, 1024, WSP(bf16_t, WS_OM) + h * 64, 512, lds, (1u << qb) - 1u);
          } }
        STAMP(30 + l * 8 + 2);
        if (PH(7)) { PHASE_VARS
          for (int un = vcu; un < 512; un += G) {
            const int bh = (un & 255) >> 3, qb = un < 256 ? (un & 7) : 15 - (un & 7), b = bh >> 3, h = bh & 7;
            LAS float* km = (LAS float*)(lds + att::L_KM); LAS unsigned* selp = (LAS unsigned*)(lds + att::L_SEL); LAS unsigned* ump = (LAS unsigned*)(lds + att::L_UM);
            bf16_t* MQ = WSP(bf16_t, WS_MQ);
            if (tid == 0) *ump = 0u;
            for (int e = tid; e < 1024; e += 512) { const int n = e >> 6, d = e & 63; float s = 0.f;
                if (n < qb) { const float* p = WSP(float, WS_KMP) + ((size_t)(b * 16 + n) * 4) * 512 + h * 64 + d; s = (p[0] + p[512]) + (p[1024] + p[1536]); }
                km[e] = s * (1.f / 256.f); }
            __syncthreads();
            if (tid < 256) { const bf16_t* qp = MQ + ((size_t)b * SS + qb * 256 + tid) * 512 + h * 64;
                float v1 = -INFINITY, v2 = -INFINITY, v3 = -INFINITY; int i1 = 0, i2 = 0, i3 = 0;
#pragma unroll 1
                for (int n = 0; n < qb; ++n) { float gsum = 0.f;
#pragma unroll
                    for (int i = 0; i < 8; ++i) { f32x4 a, bq; unpack8(*(const u32x4*)(qp + 8 * i), a, bq); const f32x4 k0 = *(const LAS f32x4*)(km + n * 64 + 8 * i), k1 = *(const LAS f32x4*)(km + n * 64 + 8 * i + 4);
                        gsum += (a[0] * k0[0] + a[1] * k0[1]) + (a[2] * k0[2] + a[3] * k0[3]) + (bq[0] * k1[0] + bq[1] * k1[1]) + (bq[2] * k1[2] + bq[3] * k1[3]); }
                    if (gsum > v1) { v3 = v2; i3 = i2; v2 = v1; i2 = i1; v1 = gsum; i1 = n; } else if (gsum > v2) { v3 = v2; i3 = i2; v2 = gsum; i2 = n; } else if (gsum > v3) { v3 = gsum; i3 = n; } }
                unsigned sel = qb <= 3 ? ((1u << qb) - 1u) : ((1u << i1) | (1u << i2) | (1u << i3));
                selp[tid] = sel;
                unsigned um = sel;
#pragma unroll
                for (int o = 1; o < 64; o <<= 1) um |= (unsigned)__shfl_xor((int)um, o);
                if (lane == 0) atomicOr((unsigned*)ump, um); }
            __syncthreads();
            const unsigned umask = *ump;
            att::attn_unit<64, true>((long)b * SS, qb, MQ + h * 64, 512, WSP(bf16_t, WS_MK) + h * 64, 512, nullptr, WSP(bf16_t, WS_MV) + h * 64, 512, MQ + h * 64, 512, lds, umask);
          } }
        STAMP(30 + l * 8 + 3);
        if (PH(8)) { PHASE_VARS for (int un = vcu; un < 512; un += G) ret_out_unit(un, WSP(bf16_t, WS_RQ), WSP(bf16_t, WS_RK), WSP(bf16_t, WS_RV), WSP(float, WS_RKV), ap->in[7] + l * 512, ap->in[8] + l * 512, (const float*)ap->ret_lg2, lds); }
        grid_bar(ap_ws(), lds);
        STAMP(1 + l * 12 + 3);
        if (PH(9)) { PHASE_VARS pg8::Gemm g{1024, 1024, 1024}; pg8::SchedStd S; S.init(ws + WS_XB, ws + W_IN + (size_t)3072 * 1024 * 2, 1024, 1024, 64, 14, G, bx);
          EpiGate E{ws}; pg8::gemm_phase(lds, g, S, E); }
        grid_bar(ap_ws(), lds);
        STAMP(1 + l * 12 + 4);
        if (PH(10)) { PHASE_VARS pg8::Gemm g{512, 512, 512}; pg8::SchedMerge S{(const char*)(ws + WS_OM), (const char*)(ws + WS_MQ), (const char*)(ws + WS_RV), (const char*)(ws + W_BR), G, bx};
          EpiMerge E{ws}; pg8::gemm_phase(lds, g, S, E); }
        grid_bar(ap_ws(), lds);
        STAMP(1 + l * 12 + 5);
        if (PH(11)) { PHASE_VARS pg8::Gemm g{1024, 1024, 1024}; pg8::SchedStd S; S.init(ws + WS_MB, ws + W_OUT, 1024, 1024, 64, 4, G, bx);
          EpiRes E{l == 0 ? ap->in[0] : (const float*)out, out, ws, 1}; pg8::gemm_phase(lds, g, S, E); }
        grid_bar(ap_ws(), lds);
        STAMP(1 + l * 12 + 6);
        if (PH(12)) { PHASE_VARS pg8::Gemm g{1024, 1024, 1024}; pg8::SchedStd S; S.init(ws + WS_XB, ws + W_UP, 1024, 1024, 64, 16, G, bx); EpiUp E{ws}; pg8::gemm_phase(lds, g, S, E); }
        grid_bar(ap_ws(), lds);
        STAMP(1 + l * 12 + 7);
        if (PH(13)) { PHASE_VARS pg8::Gemm g{4096, 4096, 4096}; pg8::SchedStd S; S.init(ws + WS_HID, ws + W_DN, 4096, 4096, 64, 4, G, bx); EpiRes E{(const float*)out, out, ws, l == 0 ? 1 : 0}; pg8::gemm_phase(lds, g, S, E); }
        grid_bar(ap_ws(), lds);
        STAMP(1 + l * 12 + 8);
    }
    { PHASE_VARS const float* fn = ap->in[16];
      for (int m = gw; m < TT; m += NGW) { f32x4* xr = (f32x4*)(out + (size_t)m * DM) + lane; f32x4 v[4]; float s = 0.f;
#pragma unroll
          for (int j = 0; j < 4; ++j) { v[j] = xr[64 * j]; s += dot4(v[j]); }
          s = wave_sum(s); const float rs = rsqrtf(s * (1.f / 1024.f) + NEPS);
#pragma unroll
          for (int j = 0; j < 4; ++j) { const f32x4 gsc = *((const f32x4*)fn + lane + 64 * j); xr[64 * j] = v[j] * rs * gsc; } }
#ifdef PROBE_A
      { const unsigned long long* ts = (const unsigned long long*)(ws + WS_TS); const float dlt = (float)(ts[PROBE_B] - ts[PROBE_A]) * 4e-7f;
        for (int m = gw; m < 1024; m += NGW) { f32x4* xr = (f32x4*)(out + (size_t)m * DM) + lane;
#pragma unroll
          for (int j = 0; j < 4; ++j) xr[64 * j] = xr[64 * j] + dlt; } }
#endif
    }
}

extern "C" void kernel_launch(void* const* d_in, const int* in_sizes, int n_in, void* d_out, int out_size, void* d_ws, size_t ws_size, hipStream_t stream) {
    static int grid = 0;
    if (grid == 0) {
        if (n_in != 17 || out_size != TT * DM || ws_size < WS_END) { fprintf(stderr, "kernel_launch: unexpected shapes (n_in %d out %d ws %zu)\n", n_in, out_size, ws_size); grid = -1; return; }
        int dev = 0, cus = 0, per_cu = 0;
        hipGetDevice(&dev); hipDeviceGetAttribute(&cus, hipDeviceAttributeMultiprocessorCount, dev);
        hipFuncSetAttribute((const void*)mega_fwd, hipFuncAttributeMaxDynamicSharedMemorySize, LDS_BYTES);
        hipOccupancyMaxActiveBlocksPerMultiprocessor(&per_cu, (const void*)mega_fwd, 512, LDS_BYTES);
        if (per_cu < 1) per_cu = 1;
        grid = cus * per_cu;
        (void)hipGetLastError();
    }
    if (grid < 0) return;
    Args a{};
    for (int i = 0; i < 17; ++i) a.in[i] = (const float*)d_in[i];
    a.out = (float*)d_out; a.ws = (unsigned char*)d_ws;
    for (int i = 0; i < 16; ++i) a.inv_mla[i] = 1.0f / powf(500000.0f, (float)(2 * i) / 32.0f);
    for (int i = 0; i < 8; ++i) a.inv_moba[i] = 1.0f / powf(500000.0f, (float)(2 * i) / 16.0f);
    for (int i = 0; i < 32; ++i) a.inv_ret[i] = 1.0f / powf(10000.0f, (float)(2 * i) / 64.0f);
    for (int i = 0; i < 4; ++i) a.ret_lg2[i] = (float)log2(1.0 - pow(2.0, -5.0 - (double)i));
    a.use_cg_sync = 0; a.pad_ = 0;
    (void)hipMemsetAsync((unsigned char*)d_ws + WS_BAR, 0, XCD_BAR_WORDS * 4, stream);
    void* kargs[] = {&a};
    hipError_t e = hipLaunchCooperativeKernel((const void*)mega_fwd, dim3(grid), dim3(512), kargs, LDS_BYTES, stream);
    if (e != hipSuccess) fprintf(stderr, "cooperative launch failed: %s (grid %d)\n", hipGetErrorString(e), grid);
}
```
